# Optimizing an MI355X kernel written in HIP

```python
import jax
import jax.numpy as jnp
from jax import lax
import numpy as np

D_MODEL = 2048
BATCH = 4
SEQ = 4096
DEPTH = 4

N_A_LAYERS = DEPTH // 2
N_B_LAYERS = DEPTH - N_A_LAYERS
NORM_EPS = 1e-6

RWKV_HEAD_SIZE = 64
RWKV_HEADS = D_MODEL // RWKV_HEAD_SIZE
DECAY_LORA = 96
AAA_LORA = 96
MV_LORA = 64
GN_EPS = 64e-5

NSA_HEADS = 16
NSA_GROUPS = 4
NSA_REP = NSA_HEADS // NSA_GROUPS
NSA_HEAD_DIM = D_MODEL // NSA_HEADS
NSA_WIDTH = NSA_HEADS * NSA_HEAD_DIM
KV_WIDTH = NSA_GROUPS * NSA_HEAD_DIM
N_BRANCH = 3
CMP_BLOCK = 32
CMP_STRIDE = 16
CMP_HIDDEN = 256
SEL_BLOCK = 64
SEL_TOP_N = 16
WINDOW = 512
Q_BLOCK = 64
ROPE_DIM = NSA_HEAD_DIM // 4
ROPE_THETA = 500000.0
NEG_INF = -1e30
FORCE_BONUS = 1e4

kernel_name = 'hybrid_rwkv7_nsa_yoco'


def rmsnorm(x, g):
    xf = x.astype(jnp.float32)
    y = xf * lax.rsqrt(jnp.mean(xf * xf, axis=-1, keepdims=True) + NORM_EPS)
    return (y * g.astype(jnp.float32)).astype(x.dtype)


def rope_partial(x, pos):
    half = ROPE_DIM // 2
    inv = ROPE_THETA ** (-jnp.arange(half, dtype=jnp.float32) / half)
    ang = pos.astype(jnp.float32)[:, None] * inv[None, :]
    cos = jnp.cos(ang)[None, :, None, :]
    sin = jnp.sin(ang)[None, :, None, :]
    xr = x[..., :ROPE_DIM].astype(jnp.float32)
    x1, x2 = xr[..., :half], xr[..., half:]
    rot = jnp.concatenate([x1 * cos - x2 * sin, x2 * cos + x1 * sin], axis=-1)
    return jnp.concatenate([rot.astype(x.dtype), x[..., ROPE_DIM:]], axis=-1)


def token_shift(x):
    return jnp.pad(x, ((0, 0), (1, 0), (0, 0)))[:, :-1]


def wkv7_scan(r, w, k, v, a, b):
    B, T, H, N = r.shape
    seq = tuple(jnp.moveaxis(t.astype(jnp.float32), 1, 0) for t in (r, w, k, v, a, b))

    def step(S, inp):
        r_t, w_t, k_t, v_t, a_t, b_t = inp
        sa = jnp.einsum('bhvk,bhk->bhv', S, a_t)
        S = S * w_t[:, :, None, :] + sa[..., None] * b_t[:, :, None, :] + v_t[..., None] * k_t[:, :, None, :]
        return S, jnp.einsum('bhvk,bhk->bhv', S, r_t)

    S0 = jnp.zeros((B, H, N, N), jnp.float32)
    _, o = lax.scan(step, S0, seq)
    return jnp.moveaxis(o, 0, 1)


def rwkv7_mixer(u, v_first, mu, w_rkvz, w0, w1, w2, a0, a1, a2, vres, k_k, k_a, r_k, ln_g, ln_b, w_o):
    B, T, D = u.shape
    xx = token_shift(u) - u
    mixed = u[None] + xx[None] * mu[:, None, None, :]
    rkvz = jnp.einsum('nbtd,nde->nbte', mixed[:4], w_rkvz)
    r, k, v, z = rkvz[0], rkvz[1], rkvz[2], rkvz[3]
    xv, xw, xa = mixed[2], mixed[4], mixed[5]
    w_log = -jax.nn.softplus(-(w0 + jnp.tanh(xw @ w1) @ w2)) - 0.5
    decay = jnp.exp(-jnp.exp(w_log.astype(jnp.float32)))
    a = jax.nn.sigmoid(a0 + (xa @ a1) @ a2)
    if vres is not None:
        v0, v1, v2 = vres
        v = v + (v_first - v) * jax.nn.sigmoid(v0 + (xv @ v1) @ v2)
    heads = lambda t: t.reshape(B, T, RWKV_HEADS, RWKV_HEAD_SIZE)
    kk = heads(k * k_k).astype(jnp.float32)
    kk = kk / jnp.maximum(jnp.sqrt(jnp.sum(kk * kk, axis=-1, keepdims=True)), 1e-12)
    k = k * (1.0 + (a - 1.0) * k_a)
    rh, kh, vh, ah = heads(r), heads(k), heads(v), heads(a)
    o = wkv7_scan(rh, heads(decay), kh, vh, -kk, kk * ah.astype(jnp.float32))
    mean = jnp.mean(o, axis=-1, keepdims=True)
    var = jnp.mean(jnp.square(o - mean), axis=-1, keepdims=True)
    o = ((o - mean) * lax.rsqrt(var + GN_EPS)).reshape(B, T, D) * ln_g + ln_b
    bonus = jnp.sum((rh * kh * r_k).astype(jnp.float32), axis=-1, keepdims=True) * vh
    o = (o + bonus.reshape(B, T, D)) * jax.nn.silu(z)
    return o.astype(u.dtype) @ w_o, v


def nsa_shared_kv(h, kv_norm_g, kv_w, cmp_pe, cmp_w1, cmp_w2):
    B, T, D = h.shape
    hn = rmsnorm(h, kv_norm_g)
    kv = (hn @ kv_w).reshape(B, T, 6, NSA_GROUPS, NSA_HEAD_DIM)
    k_c, v_c, k_s, v_s, k_w, v_w = [kv[:, :, i] for i in range(6)]
    pos = jnp.arange(T)
    k_s = rope_partial(k_s, pos)
    k_w = rope_partial(k_w, pos)
    n_cmp = (T - CMP_BLOCK) // CMP_STRIDE + 1
    idx = jnp.arange(n_cmp)[:, None] * CMP_STRIDE + jnp.arange(CMP_BLOCK)[None, :]

    def compress(t, j):
        blocks = t[:, idx] + cmp_pe[j][None, None, :, None, :]
        blocks = jnp.moveaxis(blocks, 3, 2).reshape(B, n_cmp, NSA_GROUPS, CMP_BLOCK * NSA_HEAD_DIM)
        return jax.nn.silu(blocks @ cmp_w1[j]) @ cmp_w2[j]

    k_cmp = rope_partial(compress(k_c, 0), idx[:, -1])
    v_cmp = compress(v_c, 1)
    to_g = lambda t: jnp.moveaxis(t, 2, 1)
    n_blk = T // SEL_BLOCK
    k_sel = to_g(k_s).reshape(B, NSA_GROUPS, n_blk, SEL_BLOCK, NSA_HEAD_DIM)
    v_sel = to_g(v_s).reshape(B, NSA_GROUPS, n_blk, SEL_BLOCK, NSA_HEAD_DIM)
    pad = ((0, 0), (0, 0), (WINDOW, 0), (0, 0))
    k_win = jnp.pad(to_g(k_w), pad)
    v_win = jnp.pad(to_g(v_w), pad)
    return (to_g(k_cmp), to_g(v_cmp), k_sel, v_sel, k_win, v_win)


def nsa_mixer(u, shared, w_in, gate_b, w_o):
    B, T, D = u.shape
    H, G, R, d = NSA_HEADS, NSA_GROUPS, NSA_REP, NSA_HEAD_DIM
    k_cmp, v_cmp, k_sel, v_sel, k_win, v_win = shared
    proj = u @ w_in
    q = rope_partial(proj[..., :NSA_WIDTH].reshape(B, T, H, d), jnp.arange(T))
    gl = proj[..., NSA_WIDTH:NSA_WIDTH + N_BRANCH * H] + gate_b
    z = proj[..., NSA_WIDTH + N_BRANCH * H:]
    gates = jax.nn.sigmoid(gl.astype(jnp.float32)).reshape(B, T, G, R, N_BRANCH)
    nq = T // Q_BLOCK
    q_blocks = q.reshape(B, nq, Q_BLOCK, G, R, d).transpose(1, 0, 3, 4, 2, 5)
    g_blocks = gates.reshape(B, nq, Q_BLOCK, G, R, N_BRANCH).transpose(1, 0, 3, 4, 2, 5)
    n_cmp = k_cmp.shape[2]
    n_blk = k_sel.shape[2]
    n_sel = min(SEL_TOP_N, n_blk)
    cmp_start = jnp.arange(n_cmp) * CMP_STRIDE
    cmp_end = cmp_start + CMP_BLOCK - 1
    cpos = cmp_start[:, None] + jnp.arange(CMP_BLOCK)[None, :]
    overlap = jax.nn.one_hot(cpos // SEL_BLOCK, n_blk, dtype=jnp.float32).mean(axis=1)
    blk = jnp.arange(n_blk)
    scale = d ** -0.5
    b_ix = jnp.arange(B)[:, None, None, None]
    g_ix = jnp.arange(G)[None, :, None, None]

    def block_fn(args):
        qb, gb, start = args
        tq = start + jnp.arange(Q_BLOCK)
        s = jnp.einsum('bgrqd,bgcd->bgrqc', qb, k_cmp).astype(jnp.float32) * scale
        vis = cmp_end[None, :] <= tq[:, None]
        p_cmp = jax.nn.softmax(jnp.where(vis, s, NEG_INF), axis=-1) * jnp.any(vis, axis=-1)[:, None]
        o_cmp = jnp.einsum('bgrqc,bgcd->bgrqd', p_cmp.astype(v_cmp.dtype), v_cmp)
        imp = jnp.einsum('bgrqc,cj->bgqj', p_cmp, overlap)
        cur = tq // SEL_BLOCK
        forced = (blk[None, :] == 0) | (blk[None, :] == cur[:, None]) | (blk[None, :] == cur[:, None] - 1)
        future = blk[None, :] > cur[:, None]
        imp = jnp.where(forced, FORCE_BONUS, jnp.where(future, NEG_INF, imp))
        _, sel = lax.top_k(imp, n_sel)
        ks = k_sel[b_ix, g_ix, sel]
        vs = v_sel[b_ix, g_ix, sel]
        s = jnp.einsum('bgrqd,bgqsld->bgrqsl', qb, ks).astype(jnp.float32) * scale
        kpos = sel[..., None] * SEL_BLOCK + jnp.arange(SEL_BLOCK)
        ok = kpos <= tq[None, None, :, None, None]
        s = jnp.where(ok[:, :, None], s, NEG_INF)
        p = jax.nn.softmax(s.reshape(B, G, R, Q_BLOCK, n_sel * SEL_BLOCK), axis=-1).reshape(s.shape)
        o_sel = jnp.einsum('bgrqsl,bgqsld->bgrqd', p.astype(vs.dtype), vs)
        kw = lax.dynamic_slice_in_dim(k_win, start, WINDOW + Q_BLOCK, axis=2)
        vw = lax.dynamic_slice_in_dim(v_win, start, WINDOW + Q_BLOCK, axis=2)
        wpos = start - WINDOW + jnp.arange(WINDOW + Q_BLOCK)
        diff = tq[:, None] - wpos[None, :]
        okw = (diff >= 0) & (diff < WINDOW) & (wpos[None, :] >= 0)
        s = jnp.einsum('bgrqd,bgkd->bgrqk', qb, kw).astype(jnp.float32) * scale
        p = jax.nn.softmax(jnp.where(okw, s, NEG_INF), axis=-1)
        o_win = jnp.einsum('bgrqk,bgkd->bgrqd', p.astype(vw.dtype), vw)
        o = gb[..., 0:1] * o_cmp + gb[..., 1:2] * o_sel + gb[..., 2:3] * o_win
        return o.astype(qb.dtype)

    starts = jnp.arange(nq) * Q_BLOCK
    o = lax.map(block_fn, (q_blocks, g_blocks, starts))
    o = o.transpose(1, 0, 4, 2, 3, 5).reshape(B, T, NSA_WIDTH)
    o = o * jax.nn.silu(z)
    return o @ w_o


def setup_inputs(seed: int = 0) -> dict:
    key = jax.random.key(seed)
    ks = jax.random.split(key, 32)
    D = D_MODEL
    na, nb = N_A_LAYERS, N_B_LAYERS
    nv = max(na - 1, 0)
    nrm = lambda i, shape, s: jax.random.normal(ks[i], shape, jnp.float32) * s
    return {
        'x': nrm(0, (BATCH, SEQ, D), 1.0),
        'a_norm_g': 1.0 + nrm(1, (na, D), 0.02),
        'a_mu': jax.random.uniform(ks[2], (na, 6, D), jnp.float32),
        'a_w_rkvz': nrm(3, (na, 4, D, D), D ** -0.5),
        'a_w0': jax.random.uniform(ks[4], (na, D), jnp.float32, minval=-6.0, maxval=0.0),
        'a_w1': nrm(5, (na, D, DECAY_LORA), D ** -0.5),
        'a_w2': nrm(6, (na, DECAY_LORA, D), 0.1 * DECAY_LORA ** -0.5),
        'a_a0': nrm(7, (na, D), 0.1),
        'a_a1': nrm(8, (na, D, AAA_LORA), D ** -0.5),
        'a_a2': nrm(9, (na, AAA_LORA, D), 0.1 * AAA_LORA ** -0.5),
        'a_v0': nrm(10, (nv, D), 0.1),
        'a_v1': nrm(11, (nv, D, MV_LORA), D ** -0.5),
        'a_v2': nrm(12, (nv, MV_LORA, D), 0.1 * MV_LORA ** -0.5),
        'a_k_k': 0.85 + nrm(13, (na, D), 0.02),
        'a_k_a': 1.0 + nrm(14, (na, D), 0.02),
        'a_r_k': nrm(15, (na, RWKV_HEADS, RWKV_HEAD_SIZE), 0.1),
        'a_ln_g': 1.0 + nrm(16, (na, D), 0.02),
        'a_ln_b': nrm(17, (na, D), 0.02),
        'a_w_o': nrm(18, (na, D, D), D ** -0.5),
        'kv_norm_g': 1.0 + nrm(19, (D,), 0.02),
        'kv_w': nrm(20, (D, 6 * KV_WIDTH), D ** -0.5),
        'cmp_pe': nrm(21, (2, CMP_BLOCK, NSA_HEAD_DIM), 0.1),
        'cmp_w1': nrm(22, (2, CMP_BLOCK * NSA_HEAD_DIM, CMP_HIDDEN), (CMP_BLOCK * NSA_HEAD_DIM) ** -0.5),
        'cmp_w2': nrm(23, (2, CMP_HIDDEN, NSA_HEAD_DIM), CMP_HIDDEN ** -0.5),
        'b_norm_g': 1.0 + nrm(24, (nb, D), 0.02),
        'b_w_in': nrm(25, (nb, D, 2 * NSA_WIDTH + N_BRANCH * NSA_HEADS), D ** -0.5),
        'b_gate_b': nrm(26, (nb, N_BRANCH * NSA_HEADS), 0.1),
        'b_w_o': nrm(27, (nb, NSA_WIDTH, D), NSA_WIDTH ** -0.5),
        'final_g': 1.0 + nrm(28, (D,), 0.02),
    }


def reference(x, a_norm_g, a_mu, a_w_rkvz, a_w0, a_w1, a_w2, a_a0, a_a1, a_a2, a_v0, a_v1, a_v2,
              a_k_k, a_k_a, a_r_k, a_ln_g, a_ln_b, a_w_o, kv_norm_g, kv_w, cmp_pe, cmp_w1, cmp_w2,
              b_norm_g, b_w_in, b_gate_b, b_w_o, final_g):
    h = x
    v_first = None
    shared = None
    for layer in range(DEPTH):
        if layer < N_A_LAYERS:
            i = layer
            vres = None if i == 0 else (a_v0[i - 1], a_v1[i - 1], a_v2[i - 1])
            y, v = rwkv7_mixer(rmsnorm(h, a_norm_g[i]), v_first, a_mu[i], a_w_rkvz[i],
                               a_w0[i], a_w1[i], a_w2[i], a_a0[i], a_a1[i], a_a2[i], vres,
                               a_k_k[i], a_k_a[i], a_r_k[i], a_ln_g[i], a_ln_b[i], a_w_o[i])
            if i == 0:
                v_first = v
            h = h + y
        else:
            if shared is None:
                shared = nsa_shared_kv(h, kv_norm_g, kv_w, cmp_pe, cmp_w1, cmp_w2)
            j = layer - N_A_LAYERS
            h = h + nsa_mixer(rmsnorm(h, b_norm_g[j]), shared, b_w_in[j], b_gate_b[j], b_w_o[j])
    return rmsnorm(h, final_g)
```

```cpp
#include <hip/hip_runtime.h>
#include <hip/hip_cooperative_groups.h>
#include <cstdio>
#include <cstdint>
#include <cstring>
#include <cmath>
namespace cg = cooperative_groups;

#ifndef ONE_LAUNCH
#define ONE_LAUNCH 1
#endif

typedef unsigned short bf16_t;
typedef short bf16x8 __attribute__((ext_vector_type(8)));
typedef float f32x4 __attribute__((ext_vector_type(4)));
typedef float f32x16 __attribute__((ext_vector_type(16)));
typedef unsigned u32x4 __attribute__((ext_vector_type(4)));
typedef unsigned u32x2 __attribute__((ext_vector_type(2)));

#define MTOK 16384
#define TSEQ 4096
#define DM 2048
#define NTHREADS 256
#define QSCALE 0.12751743f
#define ATT_KSZ 17408
#define ATT_BUF 35840
#define LDS_BYTES 71680

struct ConvJob { const float* src; bf16_t* dst; int K, N, ld, Kpad, Npad, tile0; };

struct P {
  const float *x, *a_norm_g, *a_mu, *a_w0, *a_a0, *a_v0, *a_k_k, *a_k_a, *a_r_k, *a_ln_g, *a_ln_b;
  const float *kv_norm_g, *cmp_pe, *b_norm_g, *b_gate_b, *final_g;
  float* out;
  bf16_t *ysum, *ubuf, *r, *k, *vA, *z, *vB;
  bf16_t *lw, *la, *lv; float *bon; float *ropec, *ropes;
  bf16_t *Wp, *W2w, *W2a, *W2v, *Wo;
  bf16_t *Wkv, *Win, *Wc1, *Wc2, *Wob;
  bf16_t *hn, *q, *sz, *ocmp;
  bf16_t *kc, *vc, *ks, *vsT, *kw, *vwT, *hc, *kcmp, *vcmpT;
  float *gates; unsigned *selmask;
};
struct PJ {
  ConvJob jobs[33];
  float rope_inv[16];
  int stage_tiles[4];
};

typedef __bf16 bf16x2_t __attribute__((ext_vector_type(2)));
typedef float f32x2 __attribute__((ext_vector_type(2)));
__device__ __forceinline__ unsigned cvtpk(float lo, float hi) {
  f32x2 v = {lo, hi};
  bf16x2_t b = __builtin_convertvector(v, bf16x2_t);
  return __builtin_bit_cast(unsigned, b);
}
__device__ __forceinline__ bf16_t f2bf(float x) { return (bf16_t)(cvtpk(x, x) & 0xffffu); }
__device__ __forceinline__ float bflo(unsigned w) { return __uint_as_float(w << 16); }
__device__ __forceinline__ float bfhi(unsigned w) { return __uint_as_float(w & 0xffff0000u); }
__device__ __forceinline__ float bf2f(bf16_t v) { return __uint_as_float(((unsigned)v) << 16); }
__device__ __forceinline__ void unpack8(bf16x8 v, float* f) {
  u32x4 w = *reinterpret_cast<u32x4*>(&v);
#pragma unroll
  for (int i = 0; i < 4; ++i) { f[2 * i] = bflo(w[i]); f[2 * i + 1] = bfhi(w[i]); }
}
__device__ __forceinline__ bf16x8 pack8f(const float* f) {
  u32x4 w = {cvtpk(f[0], f[1]), cvtpk(f[2], f[3]), cvtpk(f[4], f[5]), cvtpk(f[6], f[7])};
  return *reinterpret_cast<bf16x8*>(&w);
}
__device__ __forceinline__ float sigmoidf_(float x) { return __builtin_amdgcn_rcpf(1.f + __expf(-x)); }
__device__ __forceinline__ float siluf_(float x) { return x * __builtin_amdgcn_rcpf(1.f + __expf(-x)); }
#define DPP(x, ctrl) __int_as_float(__builtin_amdgcn_mov_dpp(__float_as_int(x), ctrl, 0xF, 0xF, true))
__device__ __forceinline__ float sum8(float x) {
  x += DPP(x, 0xB1); x += DPP(x, 0x4E); x += DPP(x, 0x141); return x;
}
__device__ __forceinline__ float wave_sum(float x) {
#pragma unroll
  for (int o = 32; o >= 1; o >>= 1) x += __shfl_xor(x, o);
  return x;
}
__device__ __forceinline__ float swap32_max(float x) {
  auto rr = __builtin_amdgcn_permlane32_swap(__float_as_uint(x), __float_as_uint(x), false, false);
  return fmaxf(__uint_as_float(rr[0]), __uint_as_float(rr[1]));
}
__device__ __forceinline__ float swap32_sum(float x) {
  auto rr = __builtin_amdgcn_permlane32_swap(__float_as_uint(x), __float_as_uint(x), false, false);
  return __uint_as_float(rr[0]) + __uint_as_float(rr[1]);
}
__device__ __forceinline__ int crow(int r, int hi) { return (r & 3) + 8 * (r >> 2) + 4 * hi; }

__device__ __forceinline__ void conv_tile(const ConvJob& jb, int tile, char* lds) {
  float* T = (float*)lds;
  const int nkt = jb.Kpad >> 6;
  const int n0 = (tile / nkt) * 64, k0 = (tile % nkt) * 64;
  const int tx = threadIdx.x & 63, ty = threadIdx.x >> 6;
#pragma unroll 4
  for (int rr = 0; rr < 16; ++rr) {
    int kl = ty * 16 + rr, kk = k0 + kl, n = n0 + tx;
    float v = (kk < jb.K && n < jb.N) ? jb.src[(size_t)kk * jb.ld + n] : 0.f;
    T[kl * 65 + tx] = v;
  }
  __syncthreads();
  const int nl = threadIdx.x >> 2, kc = (threadIdx.x & 3) * 16;
  unsigned w[8];
#pragma unroll
  for (int i = 0; i < 8; ++i) w[i] = cvtpk(T[(kc + 2 * i) * 65 + nl], T[(kc + 2 * i + 1) * 65 + nl]);
  bf16_t* d = jb.dst + (size_t)(n0 + nl) * jb.Kpad + k0 + kc;
  *(u32x4*)d = u32x4{w[0], w[1], w[2], w[3]};
  *(u32x4*)(d + 8) = u32x4{w[4], w[5], w[6], w[7]};
  __syncthreads();
}

template <int MODE>
__device__ __forceinline__ void rmsnorm_row(const P& p, int row, bool has_y, const float* g1, bf16_t* o1, const float* g2, bf16_t* o2, float* of) {
  const int lane = threadIdx.x & 63;
  const float* xr = p.x + (size_t)row * DM;
  const bf16_t* yr = p.ysum + (size_t)row * DM;
  f32x4 v[8]; float ss = 0.f;
#pragma unroll
  for (int i = 0; i < 8; ++i) {
    int c = (lane + 64 * i) * 4;
    v[i] = *(const f32x4*)(xr + c);
    if (has_y) { u32x2 w = *(const u32x2*)(yr + c); v[i][0] += bflo(w[0]); v[i][1] += bfhi(w[0]); v[i][2] += bflo(w[1]); v[i][3] += bfhi(w[1]); }
    ss += v[i][0] * v[i][0] + v[i][1] * v[i][1] + v[i][2] * v[i][2] + v[i][3] * v[i][3];
  }
  ss = wave_sum(ss);
  const float rs = rsqrtf(ss * (1.f / DM) + 1e-6f);
#pragma unroll
  for (int i = 0; i < 8; ++i) {
    int c = (lane + 64 * i) * 4;
    f32x4 g = *(const f32x4*)(g1 + c);
    if (MODE == 2) {
      f32x4 y = {v[i][0] * rs * g[0], v[i][1] * rs * g[1], v[i][2] * rs * g[2], v[i][3] * rs * g[3]};
      *(f32x4*)(of + (size_t)row * DM + c) = y;
    } else {
      u32x2 w = {cvtpk(v[i][0] * rs * g[0], v[i][1] * rs * g[1]), cvtpk(v[i][2] * rs * g[2], v[i][3] * rs * g[3])};
      *(u32x2*)(o1 + (size_t)row * DM + c) = w;
      if (MODE == 1) {
        f32x4 gg = *(const f32x4*)(g2 + c);
        u32x2 w2 = {cvtpk(v[i][0] * rs * gg[0], v[i][1] * rs * gg[1]), cvtpk(v[i][2] * rs * gg[2], v[i][3] * rs * gg[3])};
        *(u32x2*)(o2 + (size_t)row * DM + c) = w2;
      }
    }
  }
}

template <int MODE, int STAGE>
__device__ __forceinline__ void norm_phase(const P& p, const PJ& pj, bool has_y, const float* g1, bf16_t* o1, const float* g2, bf16_t* o2, float* of, char* lds) {
  if constexpr (STAGE >= 0) {
    constexpr int J0 = STAGE == 0 ? 0 : STAGE == 1 ? 9 : STAGE == 2 ? 20 : 29;
    constexpr int J1 = STAGE == 0 ? 9 : STAGE == 1 ? 20 : STAGE == 2 ? 29 : 33;
    const int nt = pj.stage_tiles[STAGE];
    for (int t = blockIdx.x; t < nt; t += gridDim.x) {
      const float* jsrc = pj.jobs[J0].src; bf16_t* jdst = pj.jobs[J0].dst;
      int jK = pj.jobs[J0].K, jN = pj.jobs[J0].N, jld = pj.jobs[J0].ld, jKp = pj.jobs[J0].Kpad, jNp = pj.jobs[J0].Npad, jt0 = pj.jobs[J0].tile0;
#pragma unroll
      for (int j = J0 + 1; j < J1; ++j) {
        const bool cnd = t >= pj.jobs[j].tile0;
        jsrc = cnd ? pj.jobs[j].src : jsrc; jdst = cnd ? pj.jobs[j].dst : jdst;
        jK = cnd ? pj.jobs[j].K : jK; jN = cnd ? pj.jobs[j].N : jN; jld = cnd ? pj.jobs[j].ld : jld;
        jKp = cnd ? pj.jobs[j].Kpad : jKp; jNp = cnd ? pj.jobs[j].Npad : jNp; jt0 = cnd ? pj.jobs[j].tile0 : jt0;
      }
      ConvJob jb; jb.src = jsrc; jb.dst = jdst; jb.K = jK; jb.N = jN; jb.ld = jld; jb.Kpad = jKp; jb.Npad = jNp; jb.tile0 = jt0;
      conv_tile(jb, t - jt0, lds);
    }
    if constexpr (STAGE == 0) {
      for (int pos = blockIdx.x * NTHREADS + threadIdx.x; pos < TSEQ; pos += gridDim.x * NTHREADS) {
#pragma unroll
        for (int i = 0; i < 16; ++i) {
          const float ang = (float)pos * pj.rope_inv[i];
          const double a = (double)ang * 0.15915494309189535;
          const float fr = (float)(a - rint(a));
          p.ropec[pos * 16 + i] = __builtin_amdgcn_cosf(fr); p.ropes[pos * 16 + i] = __builtin_amdgcn_sinf(fr);
        }
      }
    }
  }
  const int gw = blockIdx.x * 4 + (threadIdx.x >> 6), nw = gridDim.x * 4;
  for (int row = gw; row < MTOK; row += nw) rmsnorm_row<MODE>(p, row, has_y, g1, o1, g2, o2, of);
}

enum { AL_PLAIN = 0, AL_MIX = 1, AL_CMP = 2 };
enum { EP_PROJ = 0, EP_RESID = 1, EP_KV = 2, EP_CMP1 = 3, EP_CMP2 = 4, EP_WIN = 5 };

struct GemmCtx {
  const bf16_t* A; int lda;
  const bf16_t* Bt; int K;
  const float* aux;
  int layer, j;
};

template <int EP, int NI>
__device__ __forceinline__ void gemm_epilogue(const P& p, const GemmCtx& c, const int nt, const int m0, const int wr, const int lq, const int lr, const int cbase, f32x4 (&acc)[4][NI]) {
  const int rbase = m0 + wr * 64 + lq * 4; const int n0 = nt * 128;
  const int cl = cbase + lr;
  if constexpr (EP == EP_PROJ) {
    if (nt < 64) {
      const int which = nt >> 4;
      const int slab = which < 2 ? which : which == 3 ? 3 : (c.layer == 0 ? 2 : 4);
      bf16_t* dst = p.r + (size_t)slab * (32u << 20);
      const int cb = (nt & 15) * 128 + cl;
#pragma unroll
      for (int mi = 0; mi < 4; ++mi)
#pragma unroll
        for (int ni = 0; ni < NI; ++ni)
#pragma unroll
          for (int j = 0; j < 4; ++j) dst[(size_t)(rbase + mi * 16 + j) * DM + cb + ni * 16] = f2bf(acc[mi][ni][j]);
    } else {
      bf16_t* dst = p.lw + (size_t)(nt - 64) * (2u << 20);
#pragma unroll
      for (int mi = 0; mi < 4; ++mi)
#pragma unroll
        for (int ni = 0; ni < NI; ++ni)
#pragma unroll
          for (int j = 0; j < 4; ++j) {
            float v = acc[mi][ni][j];
            if (nt == 64) v = 1.f - 2.f * __builtin_amdgcn_rcpf(1.f + __expf(2.f * v));
            dst[(size_t)(rbase + mi * 16 + j) * 128 + cl + ni * 16] = f2bf(v);
          }
    }
  } else if constexpr (EP == EP_RESID) {
    const bool has_y = c.layer != 0;
#pragma unroll
    for (int mi = 0; mi < 4; ++mi)
#pragma unroll
      for (int ni = 0; ni < NI; ++ni)
#pragma unroll
        for (int j = 0; j < 4; ++j) {
          bf16_t* d = p.ysum + (size_t)(rbase + mi * 16 + j) * DM + n0 + cl + ni * 16;
          float v = acc[mi][ni][j]; if (has_y) v += bf2f(*d);
          *d = f2bf(v);
        }
  } else if constexpr (EP == EP_KV || EP == EP_WIN || EP == EP_CMP2) {
    int kind;
    bool rope = false; float qs = 1.f;
    bf16_t* dst = nullptr; int bgidx = 0;
    if constexpr (EP == EP_KV) {
      const int i = nt >> 2, g = nt & 3; bgidx = g;
      kind = (i == 3 || i == 5) ? 1 : 0; rope = (i == 2 || i == 4);
      dst = p.kc + (size_t)i * (8u << 20);
    } else if constexpr (EP == EP_WIN) {
      kind = nt < 16 ? 0 : nt < 32 ? 2 : 3; rope = nt < 16; qs = nt < 16 ? QSCALE : 1.f;
      dst = p.q + (nt < 16 ? (size_t)0 : (size_t)(32u << 20));
    } else {
      kind = c.j == 0 ? 0 : 1; rope = c.j == 0; dst = p.kcmp + (size_t)c.j * (512u << 10);
    }
    if (rope && cbase == 0) {
#pragma unroll
      for (int mi = 0; mi < 4; ++mi)
#pragma unroll
        for (int j = 0; j < 4; ++j) {
          const int row = rbase + mi * 16 + j;
          int pos;
          if constexpr (EP == EP_CMP2) { pos = 16 * (row & 255) + 31; if (pos > TSEQ - 1) pos = TSEQ - 1; } else pos = row & (TSEQ - 1);
          const float cs = p.ropec[pos * 16 + lr], sn = p.ropes[pos * 16 + lr];
          const float x1 = acc[mi][0][j], x2 = acc[mi][1][j];
          acc[mi][0][j] = x1 * cs - x2 * sn; acc[mi][1][j] = x2 * cs + x1 * sn;
        }
    }
    if (kind == 0) {
#pragma unroll
      for (int mi = 0; mi < 4; ++mi)
#pragma unroll
        for (int ni = 0; ni < NI; ++ni)
#pragma unroll
          for (int j = 0; j < 4; ++j) {
            const int row = rbase + mi * 16 + j; const int d = cl + ni * 16;
            size_t idx;
            if constexpr (EP == EP_KV) {
              const int i = nt >> 2;
              if (i < 2) idx = (size_t)row * 512 + bgidx * 128 + d;
              else { const int b = row >> 12, t = row & (TSEQ - 1); idx = ((size_t)((b * 4 + bgidx) * TSEQ + t)) * 128 + d; }
            } else if constexpr (EP == EP_WIN) idx = (size_t)row * DM + nt * 128 + d;
            else idx = (size_t)row * 128 + d;
            dst[idx] = f2bf(acc[mi][ni][j] * qs);
          }
    } else if (kind == 1) {
#pragma unroll
      for (int mi = 0; mi < 4; ++mi)
#pragma unroll
        for (int ni = 0; ni < NI; ++ni) {
          const int row0 = m0 + wr * 64 + mi * 16;
          const int d = cl + ni * 16;
          const int slot = (lq & 1) * 8 + (lq >> 1) * 4;
          u32x2 w = {cvtpk(acc[mi][ni][0], acc[mi][ni][1]), cvtpk(acc[mi][ni][2], acc[mi][ni][3])};
          size_t idx;
          if constexpr (EP == EP_KV) { const int b = row0 >> 12, t0 = row0 & (TSEQ - 1); idx = ((size_t)((b * 4 + bgidx) * 128 + d)) * TSEQ + t0 + slot; }
          else { const int bg = row0 >> 8, c0 = row0 & 255; idx = ((size_t)(bg * 128 + d)) * 256 + c0 + slot; }
          *(u32x2*)(dst + idx) = w;
        }
    } else if (kind == 2) {
#pragma unroll
      for (int mi = 0; mi < 4; ++mi)
#pragma unroll
        for (int ni = 0; ni < NI; ++ni)
#pragma unroll
          for (int j = 0; j < 4; ++j)
            dst[(size_t)(rbase + mi * 16 + j) * DM + (nt - 16) * 128 + cl + ni * 16] = f2bf(siluf_(acc[mi][ni][j]));
    } else {
      const float* gb = p.b_gate_b + c.j * 48;
#pragma unroll
      for (int mi = 0; mi < 4; ++mi)
#pragma unroll
        for (int ni = 0; ni < NI; ++ni) {
          const int n = cl + ni * 16;
          if (n < 48) {
#pragma unroll
            for (int j = 0; j < 4; ++j) p.gates[(size_t)(rbase + mi * 16 + j) * 48 + n] = sigmoidf_(acc[mi][ni][j] + gb[n]);
          }
        }
    }
  } else if constexpr (EP == EP_CMP1) {
    bf16_t* dst = p.hc + (size_t)c.j * 4096 * 256;
#pragma unroll
    for (int mi = 0; mi < 4; ++mi)
#pragma unroll
      for (int ni = 0; ni < NI; ++ni)
#pragma unroll
        for (int j = 0; j < 4; ++j) dst[(size_t)(rbase + mi * 16 + j) * 256 + n0 + cl + ni * 16] = f2bf(siluf_(acc[mi][ni][j]));
  }
}

template <int AL, int EP>
__device__ __forceinline__ void gemm_tile(const P& p, const GemmCtx& c, const int mt, const int nt, char* lds) {
  const int tid = threadIdx.x, lane = tid & 63, wid = tid >> 6;
  const int wr = wid >> 1, wc = wid & 1, lr = lane & 15, lq = lane >> 4;
  const int m0 = mt * 128, n0 = nt * 128;
  const int K = c.K, nk = K >> 6;
  const int lc = tid & 7, lrow = tid >> 3;
  f32x4 acc[4][4];
#pragma unroll
  for (int i = 0; i < 4; ++i)
#pragma unroll
    for (int j = 0; j < 4; ++j) acc[i][j] = f32x4{0.f, 0.f, 0.f, 0.f};
  bf16x8 ra[4], rp[4], rb[4]; f32x4 ax0, ax1;

  auto load_tile = [&](int kt) {
#pragma unroll
    for (int i = 0; i < 4; ++i) {
      const int row = lrow + 32 * i;
      rb[i] = *(const bf16x8*)(c.Bt + (size_t)(n0 + row) * K + kt * 64 + lc * 8);
      if constexpr (AL == AL_PLAIN) {
        ra[i] = *(const bf16x8*)(c.A + (size_t)(m0 + row) * c.lda + kt * 64 + lc * 8);
      } else if constexpr (AL == AL_MIX) {
        const int m = m0 + row;
        const bf16_t* src = c.A + (size_t)m * DM + kt * 64 + lc * 8;
        ra[i] = *(const bf16x8*)src;
        if ((m & (TSEQ - 1)) != 0) rp[i] = *(const bf16x8*)(src - DM); else rp[i] = bf16x8{0, 0, 0, 0, 0, 0, 0, 0};
      } else {
        const int R = m0 + row, bg = R >> 8, cc = R & 255, b = bg >> 2, g = bg & 3;
        const int l = kt >> 1, d = (kt & 1) * 64 + lc * 8;
        int t = 16 * cc + l; if (t > TSEQ - 1) t = TSEQ - 1;
        ra[i] = *(const bf16x8*)(c.A + ((size_t)(b * TSEQ + t)) * 512 + g * 128 + d);
      }
    }
    if constexpr (AL == AL_MIX) { const float* mu = c.aux + kt * 64 + lc * 8; ax0 = *(const f32x4*)mu; ax1 = *(const f32x4*)(mu + 4); }
    if constexpr (AL == AL_CMP) { const float* pe = c.aux + (kt >> 1) * 128 + (kt & 1) * 64 + lc * 8; ax0 = *(const f32x4*)pe; ax1 = *(const f32x4*)(pe + 4); }
  };
  auto store_tile = [&](int buf) {
    char* Ab = lds + buf * 32768; char* Bb = Ab + 16384;
#pragma unroll
    for (int i = 0; i < 4; ++i) {
      const int row = lrow + 32 * i;
      const int off = row * 128 + ((lc ^ (row & 7)) << 4);
      *(bf16x8*)(Bb + off) = rb[i];
      if constexpr (AL == AL_PLAIN) { *(bf16x8*)(Ab + off) = ra[i]; }
      else {
        float f[8]; unpack8(ra[i], f);
        const float mu[8] = {ax0[0], ax0[1], ax0[2], ax0[3], ax1[0], ax1[1], ax1[2], ax1[3]};
        if constexpr (AL == AL_MIX) {
          float fp[8]; unpack8(rp[i], fp);
#pragma unroll
          for (int e = 0; e < 8; ++e) f[e] = f[e] + (fp[e] - f[e]) * mu[e];
        } else {
#pragma unroll
          for (int e = 0; e < 8; ++e) f[e] = f[e] + mu[e];
        }
        *(bf16x8*)(Ab + off) = pack8f(f);
      }
    }
  };
  auto compute = [&](int buf) {
    const char* Ab = lds + buf * 32768; const char* Bb = Ab + 16384;
#pragma unroll
    for (int ks = 0; ks < 2; ++ks) {
      bf16x8 af[4], bfr[4];
#pragma unroll
      for (int mi = 0; mi < 4; ++mi) { const int row = wr * 64 + mi * 16 + lr; af[mi] = *(const bf16x8*)(Ab + row * 128 + (((ks * 4 + lq) ^ (row & 7)) << 4)); }
#pragma unroll
      for (int ni = 0; ni < 4; ++ni) { const int row = wc * 64 + ni * 16 + lr; bfr[ni] = *(const bf16x8*)(Bb + row * 128 + (((ks * 4 + lq) ^ (row & 7)) << 4)); }
#pragma unroll
      for (int mi = 0; mi < 4; ++mi)
#pragma unroll
        for (int ni = 0; ni < 4; ++ni) acc[mi][ni] = __builtin_amdgcn_mfma_f32_16x16x32_bf16(af[mi], bfr[ni], acc[mi][ni], 0, 0, 0);
    }
  };

  load_tile(0);
  store_tile(0);
  __syncthreads();
  for (int kt = 0; kt < nk; ++kt) {
    if (kt + 1 < nk) load_tile(kt + 1);
    __builtin_amdgcn_sched_barrier(0);
    compute(kt & 1);
    __builtin_amdgcn_sched_barrier(0);
    if (kt + 1 < nk) store_tile((kt + 1) & 1);
    __syncthreads();
  }

  gemm_epilogue<EP, 4>(p, c, nt, m0, wr, lq, lr, wc * 64, acc);
}


template <int AL, int EP>
__device__ __forceinline__ void gemm_wide(const P& p, const GemmCtx& c, const int mt, const int nt2, char* lds) {
  const int tid = threadIdx.x, lane = tid & 63, wid = tid >> 6;
  const int wr = wid >> 1, wc = wid & 1, lr = lane & 15, lq = lane >> 4;
  const int m0 = mt * 128, n0 = nt2 * 256;
  const int K = c.K, nk = K >> 5;
  const bf16_t* A = c.A;
  const bf16_t* Bt = c.Bt;
  const float* mu = c.aux;
  const int lc = tid & 3, lrow = tid >> 2;
  f32x4 acc[4][8];
#pragma unroll
  for (int i = 0; i < 4; ++i)
#pragma unroll
    for (int j = 0; j < 8; ++j) acc[i][j] = f32x4{0.f, 0.f, 0.f, 0.f};
  bf16x8 ra[2], rp[2], rb[4]; f32x4 ax0, ax1;
  auto load_tile = [&](int kt) {
#pragma unroll
    for (int i = 0; i < 4; ++i) rb[i] = *(const bf16x8*)(Bt + (size_t)(n0 + lrow + 64 * i) * K + kt * 32 + lc * 8);
#pragma unroll
    for (int i = 0; i < 2; ++i) {
      const int m = m0 + lrow + 64 * i;
      const bf16_t* src = A + (size_t)m * c.lda + kt * 32 + lc * 8;
      ra[i] = *(const bf16x8*)src;
      if constexpr (AL == AL_MIX) { if ((m & (TSEQ - 1)) != 0) rp[i] = *(const bf16x8*)(src - DM); else rp[i] = bf16x8{0, 0, 0, 0, 0, 0, 0, 0}; }
    }
    if constexpr (AL == AL_MIX) { ax0 = *(const f32x4*)(mu + kt * 32 + lc * 8); ax1 = *(const f32x4*)(mu + kt * 32 + lc * 8 + 4); }
  };
  auto store_tile = [&](int buf) {
    char* Ab = lds + buf * 24576; char* Bb = Ab + 8192;
#pragma unroll
    for (int i = 0; i < 4; ++i) { const int row = lrow + 64 * i; *(bf16x8*)(Bb + row * 64 + ((lc ^ ((-(row >> 2)) & 3)) << 4)) = rb[i]; }
#pragma unroll
    for (int i = 0; i < 2; ++i) {
      const int row = lrow + 64 * i;
      if constexpr (AL == AL_MIX) {
        const float muv[8] = {ax0[0], ax0[1], ax0[2], ax0[3], ax1[0], ax1[1], ax1[2], ax1[3]};
        float f[8], fp[8]; unpack8(ra[i], f); unpack8(rp[i], fp);
#pragma unroll
        for (int e = 0; e < 8; ++e) f[e] = f[e] + (fp[e] - f[e]) * muv[e];
        *(bf16x8*)(Ab + row * 64 + ((lc ^ ((-(row >> 2)) & 3)) << 4)) = pack8f(f);
      } else {
        *(bf16x8*)(Ab + row * 64 + ((lc ^ ((-(row >> 2)) & 3)) << 4)) = ra[i];
      }
    }
  };
  auto compute = [&](int buf) {
    const char* Ab = lds + buf * 24576; const char* Bb = Ab + 8192;
    const int sw = (lq ^ ((-(lr >> 2)) & 3)) << 4;
    bf16x8 af[4];
#pragma unroll
    for (int mi = 0; mi < 4; ++mi) af[mi] = *(const bf16x8*)(Ab + (wr * 64 + mi * 16 + lr) * 64 + sw);
#pragma unroll
    for (int nh = 0; nh < 2; ++nh) {
      bf16x8 bfr[4];
#pragma unroll
      for (int ni = 0; ni < 4; ++ni) bfr[ni] = *(const bf16x8*)(Bb + (wc * 128 + (nh * 4 + ni) * 16 + lr) * 64 + sw);
#pragma unroll
      for (int mi = 0; mi < 4; ++mi)
#pragma unroll
        for (int ni = 0; ni < 4; ++ni) acc[mi][nh * 4 + ni] = __builtin_amdgcn_mfma_f32_16x16x32_bf16(af[mi], bfr[ni], acc[mi][nh * 4 + ni], 0, 0, 0);
    }
  };
  load_tile(0);
  store_tile(0);
  __syncthreads();
  for (int kt = 0; kt < nk; ++kt) {
    if (kt + 1 < nk) load_tile(kt + 1);
    __builtin_amdgcn_sched_barrier(0);
    compute(kt & 1);
    __builtin_amdgcn_sched_barrier(0);
    if (kt + 1 < nk) store_tile((kt + 1) & 1);
    __syncthreads();
  }
  gemm_epilogue<EP, 8>(p, c, 2 * nt2 + wc, m0, wr, lq, lr, 0, acc);
}

__device__ __forceinline__ float sum16(float x) {
  x += DPP(x, 0xB1); x += DPP(x, 0x4E); x += DPP(x, 0x141); x += DPP(x, 0x140); return x;
}
__device__ __forceinline__ void scan_item(const P& p, const int layer, const int item, char* lds) {
  const int quarter = item & 3, h = (item >> 2) & 31, b = item >> 7;
  const int tid = threadIdx.x, lane = tid & 63, wid = tid >> 6;
  float* R = (float*)lds;
  float* W = R + 2048; float* Kk = W + 2048; float* Aa = Kk + 2048; float* Bv = Aa + 2048;
  float* V = Bv + 2048;
  float* Vg = V + 512;
  float* O = Vg + 512;
  float* KKp = O + 528; float* KAp = KKp + 64; float* RKp = KAp + 64;
  float* LBp = RKp + 64;
  const bf16_t* vsrc = p.vA + (size_t)layer * (64u << 20);
  bf16_t* vdst = p.vB;
  const int tl = tid >> 3, c8 = tid & 7;
  const int ch0 = h * 64 + c8 * 8;
  const int vc0 = h * 64 + quarter * 16;
  const int lr = lane & 15, lq = lane >> 4;
  const int ten = wid >> 1, lmi = wid & 1;
  const bf16_t* lA = p.lw + (size_t)ten * (2u << 20);
  const bf16_t* lB = p.W2w + (size_t)ten * (256u << 10);
  if (tid < 64) {
    KKp[tid] = p.a_k_k[layer * DM + h * 64 + tid]; KAp[tid] = p.a_k_a[layer * DM + h * 64 + tid]; RKp[tid] = p.a_r_k[layer * DM + h * 64 + tid];
  }
  if (tid < 128) { const float b0_ = p.a_w0[layer * DM + h * 64 + (tid & 63)], b1_ = p.a_a0[layer * DM + h * 64 + (tid & 63)]; LBp[tid] = tid < 64 ? b0_ : b1_; }
  if (tid >= 128 && tid < 144) LBp[tid] = layer == 1 ? p.a_v0[vc0 + (tid - 128)] : 0.f;
  const int row = tid >> 4, kq = tid & 15;
  f32x2 S01 = {0.f, 0.f}, S23 = {0.f, 0.f};

  const size_t tok0 = (size_t)b * TSEQ;
  bf16x8 rr, rk, rv, rvf;
  bf16x8 wB[3][4], wBv[2], fA[3], fAv[2];
#pragma unroll
  for (int ks = 0; ks < 3; ++ks)
#pragma unroll
    for (int ni = 0; ni < 4; ++ni) wB[ks][ni] = *(const bf16x8*)(lB + (size_t)(h * 64 + ni * 16 + lr) * 128 + ks * 32 + lq * 8);
  if (layer == 1) {
#pragma unroll
    for (int ks = 0; ks < 2; ++ks) wBv[ks] = *(const bf16x8*)(p.W2v + (size_t)(vc0 + lr) * 128 + ks * 32 + lq * 8);
  }
  auto load_raw = [&](int c) {
    const size_t m = tok0 + c * 32 + tl;
    {
      const size_t ml = tok0 + c * 32 + lmi * 16 + lr;
#pragma unroll
      for (int ks = 0; ks < 3; ++ks) fA[ks] = *(const bf16x8*)(lA + ml * 128 + ks * 32 + lq * 8);
      if (layer == 1) {
#pragma unroll
        for (int ks = 0; ks < 2; ++ks) fAv[ks] = *(const bf16x8*)(p.lv + ml * 128 + ks * 32 + lq * 8);
      }
    }
    rr = *(const bf16x8*)(p.r + m * DM + ch0);
    rk = *(const bf16x8*)(p.k + m * DM + ch0);
    if (c8 < 2) {
      rv = *(const bf16x8*)(vsrc + m * DM + vc0 + c8 * 8);
      if (layer == 1) rvf = *(const bf16x8*)(p.vA + m * DM + vc0 + c8 * 8);
    }
  };
  load_raw(0);
  __syncthreads();
  for (int c = 0; c < TSEQ / 32; ++c) {
    const size_t mc = tok0 + c * 32;
    {
      f32x4 acc[4];
#pragma unroll
      for (int ni = 0; ni < 4; ++ni) acc[ni] = f32x4{0.f, 0.f, 0.f, 0.f};
#pragma unroll
      for (int ks = 0; ks < 3; ++ks) {
#pragma unroll
        for (int ni = 0; ni < 4; ++ni) acc[ni] = __builtin_amdgcn_mfma_f32_16x16x32_bf16(fA[ks], wB[ks][ni], acc[ni], 0, 0, 0);
      }
      float* dstL = ten == 0 ? W : Bv;
#pragma unroll
      for (int ni = 0; ni < 4; ++ni)
#pragma unroll
        for (int j = 0; j < 4; ++j) {
          float sg = sigmoidf_(acc[ni][j] + LBp[ten * 64 + ni * 16 + lr]);
          float val = ten == 0 ? __expf(-0.6065306597126334f * sg) : sg;
          dstL[(lmi * 16 + lq * 4 + j) * 64 + ni * 16 + lr] = val;
        }
      if (layer == 1 && wid < 2) {
        f32x4 av = f32x4{0.f, 0.f, 0.f, 0.f};
#pragma unroll
        for (int ks = 0; ks < 2; ++ks) av = __builtin_amdgcn_mfma_f32_16x16x32_bf16(fAv[ks], wBv[ks], av, 0, 0, 0);
#pragma unroll
        for (int j = 0; j < 4; ++j) Vg[(wid * 16 + lq * 4 + j) * 16 + lr] = sigmoidf_(av[j] + LBp[128 + lr]);
      }
    }
    if (c > 0) {
      const float o0 = O[(c8 * 2) * 33 + tl], o1 = O[(c8 * 2 + 1) * 33 + tl];
      *(unsigned*)(p.ubuf + (mc - 32 + tl) * DM + vc0 + c8 * 2) = cvtpk(o0, o1);
    }
    __syncthreads();
    {
      float fr[8], fk[8], fa[8];
      unpack8(rr, fr); unpack8(rk, fk);
      { f32x4 a0 = *(const f32x4*)(Bv + tl * 64 + c8 * 8), a1 = *(const f32x4*)(Bv + tl * 64 + c8 * 8 + 4);
        fa[0] = a0[0]; fa[1] = a0[1]; fa[2] = a0[2]; fa[3] = a0[3]; fa[4] = a1[0]; fa[5] = a1[1]; fa[6] = a1[2]; fa[7] = a1[3]; }
      float kk[8], ss = 0.f, bsum = 0.f;
      float kkv[8], kav[8], rkv[8];
      { f32x4 t0 = *(const f32x4*)(KKp + c8 * 8), t1 = *(const f32x4*)(KKp + c8 * 8 + 4);
        kkv[0] = t0[0]; kkv[1] = t0[1]; kkv[2] = t0[2]; kkv[3] = t0[3]; kkv[4] = t1[0]; kkv[5] = t1[1]; kkv[6] = t1[2]; kkv[7] = t1[3];
        t0 = *(const f32x4*)(KAp + c8 * 8); t1 = *(const f32x4*)(KAp + c8 * 8 + 4);
        kav[0] = t0[0]; kav[1] = t0[1]; kav[2] = t0[2]; kav[3] = t0[3]; kav[4] = t1[0]; kav[5] = t1[1]; kav[6] = t1[2]; kav[7] = t1[3];
        t0 = *(const f32x4*)(RKp + c8 * 8); t1 = *(const f32x4*)(RKp + c8 * 8 + 4);
        rkv[0] = t0[0]; rkv[1] = t0[1]; rkv[2] = t0[2]; rkv[3] = t0[3]; rkv[4] = t1[0]; rkv[5] = t1[1]; rkv[6] = t1[2]; rkv[7] = t1[3]; }
#pragma unroll
      for (int e = 0; e < 8; ++e) { kk[e] = fk[e] * kkv[e]; ss += kk[e] * kk[e]; }
      ss = sum8(ss);
      const float inv = __builtin_amdgcn_rsqf(fmaxf(ss, 1e-24f));
      float kp[8], na[8], bb[8];
#pragma unroll
      for (int e = 0; e < 8; ++e) {
        kk[e] *= inv;
        kp[e] = fk[e] * (1.f + (fa[e] - 1.f) * kav[e]);
        na[e] = -kk[e]; bb[e] = kk[e] * fa[e];
        bsum += fr[e] * kp[e] * rkv[e];
      }
      bsum = sum8(bsum);
      float* d;
      d = R + tl * 64 + c8 * 8;  *(f32x4*)d = f32x4{fr[0], fr[1], fr[2], fr[3]}; *(f32x4*)(d + 4) = f32x4{fr[4], fr[5], fr[6], fr[7]};
      d = Kk + tl * 64 + c8 * 8; *(f32x4*)d = f32x4{kp[0], kp[1], kp[2], kp[3]}; *(f32x4*)(d + 4) = f32x4{kp[4], kp[5], kp[6], kp[7]};
      d = Aa + tl * 64 + c8 * 8; *(f32x4*)d = f32x4{na[0], na[1], na[2], na[3]}; *(f32x4*)(d + 4) = f32x4{na[4], na[5], na[6], na[7]};
      d = Bv + tl * 64 + c8 * 8; *(f32x4*)d = f32x4{bb[0], bb[1], bb[2], bb[3]}; *(f32x4*)(d + 4) = f32x4{bb[4], bb[5], bb[6], bb[7]};
      if (quarter == 0 && c8 == 0) p.bon[(mc + tl) * 32 + h] = bsum;
      if (c8 < 2) {
        float fv[8]; unpack8(rv, fv);
        if (layer == 1) {
          float ff[8]; unpack8(rvf, ff);
          f32x4 g0 = *(const f32x4*)(Vg + tl * 16 + c8 * 8), g1 = *(const f32x4*)(Vg + tl * 16 + c8 * 8 + 4);
          const float gg[8] = {g0[0], g0[1], g0[2], g0[3], g1[0], g1[1], g1[2], g1[3]};
#pragma unroll
          for (int e = 0; e < 8; ++e) fv[e] = fv[e] + (ff[e] - fv[e]) * gg[e];
          *(bf16x8*)(vdst + (mc + tl) * DM + vc0 + c8 * 8) = pack8f(fv);
        }
        d = V + tl * 16 + c8 * 8; *(f32x4*)d = f32x4{fv[0], fv[1], fv[2], fv[3]}; *(f32x4*)(d + 4) = f32x4{fv[4], fv[5], fv[6], fv[7]};
      }
    }
    __syncthreads();
    if (c + 1 < TSEQ / 32) load_raw(c + 1);
    {
      f32x4 xa, xw, xk, xb, xr, na_, nw_, nk_, nb_, nr_; float xv, nv;
      const float* bA = Aa + kq * 4; const float* bW = W + kq * 4; const float* bK = Kk + kq * 4; const float* bB = Bv + kq * 4; const float* bR = R + kq * 4;
      xa = *(const f32x4*)bA; xw = *(const f32x4*)bW; xk = *(const f32x4*)bK; xb = *(const f32x4*)bB; xr = *(const f32x4*)bR; xv = V[row];
      float opend = 0.f;
#pragma unroll 8
      for (int t = 0; t < 32; ++t) {
        const f32x2 xa01 = {xa[0], xa[1]}, xa23 = {xa[2], xa[3]};
        f32x2 pa = S01 * xa01; pa = __builtin_elementwise_fma(S23, xa23, pa);
        float ra_ = pa[0] + pa[1];
        {
          const int o_ = ((t + 1) & 31) * 64;
          na_ = *(const f32x4*)(bA + o_); nw_ = *(const f32x4*)(bW + o_); nk_ = *(const f32x4*)(bK + o_); nb_ = *(const f32x4*)(bB + o_); nr_ = *(const f32x4*)(bR + o_);
          nv = V[((t + 1) & 31) * 16 + row];
        }
        float ro_ = opend;
        ra_ += DPP(ra_, 0xB1); ro_ += DPP(ro_, 0xB1);
        ra_ += DPP(ra_, 0x4E); ro_ += DPP(ro_, 0x4E);
        ra_ += DPP(ra_, 0x141); ro_ += DPP(ro_, 0x141);
        ra_ += DPP(ra_, 0x140); ro_ += DPP(ro_, 0x140);
        O[row * 33 + ((t - 1) & 31)] = ro_;
        const f32x2 sa2 = {ra_, ra_}, xv2 = {xv, xv};
        const f32x2 xk01 = {xk[0], xk[1]}, xk23 = {xk[2], xk[3]}, xb01 = {xb[0], xb[1]}, xb23 = {xb[2], xb[3]};
        const f32x2 xw01 = {xw[0], xw[1]}, xw23 = {xw[2], xw[3]}, xr01 = {xr[0], xr[1]}, xr23 = {xr[2], xr[3]};
        S01 = __builtin_elementwise_fma(S01, xw01, __builtin_elementwise_fma(sa2, xb01, xv2 * xk01));
        S23 = __builtin_elementwise_fma(S23, xw23, __builtin_elementwise_fma(sa2, xb23, xv2 * xk23));
        f32x2 po = S01 * xr01; po = __builtin_elementwise_fma(S23, xr23, po);
        opend = po[0] + po[1];
        xa = na_; xw = nw_; xk = nk_; xb = nb_; xr = nr_; xv = nv;
      }
      { const float ro_ = sum16(opend); O[row * 33 + 31] = ro_; }
    }
    __syncthreads();
  }
  {
    const size_t mp = tok0 + (TSEQ - 32);
    const float o0 = O[(c8 * 2) * 33 + tl], o1 = O[(c8 * 2 + 1) * 33 + tl];
    *(unsigned*)(p.ubuf + (mp + tl) * DM + vc0 + c8 * 2) = cvtpk(o0, o1);
  }
  __syncthreads();
}

__device__ __forceinline__ void postscan_phase(const P& p, const int layer) {
  const int tid = threadIdx.x, head = tid >> 3, ch = tid * 8;
  const bf16_t* vsrc = p.vA + (size_t)layer * (64u << 20);
  float lg[8], lb[8];
  {
    const float* pg = p.a_ln_g + layer * DM + ch; const float* pb = p.a_ln_b + layer * DM + ch;
#pragma unroll
    for (int e = 0; e < 8; ++e) { lg[e] = pg[e]; lb[e] = pb[e]; }
  }
  for (int m0 = blockIdx.x; m0 < MTOK; m0 += 4 * gridDim.x) {
    bf16x8 ro[4], rv[4], rz[4]; float bn[4];
#pragma unroll
    for (int u = 0; u < 4; ++u) {
      const int m = m0 + u * gridDim.x;
      if (m < MTOK) {
        ro[u] = *(const bf16x8*)(p.ubuf + (size_t)m * DM + ch);
        rv[u] = *(const bf16x8*)(vsrc + (size_t)m * DM + ch);
        rz[u] = *(const bf16x8*)(p.z + (size_t)m * DM + ch);
        bn[u] = p.bon[(size_t)m * 32 + head];
      }
    }
#pragma unroll
    for (int u = 0; u < 4; ++u) {
      const int m = m0 + u * gridDim.x;
      if (m < MTOK) {
        float fo[8], fv[8], fz[8];
        unpack8(ro[u], fo); unpack8(rv[u], fv); unpack8(rz[u], fz);
        float sm = 0.f;
#pragma unroll
        for (int e = 0; e < 8; ++e) sm += fo[e];
        const float mean = sum8(sm) * (1.f / 64.f);
        float sv = 0.f;
#pragma unroll
        for (int e = 0; e < 8; ++e) { fo[e] -= mean; sv += fo[e] * fo[e]; }
        const float rstd = rsqrtf(sum8(sv) * (1.f / 64.f) + 64e-5f);
#pragma unroll
        for (int e = 0; e < 8; ++e) fo[e] = (fo[e] * rstd * lg[e] + lb[e] + bn[u] * fv[e]) * siluf_(fz[e]);
        *(bf16x8*)(p.ubuf + (size_t)m * DM + ch) = pack8f(fo);
      }
    }
  }
}

__device__ __forceinline__ void cmp_item(const P& p, const int item, char* lds) {
  const int qb = (item & 512) ? 63 - (item & 63) : (item & 63), g = (item >> 6) & 3, b = item >> 8;
  const int bg = b * 4 + g;
  const int tid = threadIdx.x, lane = tid & 63, w = tid >> 6;
  const int n = lane & 31, hi = lane >> 5;
  float* impM = (float*)lds;
  float* impS = impM + 64 * 68;
  for (int e = lane; e < 16 * 68; e += 64) { impM[w * 16 * 68 + e] = 0.f; impS[w * 16 * 68 + e] = 0.f; }
  const int ql = 16 * w + (n & 15);
  const int tq = qb * 64 + ql;
  const size_t m = (size_t)b * TSEQ + tq;
  const int cmaxq = (tq - 31) >> 4;
  const int nkt = (4 * qb + 3 + 31) >> 5;
  const bf16_t* Kc = p.kcmp + (size_t)bg * 256 * 128;
  const bf16_t* Vc = p.vcmpT + (size_t)bg * 128 * 256;
  const float NEG = -__builtin_inff();
#pragma unroll 1
  for (int ct = 0; ct < 2; ++ct) {
    const int head = g * 4 + 2 * ct + (n >> 4);
    bf16x8 qf[8];
#pragma unroll
    for (int d0 = 0; d0 < 8; ++d0) qf[d0] = *(const bf16x8*)(p.q + m * DM + head * 128 + d0 * 16 + hi * 8);
    float mx = -1e30f, l = 0.f;
#pragma unroll 1
    for (int kt = 0; kt < nkt; ++kt) {
      f32x16 sc; for (int r = 0; r < 16; ++r) sc[r] = 0.f;
#pragma unroll
      for (int d0 = 0; d0 < 8; ++d0) {
        bf16x8 kf = *(const bf16x8*)(Kc + (size_t)(kt * 32 + n) * 128 + d0 * 16 + hi * 8);
        sc = __builtin_amdgcn_mfma_f32_32x32x16_bf16(kf, qf[d0], sc, 0, 0, 0);
      }
      float tm = NEG;
#pragma unroll
      for (int r = 0; r < 16; ++r) { const int cc = kt * 32 + crow(r, hi); if (cc > cmaxq) sc[r] = NEG; tm = fmaxf(tm, sc[r]); }
      tm = swap32_max(tm);
      const float mn = fmaxf(mx, tm);
      float ps = 0.f;
#pragma unroll
      for (int r = 0; r < 16; ++r) ps += __builtin_amdgcn_exp2f(sc[r] - mn);
      ps = swap32_sum(ps);
      l = l * __builtin_amdgcn_exp2f(mx - mn) + ps; mx = mn;
    }
    const float inv_l = l > 0.f ? 1.f / l : 0.f;
    f32x16 o[4];
#pragma unroll
    for (int dt = 0; dt < 4; ++dt) for (int r = 0; r < 16; ++r) o[dt][r] = 0.f;
#pragma unroll 1
    for (int kt = 0; kt < nkt; ++kt) {
      f32x16 sc; for (int r = 0; r < 16; ++r) sc[r] = 0.f;
#pragma unroll
      for (int d0 = 0; d0 < 8; ++d0) {
        bf16x8 kf = *(const bf16x8*)(Kc + (size_t)(kt * 32 + n) * 128 + d0 * 16 + hi * 8);
        sc = __builtin_amdgcn_mfma_f32_32x32x16_bf16(kf, qf[d0], sc, 0, 0, 0);
      }
      float pr[16];
#pragma unroll
      for (int r = 0; r < 16; ++r) { const int cc = kt * 32 + crow(r, hi); pr[r] = (cc > cmaxq) ? 0.f : __builtin_amdgcn_exp2f(sc[r] - mx) * inv_l; }
#pragma unroll
      for (int a = 0; a < 4; ++a) {
        float mainv = pr[4 * a] + pr[4 * a + 1] + pr[4 * a + 2] + 0.5f * pr[4 * a + 3];
        float spill = 0.5f * pr[4 * a + 3];
        mainv += __shfl_xor(mainv, 16); spill += __shfl_xor(spill, 16);
        if ((n & 16) == 0) {
          const int jj = 8 * kt + 2 * a + hi;
          impM[ql * 68 + jj] += mainv; impS[ql * 68 + jj + 1] += spill;
        }
      }
      const float pf0[8] = {pr[0], pr[1], pr[2], pr[3], pr[4], pr[5], pr[6], pr[7]};
      const float pf1[8] = {pr[8], pr[9], pr[10], pr[11], pr[12], pr[13], pr[14], pr[15]};
      const bf16x8 pb0 = pack8f(pf0), pb1 = pack8f(pf1);
#pragma unroll
      for (int dt = 0; dt < 4; ++dt) {
        const bf16_t* vp = Vc + (size_t)(dt * 32 + n) * 256 + kt * 32 + hi * 8;
        bf16x8 v0 = *(const bf16x8*)vp, v1 = *(const bf16x8*)(vp + 16);
        o[dt] = __builtin_amdgcn_mfma_f32_32x32x16_bf16(v0, pb0, o[dt], 0, 0, 0);
        o[dt] = __builtin_amdgcn_mfma_f32_32x32x16_bf16(v1, pb1, o[dt], 0, 0, 0);
      }
    }
    const float gt = p.gates[m * 48 + head * 3 + 0];
#pragma unroll
    for (int dt = 0; dt < 4; ++dt)
#pragma unroll
      for (int a = 0; a < 4; ++a) {
        u32x2 wv = {cvtpk(o[dt][4 * a] * gt, o[dt][4 * a + 1] * gt), cvtpk(o[dt][4 * a + 2] * gt, o[dt][4 * a + 3] * gt)};
        *(u32x2*)(p.ocmp + m * DM + head * 128 + dt * 32 + 8 * a + 4 * hi) = wv;
      }
  }
  __syncthreads();
  {
    const int qq = 16 * w + (lane >> 2), part = lane & 3;
    const int cur = qb;
    unsigned lo, hi32;
    if (cur < 16) { lo = (2u << cur) - 1u; hi32 = 0u; }
    else {
      float* rowp = impM + qq * 68; const float* rows = impS + qq * 68;
      for (int e = 0; e < 16; ++e) { const int j = part * 16 + e; rowp[j] = rowp[j] + rows[j]; }
      __builtin_amdgcn_fence(__ATOMIC_RELEASE, "wavefront");
      __builtin_amdgcn_wave_barrier();
      float vj[16]; int rank[16];
#pragma unroll
      for (int e = 0; e < 16; ++e) { vj[e] = rowp[part * 16 + e]; rank[e] = 0; }
      for (int j2 = 1; j2 <= cur - 2; ++j2) {
        const float v2 = rowp[j2];
#pragma unroll
        for (int e = 0; e < 16; ++e) { const int j = part * 16 + e; rank[e] += (v2 > vj[e] || (v2 == vj[e] && j2 < j)) ? 1 : 0; }
      }
      unsigned bits = 0;
#pragma unroll
      for (int e = 0; e < 16; ++e) { const int j = part * 16 + e; if (j >= 1 && j <= cur - 2 && rank[e] < 13) bits |= 1u << e; }
      const int base = lane & ~3;
      const unsigned b0 = __shfl(bits, base), b1 = __shfl(bits, base + 1), b2 = __shfl(bits, base + 2), b3 = __shfl(bits, base + 3);
      lo = b0 | (b1 << 16); hi32 = b2 | (b3 << 16);
      lo |= 1u;
      { const int j = cur - 1; if (j < 32) lo |= 1u << j; else hi32 |= 1u << (j - 32); }
      { const int j = cur; if (j < 32) lo |= 1u << j; else hi32 |= 1u << (j - 32); }
    }
    if (part == 0) {
      unsigned* sp = p.selmask + ((size_t)bg * TSEQ + qb * 64 + qq) * 2;
      sp[0] = lo; sp[1] = hi32;
    }
  }
  __syncthreads();
}

template <int BR>
__device__ __forceinline__ void attn_pass(const P& p, const int b, const int g, const int qb, const int head, const int tq, const bf16x8* qf,
                                          unsigned long long tiles, const unsigned long long mysel, char* lds) {
  const int tid = threadIdx.x, lane = tid & 63;
  const int kl = lane & 31, hi = lane >> 5;
  const int bg = b * 4 + g;
  const bf16_t* Kg = (BR == 0 ? p.kw : p.ks) + (size_t)bg * TSEQ * 128;
  const bf16_t* Vg = (BR == 0 ? p.vwT : p.vsT) + (size_t)bg * 128 * TSEQ;
  const unsigned Wlim = BR == 0 ? 512u : 0x80000000u;
  const float NEG = -__builtin_inff();
  f32x16 o[4];
#pragma unroll
  for (int dt = 0; dt < 4; ++dt) for (int r = 0; r < 16; ++r) o[dt][r] = 0.f;
  float mx = -1e30f, l = 0.f;
  bf16x8 sk[4], sv[4];
  auto load_tile = [&](int j) {
#pragma unroll
    for (int i = 0; i < 4; ++i) {
      const int id = tid + 256 * i;
      sk[i] = *(const bf16x8*)(Kg + (size_t)(j * 64 + (id >> 4)) * 128 + (id & 15) * 8);
      sv[i] = *(const bf16x8*)(Vg + (size_t)(id >> 3) * TSEQ + j * 64 + (id & 7) * 8);
    }
  };
  auto store_tile = [&](int buf) {
    char* Kb = lds + buf * ATT_BUF; char* Vb = Kb + ATT_KSZ;
#pragma unroll
    for (int i = 0; i < 4; ++i) {
      const int id = tid + 256 * i;
      { const int row = id >> 4, c16 = id & 15; *(bf16x8*)(Kb + row * 272 + (c16 << 4)) = sk[i]; }
      { const int d = id >> 3, cx = id & 7; *(bf16x8*)(Vb + d * 144 + (cx << 4)) = sv[i]; }
    }
  };
  int j = __builtin_ctzll(tiles); tiles &= tiles - 1;
  load_tile(j);
  store_tile(0);
  __syncthreads();
  int buf = 0;
  while (true) {
    const bool more = tiles != 0ull;
    int jn = 0;
    if (more) { jn = __builtin_ctzll(tiles); tiles &= tiles - 1; load_tile(jn); }
    {
      const char* Kb = lds + buf * ATT_BUF + kl * 272 + hi * 16; const char* Vb = lds + buf * ATT_BUF + ATT_KSZ + kl * 144 + hi * 16;
      const bool lane_ok = BR == 0 ? true : ((mysel >> j) & 1ull) != 0ull;
      const bool wave_any = __any(lane_ok);
      const bool boundary = BR == 0 ? (j == qb || j + 8 == qb) : (j == qb);
      if (wave_any) {
#pragma unroll
        for (int hs = 0; hs < 2; ++hs) {
          f32x16 sc; for (int r = 0; r < 16; ++r) sc[r] = 0.f;
#pragma unroll
          for (int d0 = 0; d0 < 8; ++d0) {
            bf16x8 kf = *(const bf16x8*)(Kb + hs * 32 * 272 + d0 * 32);
            sc = __builtin_amdgcn_mfma_f32_32x32x16_bf16(kf, qf[d0], sc, 0, 0, 0);
          }
          if (boundary) {
            const int dq = tq - (j * 64 + hs * 32 + 4 * hi);
#pragma unroll
            for (int r = 0; r < 16; ++r) { const int cidx = (r & 3) + 8 * (r >> 2); if ((unsigned)(dq - cidx) >= Wlim) sc[r] = NEG; }
          }
          if (BR == 1) {
#pragma unroll
            for (int r = 0; r < 16; ++r) sc[r] = lane_ok ? sc[r] : NEG;
          }
          float tm = sc[0];
#pragma unroll
          for (int r = 1; r < 16; ++r) tm = fmaxf(tm, sc[r]);
          tm = swap32_max(tm);
          if (!__all(tm <= mx + 8.f)) {
            const float mn = fmaxf(mx, tm);
            const float alpha = __builtin_amdgcn_exp2f(mx - mn);
            l *= alpha; mx = mn;
#pragma unroll
            for (int dt = 0; dt < 4; ++dt)
#pragma unroll
              for (int r = 0; r < 16; ++r) o[dt][r] *= alpha;
          }
          float pr[16]; float ps = 0.f;
#pragma unroll
          for (int r = 0; r < 16; ++r) { pr[r] = __builtin_amdgcn_exp2f(sc[r] - mx); ps += pr[r]; }
          ps = swap32_sum(ps);
          l += ps;
          const float pf0[8] = {pr[0], pr[1], pr[2], pr[3], pr[4], pr[5], pr[6], pr[7]};
          const float pf1[8] = {pr[8], pr[9], pr[10], pr[11], pr[12], pr[13], pr[14], pr[15]};
          const bf16x8 pb0 = pack8f(pf0), pb1 = pack8f(pf1);
#pragma unroll
          for (int dt = 0; dt < 4; ++dt) {
            bf16x8 v0 = *(const bf16x8*)(Vb + dt * 32 * 144 + hs * 64);
            bf16x8 v1 = *(const bf16x8*)(Vb + dt * 32 * 144 + hs * 64 + 32);
            o[dt] = __builtin_amdgcn_mfma_f32_32x32x16_bf16(v0, pb0, o[dt], 0, 0, 0);
            o[dt] = __builtin_amdgcn_mfma_f32_32x32x16_bf16(v1, pb1, o[dt], 0, 0, 0);
          }
        }
      }
    }
    if (more) store_tile(buf ^ 1);
    __syncthreads();
    if (!more) break;
    j = jn; buf ^= 1;
  }
  const size_t m = (size_t)b * TSEQ + tq;
  const float gt = p.gates[m * 48 + head * 3 + (BR == 0 ? 2 : 1)];
  const float sc_ = gt / l;
  if (BR == 0) {
#pragma unroll
    for (int dt = 0; dt < 4; ++dt)
#pragma unroll
      for (int a = 0; a < 4; ++a) {
        const size_t idx = m * DM + head * 128 + dt * 32 + 8 * a + 4 * hi;
        *(u32x2*)(p.ubuf + idx) = u32x2{cvtpk(o[dt][4 * a] * sc_, o[dt][4 * a + 1] * sc_), cvtpk(o[dt][4 * a + 2] * sc_, o[dt][4 * a + 3] * sc_)};
      }
  } else {
#pragma unroll
    for (int dt = 0; dt < 4; ++dt)
#pragma unroll
      for (int a = 0; a < 4; ++a) {
        const size_t idx = m * DM + head * 128 + dt * 32 + 8 * a + 4 * hi;
        const u32x2 oc = *(const u32x2*)(p.ocmp + idx);
        const u32x2 zz = *(const u32x2*)(p.sz + idx);
        const u32x2 ww = *(const u32x2*)(p.ubuf + idx);
        const float y0 = (o[dt][4 * a] * sc_ + bflo(ww[0]) + bflo(oc[0])) * bflo(zz[0]);
        const float y1 = (o[dt][4 * a + 1] * sc_ + bfhi(ww[0]) + bfhi(oc[0])) * bfhi(zz[0]);
        const float y2 = (o[dt][4 * a + 2] * sc_ + bflo(ww[1]) + bflo(oc[1])) * bflo(zz[1]);
        const float y3 = (o[dt][4 * a + 3] * sc_ + bfhi(ww[1]) + bfhi(oc[1])) * bfhi(zz[1]);
        *(u32x2*)(p.ubuf + idx) = u32x2{cvtpk(y0, y1), cvtpk(y2, y3)};
      }
  }
}

__device__ __forceinline__ void attn_item(const P& p, const int item, char* lds, unsigned long long* uni) {
  const int half = item & 1, g = (item >> 1) & 3, b = (item >> 3) & 3, qb = 63 - (item >> 5);
  const int tid = threadIdx.x, lane = tid & 63, w = tid >> 6;
  const int kl = lane & 31, hi = lane >> 5;
  const int head = g * 4 + half * 2 + (w >> 1);
  const int tq = qb * 64 + (w & 1) * 32 + kl;
  const size_t m = (size_t)b * TSEQ + tq;
  bf16x8 qf[8];
#pragma unroll
  for (int d0 = 0; d0 < 8; ++d0) qf[d0] = *(const bf16x8*)(p.q + m * DM + head * 128 + d0 * 16 + hi * 8);
  const unsigned* sp = p.selmask + ((size_t)(b * 4 + g) * TSEQ + tq) * 2;
  const unsigned long long mysel = (unsigned long long)sp[0] | ((unsigned long long)sp[1] << 32);
  unsigned long long u = mysel;
#pragma unroll
  for (int o = 16; o >= 1; o >>= 1) { u |= (unsigned long long)__shfl_xor((unsigned)u, o) | ((unsigned long long)__shfl_xor((unsigned)(u >> 32), o) << 32); }
  if (lane == 0) uni[w] = u;
  __syncthreads();
  const unsigned long long U = (uni[0] | uni[1] | uni[2] | uni[3]) & (qb == 63 ? ~0ull : ((2ull << qb) - 1ull));
  const int jlo = qb >= 8 ? qb - 8 : 0;
  const unsigned long long wt = (qb == 63 ? ~0ull : ((2ull << qb) - 1ull)) & ~((1ull << jlo) - 1ull);
  attn_pass<0>(p, b, g, qb, head, tq, qf, wt, mysel, lds);
  attn_pass<1>(p, b, g, qb, head, tq, qf, U, mysel, lds);
}

typedef __attribute__((address_space(1))) unsigned gunsigned;
__device__ __forceinline__ unsigned gb_ld(unsigned* p) { return __hip_atomic_load((gunsigned*)p, __ATOMIC_RELAXED, __HIP_MEMORY_SCOPE_AGENT); }
__device__ __forceinline__ unsigned gb_add(unsigned* p, unsigned v) { return __hip_atomic_fetch_add((gunsigned*)p, v, __ATOMIC_RELAXED, __HIP_MEMORY_SCOPE_AGENT); }
__device__ __forceinline__ void grid_barrier(unsigned* bar, const unsigned e) {
  __builtin_amdgcn_fence(__ATOMIC_RELEASE, "workgroup");
  __builtin_amdgcn_s_waitcnt(0);
  __syncthreads();
  if (threadIdx.x == 0) {
    const unsigned G = gridDim.x, g = blockIdx.x & 7u;
    const unsigned ngrp = G < 8u ? G : 8u, nloc = (G + 7u - g) >> 3;
    __builtin_amdgcn_fence(__ATOMIC_RELEASE, "agent");
    __builtin_amdgcn_s_waitcnt(0);
    const unsigned old = gb_add(&bar[64u * (1u + g)], 1u);
    if (old + 1u == (e + 1u) * nloc) {
      const unsigned og = gb_add(&bar[0], 1u);
      if (og + 1u == (e + 1u) * ngrp) gb_add(&bar[64u * 20u], 1u);
      else { unsigned sp = 0; while (gb_ld(&bar[64u * 20u]) <= e && ++sp < (1u << 24)) __builtin_amdgcn_s_sleep(1); }
      gb_add(&bar[64u * (10u + g)], 1u);
    } else {
      unsigned sp = 0; while (gb_ld(&bar[64u * (10u + g)]) <= e && ++sp < (1u << 24)) __builtin_amdgcn_s_sleep(1);
    }
    __builtin_amdgcn_fence(__ATOMIC_ACQUIRE, "agent");
    __builtin_amdgcn_s_waitcnt(0);
  }
  __syncthreads();
}

#define NPHASE 23
#ifndef GRP
#define GRP 0xFFFF
#endif
#define EN(b) ((GRP >> (b)) & 1)
#ifndef DUPMASK
#define DUPMASK 0
#endif
#define PHASE(n, en, ...) if (ph_lo <= (n) && (n) < ph_hi) { if (EN(en)) { __VA_ARGS__ if ((DUPMASK >> (n)) & 1) { __syncthreads(); __VA_ARGS__ } } if ((n) + 1 < ph_hi) { if ((n) == 0) cg::this_grid().sync(); else grid_barrier(bar, (unsigned)((n) - 1)); } }

__device__ __forceinline__ bool deal_tile(int r, int NT, int& mt, int& nt) {
  const int G = gridDim.x, bid = blockIdx.x;
  if (G == 512) {
    const int x = bid & 7, lb = bid >> 3;
    const int NG = NT >> 3, rem = NT & 7;
    if (r < 2 * NG) { mt = 16 * x + (r & 1) * 8 + (lb >> 3); nt = (r >> 1) * 8 + (lb & 7); return true; }
    const int idx = (r - 2 * NG) * 64 + lb;
    if (idx < 16 * rem) { mt = 16 * x + idx / rem; nt = NG * 8 + idx % rem; return true; }
    return false;
  }
  const int t = bid + r * G;
  if (t < 128 * NT) { mt = t / NT; nt = t % NT; return true; }
  return false;
}
__device__ __forceinline__ int deal_rounds(int NT) {
  const int G = gridDim.x;
  if (G == 512) return 2 * (NT >> 3) + (16 * (NT & 7) + 63) / 64;
  return (128 * NT + G - 1) / G;
}
__device__ __forceinline__ void ph_proj(const P& p, int layer, char* lds) {
  {
    const int nr = deal_rounds(32);
    for (int r = 0; r < nr; ++r) {
      int mt, nt2;
      if (!deal_tile(r, 32, mt, nt2)) continue;
      GemmCtx cw; cw.A = p.ubuf; cw.lda = DM; cw.K = DM; cw.layer = layer; cw.j = 0; cw.Bt = p.Wp;
      cw.aux = p.a_mu + (size_t)(layer * 6 + (nt2 >> 3)) * DM;
      gemm_wide<AL_MIX, EP_PROJ>(p, cw, mt, nt2, lds);
    }
  }
  const int NL = layer == 0 ? 2 : 3;
  GemmCtx c; c.A = p.ubuf; c.lda = DM; c.K = DM; c.layer = layer; c.j = 0; c.Bt = p.Wp;
  const int nr = deal_rounds(NL);
  for (int r = 0; r < nr; ++r) {
    int mt, ntl;
    if (!deal_tile(r, NL, mt, ntl)) continue;
    const int nt = 64 + ntl;
    const int mui = nt == 64 ? 4 : nt == 65 ? 5 : 2;
    c.aux = p.a_mu + (size_t)(layer * 6 + mui) * DM;
    gemm_tile<AL_MIX, EP_PROJ>(p, c, mt, nt, lds);
  }
}
__device__ __forceinline__ void ph_wo(const P& p, int layer, const bf16_t* Wt, char* lds) {
  GemmCtx c; c.A = p.ubuf; c.lda = DM; c.Bt = Wt; c.K = DM; c.layer = layer; c.j = 0; c.aux = nullptr;
  const int nr = deal_rounds(8);
  for (int r = 0; r < nr; ++r) {
    int mt, nt2;
    if (!deal_tile(r, 8, mt, nt2)) continue;
    gemm_wide<AL_PLAIN, EP_RESID>(p, c, mt, nt2, lds);
  }
}
__device__ __forceinline__ void ph_kvwin(const P& p, int jl, int NTK, char* lds) {
  const int NK2 = NTK >> 1, NT2 = NK2 + 16;
  {
    const int nr = deal_rounds(NT2);
    for (int r = 0; r < nr; ++r) {
      int mt, nt2;
      if (!deal_tile(r, NT2, mt, nt2)) continue;
      GemmCtx c; c.lda = DM; c.K = DM; c.layer = 1; c.j = jl; c.aux = nullptr;
      if (nt2 < NK2) { c.A = p.hn; c.Bt = p.Wkv; gemm_wide<AL_PLAIN, EP_KV>(p, c, mt, nt2, lds); }
      else { c.A = p.ubuf; c.Bt = p.Win; gemm_wide<AL_PLAIN, EP_WIN>(p, c, mt, nt2 - NK2, lds); }
    }
  }
  if (jl != 0) {
    GemmCtx c; c.lda = DM; c.K = DM; c.layer = 1; c.j = jl; c.aux = nullptr; c.A = p.ubuf; c.Bt = p.Win;
    const int nr = deal_rounds(1);
    for (int r = 0; r < nr; ++r) {
      int mt, ntl;
      if (!deal_tile(r, 1, mt, ntl)) continue;
      gemm_tile<AL_PLAIN, EP_WIN>(p, c, mt, 32, lds);
    }
  }
}
__device__ __forceinline__ void ph_attn(const P& p, char* lds, unsigned long long* uni) {
  const int G = gridDim.x, bid = blockIdx.x;
  int rnd = 0;
  for (int base = 0; base < 2048; base += G, ++rnd) {
    const int idx = base + ((rnd & 1) ? (G - 1 - bid) : bid);
    if (idx < 2048) attn_item(p, idx, lds, uni);
    __syncthreads();
  }
}

__global__ void __launch_bounds__(NTHREADS, 2) fwd_kernel(const P p, const PJ pj, unsigned* bar, const int ph_lo, const int ph_hi) {
  __shared__ __attribute__((aligned(16))) char lds[LDS_BYTES];
  __shared__ unsigned long long uni[4];
  const int G = gridDim.x, bid = blockIdx.x;
  PHASE(0, 0, norm_phase<0, 0>(p, pj, false, p.a_norm_g, p.ubuf, nullptr, nullptr, nullptr, lds);)
  PHASE(1, 1, ph_proj(p, 0, lds);)
  PHASE(2, 2, for (int it = bid; it < 512; it += G) scan_item(p, 0, it, lds);)
  PHASE(3, 3, postscan_phase(p, 0);)
  PHASE(4, 4, ph_wo(p, 0, p.Wo, lds);)
  PHASE(5, 0, norm_phase<0, 1>(p, pj, true, p.a_norm_g + DM, p.ubuf, nullptr, nullptr, nullptr, lds);)
  PHASE(6, 1, ph_proj(p, 1, lds);)
  PHASE(7, 2, for (int it = bid; it < 512; it += G) scan_item(p, 1, it, lds);)
  PHASE(8, 3, postscan_phase(p, 1);)
  PHASE(9, 4, ph_wo(p, 1, p.Wo, lds);)
  PHASE(10, 0, norm_phase<1, 2>(p, pj, true, p.kv_norm_g, p.hn, p.b_norm_g, p.ubuf, nullptr, lds);)
  PHASE(11, 5, ph_kvwin(p, 0, 24, lds);)
  PHASE(12, 6,
    for (int t = bid; t < 256; t += G) {
      if (t >= 128) {
        GemmCtx cg; cg.lda = DM; cg.K = DM; cg.layer = 1; cg.j = 0; cg.aux = nullptr; cg.A = p.ubuf; cg.Bt = p.Win;
        gemm_tile<AL_PLAIN, EP_WIN>(p, cg, t - 128, 32, lds);
        continue;
      }
      const int j = t >> 6, r = t & 63, mt = r >> 1, nt = r & 1;
      GemmCtx c; c.A = p.kc + (size_t)j * (8u << 20); c.lda = 0; c.Bt = p.Wc1 + (size_t)j * 256 * 4096; c.K = 4096; c.layer = 0; c.j = j;
      c.aux = p.cmp_pe + (size_t)j * 32 * 128;
      gemm_tile<AL_CMP, EP_CMP1>(p, c, mt, nt, lds);
    })
  PHASE(13, 7,
    for (int t = bid; t < 64; t += G) {
      const int j = t >> 5, mt = t & 31;
      GemmCtx c; c.A = p.hc + (size_t)j * 4096 * 256; c.lda = 256; c.Bt = p.Wc2 + (size_t)j * 128 * 256; c.K = 256; c.layer = 0; c.j = j; c.aux = nullptr;
      gemm_tile<AL_PLAIN, EP_CMP2>(p, c, mt, 0, lds);
    })
  PHASE(14, 8, for (int t = bid; t < 1024; t += G) cmp_item(p, t, lds);)
  PHASE(15, 9, ph_attn(p, lds, uni);)
  PHASE(16, 4, ph_wo(p, 1, p.Wob, lds);)
  PHASE(17, 0, norm_phase<0, 3>(p, pj, true, p.b_norm_g + DM, p.ubuf, nullptr, nullptr, nullptr, lds);)
  PHASE(18, 5, ph_kvwin(p, 1, 0, lds);)
  PHASE(19, 8, for (int t = bid; t < 1024; t += G) cmp_item(p, t, lds);)
  PHASE(20, 9, ph_attn(p, lds, uni);)
  PHASE(21, 4, ph_wo(p, 1, p.Wob, lds);)
  PHASE(22, 0, norm_phase<2, -1>(p, pj, true, p.final_g, nullptr, nullptr, nullptr, p.out, lds);)
}

static inline size_t MiB(double x) { return (size_t)(x * 1048576.0); }

extern "C" void kernel_launch(void* const* d_in, const int* in_sizes, int n_in, void* d_out, int out_size, void* d_ws, size_t ws_size, hipStream_t stream) {
  (void)in_sizes; (void)n_in; (void)out_size;
  P p; memset(&p, 0, sizeof(P));
  PJ pj; memset(&pj, 0, sizeof(PJ));
  const float* const* in = (const float* const*)d_in;
  p.x = in[0]; p.a_norm_g = in[1]; p.a_mu = in[2];
  const float* a_w_rkvz = in[3];
  p.a_w0 = in[4]; const float* a_w1 = in[5]; const float* a_w2 = in[6];
  p.a_a0 = in[7]; const float* a_a1 = in[8]; const float* a_a2 = in[9];
  p.a_v0 = in[10]; const float* a_v1 = in[11]; const float* a_v2 = in[12];
  p.a_k_k = in[13]; p.a_k_a = in[14]; p.a_r_k = in[15]; p.a_ln_g = in[16]; p.a_ln_b = in[17];
  const float* a_w_o = in[18];
  p.kv_norm_g = in[19]; const float* kv_w = in[20]; p.cmp_pe = in[21]; const float* cmp_w1 = in[22]; const float* cmp_w2 = in[23];
  p.b_norm_g = in[24]; const float* b_w_in = in[25]; p.b_gate_b = in[26]; const float* b_w_o = in[27]; p.final_g = in[28];
  p.out = (float*)d_out;
  if (ws_size < MiB(512)) { fprintf(stderr, "workspace too small: %zu\n", ws_size); return; }
  char* ws = (char*)d_ws;
  p.ysum = (bf16_t*)(ws + MiB(0)); p.ubuf = (bf16_t*)(ws + MiB(64)); p.r = (bf16_t*)(ws + MiB(128)); p.k = (bf16_t*)(ws + MiB(192));
  p.vA = (bf16_t*)(ws + MiB(256)); p.z = (bf16_t*)(ws + MiB(320)); p.vB = (bf16_t*)(ws + MiB(384));
  p.hn = (bf16_t*)(ws + MiB(128)); p.ocmp = p.hn; p.q = (bf16_t*)(ws + MiB(192)); p.sz = (bf16_t*)(ws + MiB(256));
  p.kc = (bf16_t*)(ws + MiB(320)); p.vc = (bf16_t*)(ws + MiB(336)); p.ks = (bf16_t*)(ws + MiB(352)); p.vsT = (bf16_t*)(ws + MiB(368));
  p.kw = (bf16_t*)(ws + MiB(384)); p.vwT = (bf16_t*)(ws + MiB(400));
  p.hc = (bf16_t*)(ws + MiB(416)); p.kcmp = (bf16_t*)(ws + MiB(420)); p.vcmpT = (bf16_t*)(ws + MiB(421));
  p.gates = (float*)(ws + MiB(422)); p.selmask = (unsigned*)(ws + MiB(425));
  char* ar = ws + MiB(448);
  p.Wp = (bf16_t*)ar;
  p.W2w = (bf16_t*)(ar + MiB(33.5)); p.W2a = (bf16_t*)(ar + MiB(34)); p.W2v = (bf16_t*)(ar + MiB(34.5));
  p.Wo = (bf16_t*)(ar + MiB(35));
  p.Wkv = (bf16_t*)ar;
  p.Win = (bf16_t*)(ar + MiB(12));
  p.Wc1 = (bf16_t*)(ar + MiB(28.5));
  p.Wc2 = (bf16_t*)(ar + MiB(32.5));
  p.Wob = (bf16_t*)(ar + MiB(33));
  p.lw = (bf16_t*)(ws + MiB(492)); p.la = (bf16_t*)(ws + MiB(496)); p.lv = (bf16_t*)(ws + MiB(500));
  unsigned* bar = (unsigned*)(ws + MiB(508));
  p.bon = (float*)(ws + MiB(504)); p.ropec = (float*)(ws + MiB(506)); p.ropes = (float*)(ws + MiB(506.5));

  int nj = 0, tile = 0;
  auto add = [&](const float* src, bf16_t* dst, int K, int N, int ld, int Kpad, int Npad) {
    ConvJob& j = pj.jobs[nj++]; j.src = src; j.dst = dst; j.K = K; j.N = N; j.ld = ld; j.Kpad = Kpad; j.Npad = Npad; j.tile0 = tile;
    tile += (Kpad / 64) * (Npad / 64);
  };
  const size_t DD = (size_t)DM * DM;
  for (int L = 0; L < 2; ++L) {
    tile = 0;
    for (int n4 = 0; n4 < 4; ++n4) add(a_w_rkvz + (size_t)(L * 4 + n4) * DD, p.Wp + (size_t)n4 * DD, DM, DM, DM, DM, DM);
    add(a_w1 + (size_t)L * DM * 96, p.Wp + (size_t)8192 * DM, DM, 96, 96, DM, 128);
    add(a_a1 + (size_t)L * DM * 96, p.Wp + (size_t)8320 * DM, DM, 96, 96, DM, 128);
    if (L == 1) add(a_v1, p.Wp + (size_t)8448 * DM, DM, 64, 64, DM, 128);
    add(a_w2 + (size_t)L * 96 * DM, p.W2w, 96, DM, DM, 128, DM);
    add(a_a2 + (size_t)L * 96 * DM, p.W2a, 96, DM, DM, 128, DM);
    if (L == 1) add(a_v2, p.W2v, 64, DM, DM, 128, DM);
    add(a_w_o + (size_t)L * DD, p.Wo, DM, DM, DM, DM, DM);
    pj.stage_tiles[L] = tile;
  }
  tile = 0;
  add(kv_w, p.Wkv, DM, 3072, 3072, DM, 3072);
  for (int j = 0; j < 2; ++j) add(cmp_w1 + (size_t)j * 4096 * 256, p.Wc1 + (size_t)j * 256 * 4096, 4096, 256, 256, 4096, 256);
  for (int j = 0; j < 2; ++j) add(cmp_w2 + (size_t)j * 256 * 128, p.Wc2 + (size_t)j * 128 * 256, 256, 128, 128, 256, 128);
  for (int L = 0; L < 2; ++L) {
    if (L == 1) { pj.stage_tiles[2] = tile; tile = 0; }
    const float* wi = b_w_in + (size_t)L * DM * 4144;
    add(wi, p.Win, DM, 2048, 4144, DM, 2048);
    add(wi + 2096, p.Win + (size_t)2048 * DM, DM, 2048, 4144, DM, 2048);
    add(wi + 2048, p.Win + (size_t)4096 * DM, DM, 48, 4144, DM, 128);
    add(b_w_o + (size_t)L * DD, p.Wob, DM, DM, DM, DM, DM);
  }
  pj.stage_tiles[3] = tile;
  for (int i = 0; i < 16; ++i) pj.rope_inv[i] = (float)pow(500000.0, -(double)i / 16.0);

  static int grid_blocks = 0;
  if (!grid_blocks) {
    int dev = 0, cus = 0, per_cu = 0;
    hipGetDevice(&dev);
    hipDeviceGetAttribute(&cus, hipDeviceAttributeMultiprocessorCount, dev);
    hipOccupancyMaxActiveBlocksPerMultiprocessor(&per_cu, fwd_kernel, NTHREADS, 0);
    if (per_cu > 2) per_cu = 2;
    if (per_cu < 1) per_cu = 1;
    grid_blocks = cus * per_cu;
  }
#if ONE_LAUNCH
  hipMemsetAsync(bar, 0, 64 * 32 * 4, stream);
  int lo = 0, hi = NPHASE;
  void* args[] = {(void*)&p, (void*)&pj, (void*)&bar, (void*)&lo, (void*)&hi};
  hipError_t e = hipLaunchCooperativeKernel((void*)fwd_kernel, dim3(grid_blocks), dim3(NTHREADS), args, 0, stream);
  if (e != hipSuccess) fprintf(stderr, "cooperative launch failed: %s (grid %d)\n", hipGetErrorString(e), grid_blocks);
#else
  for (int ph = 0; ph < NPHASE; ++ph) {
    hipLaunchKernelGGL(fwd_kernel, dim3(grid_blocks), dim3(NTHREADS), 0, stream, p, pj, bar, ph, ph + 1);
  }

#endif
}
```

```cpp
#include <hip/hip_runtime.h>
#include <hip/hip_cooperative_groups.h>
#include <cstdio>
#include <cstdint>
#include <cstring>
#include <cmath>
namespace cg = cooperative_groups;

#ifndef ONE_LAUNCH
#define ONE_LAUNCH 1
#endif

typedef unsigned short bf16_t;
typedef short bf16x8 __attribute__((ext_vector_type(8)));
typedef float f32x4 __attribute__((ext_vector_type(4)));
typedef float f32x16 __attribute__((ext_vector_type(16)));
typedef unsigned u32x4 __attribute__((ext_vector_type(4)));
typedef unsigned u32x2 __attribute__((ext_vector_type(2)));

#define MTOK 16384
#define TSEQ 4096
#define DM 2048
#define NTHREADS 256
#define QSCALE 0.12751743f
#define ATT_KSZ 17408
#define ATT_BUF 35840
#define LDS_BYTES 71680

struct ConvJob { const float* src; bf16_t* dst; int K, N, ld, Kpad, Npad, tile0; };

struct P {
  const float *x, *a_norm_g, *a_mu, *a_w0, *a_a0, *a_v0, *a_k_k, *a_k_a, *a_r_k, *a_ln_g, *a_ln_b;
  const float *kv_norm_g, *cmp_pe, *b_norm_g, *b_gate_b, *final_g;
  float* out;
  bf16_t *ysum, *ubuf, *r, *k, *vA, *z, *vB;
  bf16_t *lw, *la, *lv; float *bon; float *ropec, *ropes;
  bf16_t *Wp, *W2w, *W2a, *W2v, *Wo;
  bf16_t *Wkv, *Win, *Wc1, *Wc2, *Wob;
  bf16_t *hn, *q, *sz, *ocmp;
  bf16_t *kc, *vc, *ks, *vsT, *kw, *vwT, *hc, *kcmp, *vcmpT;
  float *gates; unsigned *selmask;
};
struct PJ {
  ConvJob jobs[33];
  float rope_inv[16];
  int stage_tiles[4];
};

typedef __bf16 bf16x2_t __attribute__((ext_vector_type(2)));
typedef float f32x2 __attribute__((ext_vector_type(2)));
__device__ __forceinline__ unsigned cvtpk(float lo, float hi) {
  f32x2 v = {lo, hi};
  bf16x2_t b = __builtin_convertvector(v, bf16x2_t);
  return __builtin_bit_cast(unsigned, b);
}
__device__ __forceinline__ bf16_t f2bf(float x) { return (bf16_t)(cvtpk(x, x) & 0xffffu); }
__device__ __forceinline__ float bflo(unsigned w) { return __uint_as_float(w << 16); }
__device__ __forceinline__ float bfhi(unsigned w) { return __uint_as_float(w & 0xffff0000u); }
__device__ __forceinline__ float bf2f(bf16_t v) { return __uint_as_float(((unsigned)v) << 16); }
__device__ __forceinline__ void unpack8(bf16x8 v, float* f) {
  u32x4 w = *reinterpret_cast<u32x4*>(&v);
#pragma unroll
  for (int i = 0; i < 4; ++i) { f[2 * i] = bflo(w[i]); f[2 * i + 1] = bfhi(w[i]); }
}
__device__ __forceinline__ bf16x8 pack8f(const float* f) {
  u32x4 w = {cvtpk(f[0], f[1]), cvtpk(f[2], f[3]), cvtpk(f[4], f[5]), cvtpk(f[6], f[7])};
  return *reinterpret_cast<bf16x8*>(&w);
}
__device__ __forceinline__ float sigmoidf_(float x) { return __builtin_amdgcn_rcpf(1.f + __expf(-x)); }
__device__ __forceinline__ float siluf_(float x) { return x * __builtin_amdgcn_rcpf(1.f + __expf(-x)); }
#define DPP(x, ctrl) __int_as_float(__builtin_amdgcn_mov_dpp(__float_as_int(x), ctrl, 0xF, 0xF, true))
__device__ __forceinline__ float sum8(float x) {
  x += DPP(x, 0xB1); x += DPP(x, 0x4E); x += DPP(x, 0x141); return x;
}
__device__ __forceinline__ float wave_sum(float x) {
#pragma unroll
  for (int o = 32; o >= 1; o >>= 1) x += __shfl_xor(x, o);
  return x;
}
__device__ __forceinline__ float swap32_max(float x) {
  auto rr = __builtin_amdgcn_permlane32_swap(__float_as_uint(x), __float_as_uint(x), false, false);
  return fmaxf(__uint_as_float(rr[0]), __uint_as_float(rr[1]));
}
__device__ __forceinline__ float swap32_sum(float x) {
  auto rr = __builtin_amdgcn_permlane32_swap(__float_as_uint(x), __float_as_uint(x), false, false);
  return __uint_as_float(rr[0]) + __uint_as_float(rr[1]);
}
__device__ __forceinline__ int crow(int r, int hi) { return (r & 3) + 8 * (r >> 2) + 4 * hi; }

__device__ __forceinline__ void conv_tile(const ConvJob& jb, int tile, char* lds) {
  float* T = (float*)lds;
  const int nkt = jb.Kpad >> 6;
  const int n0 = (tile / nkt) * 64, k0 = (tile % nkt) * 64;
  const int tx = threadIdx.x & 63, ty = threadIdx.x >> 6;
#pragma unroll 4
  for (int rr = 0; rr < 16; ++rr) {
    int kl = ty * 16 + rr, kk = k0 + kl, n = n0 + tx;
    float v = (kk < jb.K && n < jb.N) ? jb.src[(size_t)kk * jb.ld + n] : 0.f;
    T[kl * 65 + tx] = v;
  }
  __syncthreads();
  const int nl = threadIdx.x >> 2, kc = (threadIdx.x & 3) * 16;
  unsigned w[8];
#pragma unroll
  for (int i = 0; i < 8; ++i) w[i] = cvtpk(T[(kc + 2 * i) * 65 + nl], T[(kc + 2 * i + 1) * 65 + nl]);
  bf16_t* d = jb.dst + (size_t)(n0 + nl) * jb.Kpad + k0 + kc;
  *(u32x4*)d = u32x4{w[0], w[1], w[2], w[3]};
  *(u32x4*)(d + 8) = u32x4{w[4], w[5], w[6], w[7]};
  __syncthreads();
}

template <int MODE>
__device__ __forceinline__ void rmsnorm_row(const P& p, int row, bool has_y, const float* g1, bf16_t* o1, const float* g2, bf16_t* o2, float* of) {
  const int lane = threadIdx.x & 63;
  const float* xr = p.x + (size_t)row * DM;
  const bf16_t* yr = p.ysum + (size_t)row * DM;
  f32x4 v[8]; float ss = 0.f;
#pragma unroll
  for (int i = 0; i < 8; ++i) {
    int c = (lane + 64 * i) * 4;
    v[i] = *(const f32x4*)(xr + c);
    if (has_y) { u32x2 w = *(const u32x2*)(yr + c); v[i][0] += bflo(w[0]); v[i][1] += bfhi(w[0]); v[i][2] += bflo(w[1]); v[i][3] += bfhi(w[1]); }
    ss += v[i][0] * v[i][0] + v[i][1] * v[i][1] + v[i][2] * v[i][2] + v[i][3] * v[i][3];
  }
  ss = wave_sum(ss);
  const float rs = rsqrtf(ss * (1.f / DM) + 1e-6f);
#pragma unroll
  for (int i = 0; i < 8; ++i) {
    int c = (lane + 64 * i) * 4;
    f32x4 g = *(const f32x4*)(g1 + c);
    if (MODE == 2) {
      f32x4 y = {v[i][0] * rs * g[0], v[i][1] * rs * g[1], v[i][2] * rs * g[2], v[i][3] * rs * g[3]};
      *(f32x4*)(of + (size_t)row * DM + c) = y;
    } else {
      u32x2 w = {cvtpk(v[i][0] * rs * g[0], v[i][1] * rs * g[1]), cvtpk(v[i][2] * rs * g[2], v[i][3] * rs * g[3])};
      *(u32x2*)(o1 + (size_t)row * DM + c) = w;
      if (MODE == 1) {
        f32x4 gg = *(const f32x4*)(g2 + c);
        u32x2 w2 = {cvtpk(v[i][0] * rs * gg[0], v[i][1] * rs * gg[1]), cvtpk(v[i][2] * rs * gg[2], v[i][3] * rs * gg[3])};
        *(u32x2*)(o2 + (size_t)row * DM + c) = w2;
      }
    }
  }
}

template <int MODE, int STAGE>
__device__ __forceinline__ void norm_phase(const P& p, const PJ& pj, bool has_y, const float* g1, bf16_t* o1, const float* g2, bf16_t* o2, float* of, char* lds) {
  if constexpr (STAGE >= 0) {
    constexpr int J0 = STAGE == 0 ? 0 : STAGE == 1 ? 9 : STAGE == 2 ? 20 : 29;
    constexpr int J1 = STAGE == 0 ? 9 : STAGE == 1 ? 20 : STAGE == 2 ? 29 : 33;
    const int nt = pj.stage_tiles[STAGE];
    for (int t = blockIdx.x; t < nt; t += gridDim.x) {
      const float* jsrc = pj.jobs[J0].src; bf16_t* jdst = pj.jobs[J0].dst;
      int jK = pj.jobs[J0].K, jN = pj.jobs[J0].N, jld = pj.jobs[J0].ld, jKp = pj.jobs[J0].Kpad, jNp = pj.jobs[J0].Npad, jt0 = pj.jobs[J0].tile0;
#pragma unroll
      for (int j = J0 + 1; j < J1; ++j) {
        const bool cnd = t >= pj.jobs[j].tile0;
        jsrc = cnd ? pj.jobs[j].src : jsrc; jdst = cnd ? pj.jobs[j].dst : jdst;
        jK = cnd ? pj.jobs[j].K : jK; jN = cnd ? pj.jobs[j].N : jN; jld = cnd ? pj.jobs[j].ld : jld;
        jKp = cnd ? pj.jobs[j].Kpad : jKp; jNp = cnd ? pj.jobs[j].Npad : jNp; jt0 = cnd ? pj.jobs[j].tile0 : jt0;
      }
      ConvJob jb; jb.src = jsrc; jb.dst = jdst; jb.K = jK; jb.N = jN; jb.ld = jld; jb.Kpad = jKp; jb.Npad = jNp; jb.tile0 = jt0;
      conv_tile(jb, t - jt0, lds);
    }
    if constexpr (STAGE == 0) {
      for (int pos = blockIdx.x * NTHREADS + threadIdx.x; pos < TSEQ; pos += gridDim.x * NTHREADS) {
#pragma unroll
        for (int i = 0; i < 16; ++i) {
          const float ang = (float)pos * pj.rope_inv[i];
          const double a = (double)ang * 0.15915494309189535;
          const float fr = (float)(a - rint(a));
          p.ropec[pos * 16 + i] = __builtin_amdgcn_cosf(fr); p.ropes[pos * 16 + i] = __builtin_amdgcn_sinf(fr);
        }
      }
    }
  }
  const int gw = blockIdx.x * 4 + (threadIdx.x >> 6), nw = gridDim.x * 4;
  for (int row = gw; row < MTOK; row += nw) rmsnorm_row<MODE>(p, row, has_y, g1, o1, g2, o2, of);
}

enum { AL_PLAIN = 0, AL_MIX = 1, AL_CMP = 2 };
enum { EP_PROJ = 0, EP_RESID = 1, EP_KV = 2, EP_CMP1 = 3, EP_CMP2 = 4, EP_WIN = 5 };

struct GemmCtx {
  const bf16_t* A; int lda;
  const bf16_t* Bt; int K;
  const float* aux;
  int layer, j;
};

template <int NI>
__device__ __forceinline__ void store_rows_lds(bf16_t* base, const size_t ld, const int row0, const int cbase, f32x4 (&acc)[4][NI], char* lds, const bool rmw) {
  constexpr int RB = NI * 32 + 16;
  constexpr int CPR = NI * 2;
  const int lane = threadIdx.x & 63, wid = threadIdx.x >> 6, lr = lane & 15, lq = lane >> 4;
  char* W = lds + wid * (64 * RB);
#pragma unroll
  for (int mi = 0; mi < 4; ++mi)
#pragma unroll
    for (int ni = 0; ni < NI; ++ni)
#pragma unroll
      for (int j = 0; j < 4; ++j) *(bf16_t*)(W + (mi * 16 + lq * 4 + j) * RB + (ni * 16 + lr) * 2) = f2bf(acc[mi][ni][j]);
  __builtin_amdgcn_fence(__ATOMIC_RELEASE, "wavefront");
  __builtin_amdgcn_wave_barrier();
#pragma unroll 4
  for (int i = 0; i < CPR; ++i) {
    const int id = lane + 64 * i, row = id / CPR, cc = id % CPR;
    bf16x8 v = *(const bf16x8*)(W + row * RB + cc * 16);
    bf16_t* g = base + (size_t)(row0 + row) * ld + cbase + cc * 8;
    if (rmw) {
      float fa[8], fb[8]; unpack8(v, fa); unpack8(*(const bf16x8*)g, fb);
#pragma unroll
      for (int e = 0; e < 8; ++e) fa[e] += fb[e];
      v = pack8f(fa);
    }
    *(bf16x8*)g = v;
  }
}

template <int EP, int NI>
__device__ __forceinline__ void gemm_epilogue(const P& p, const GemmCtx& c, const int nt, const int m0, const int wr, const int lq, const int lr, const int cbase, f32x4 (&acc)[4][NI], char* lds) {
  const int rbase = m0 + wr * 64 + lq * 4; const int n0 = nt * 128;
  const int cl = cbase + lr;
  if constexpr (EP == EP_PROJ) {
    if (nt < 64) {
      const int which = nt >> 4;
      const int slab = which < 2 ? which : which == 3 ? 3 : (c.layer == 0 ? 2 : 4);
      bf16_t* dst = p.r + (size_t)slab * (32u << 20);
      store_rows_lds<NI>(dst + (nt & 15) * 128, DM, m0 + wr * 64, cbase, acc, lds, false);
    } else {
      bf16_t* dst = p.lw + (size_t)(nt - 64) * (2u << 20);
#pragma unroll
      for (int mi = 0; mi < 4; ++mi)
#pragma unroll
        for (int ni = 0; ni < NI; ++ni)
#pragma unroll
          for (int j = 0; j < 4; ++j) {
            float v = acc[mi][ni][j];
            if (nt == 64) v = 1.f - 2.f * __builtin_amdgcn_rcpf(1.f + __expf(2.f * v));
            dst[(size_t)(rbase + mi * 16 + j) * 128 + cl + ni * 16] = f2bf(v);
          }
    }
  } else if constexpr (EP == EP_RESID) {
    const bool has_y = c.layer != 0;
    store_rows_lds<NI>(p.ysum + n0, DM, m0 + wr * 64, cbase, acc, lds, has_y);
  } else if constexpr (EP == EP_KV || EP == EP_WIN || EP == EP_CMP2) {
    int kind;
    bool rope = false; float qs = 1.f;
    bf16_t* dst = nullptr; int bgidx = 0;
    if constexpr (EP == EP_KV) {
      const int i = nt >> 2, g = nt & 3; bgidx = g;
      kind = (i == 3 || i == 5) ? 1 : 0; rope = (i == 2 || i == 4);
      dst = p.kc + (size_t)i * (8u << 20);
    } else if constexpr (EP == EP_WIN) {
      kind = nt < 16 ? 0 : nt < 32 ? 2 : 3; rope = nt < 16; qs = nt < 16 ? QSCALE : 1.f;
      dst = p.q + (nt < 16 ? (size_t)0 : (size_t)(32u << 20));
    } else {
      kind = c.j == 0 ? 0 : 1; rope = c.j == 0; dst = p.kcmp + (size_t)c.j * (512u << 10);
    }
    if (rope && cbase == 0) {
#pragma unroll
      for (int mi = 0; mi < 4; ++mi)
#pragma unroll
        for (int j = 0; j < 4; ++j) {
          const int row = rbase + mi * 16 + j;
          int pos;
          if constexpr (EP == EP_CMP2) { pos = 16 * (row & 255) + 31; if (pos > TSEQ - 1) pos = TSEQ - 1; } else pos = row & (TSEQ - 1);
          const float cs = p.ropec[pos * 16 + lr], sn = p.ropes[pos * 16 + lr];
          const float x1 = acc[mi][0][j], x2 = acc[mi][1][j];
          acc[mi][0][j] = x1 * cs - x2 * sn; acc[mi][1][j] = x2 * cs + x1 * sn;
        }
    }
    if (kind == 0 || kind == 2) {
      const bool sil = kind == 2;
#pragma unroll
      for (int mi = 0; mi < 4; ++mi)
#pragma unroll
        for (int ni = 0; ni < NI; ++ni)
#pragma unroll
          for (int j = 0; j < 4; ++j) { const float v = acc[mi][ni][j]; acc[mi][ni][j] = sil ? siluf_(v) : v * qs; }
      bf16_t* base; size_t ld;
      if constexpr (EP == EP_KV) {
        const int i = nt >> 2;
        if (i < 2) { base = dst + bgidx * 128; ld = 512; }
        else { const int b = m0 >> 12; base = dst + (size_t)(3 * b + bgidx) * TSEQ * 128; ld = 128; }
      } else if constexpr (EP == EP_WIN) { base = dst + (nt & 15) * 128; ld = DM; }
      else { base = dst; ld = 128; }
      store_rows_lds<NI>(base, ld, m0 + wr * 64, cbase, acc, lds, false);
    } else if (kind == 1) {
#pragma unroll
      for (int mi = 0; mi < 4; ++mi)
#pragma unroll
        for (int ni = 0; ni < NI; ++ni) {
          const int row0 = m0 + wr * 64 + mi * 16;
          const int d = cl + ni * 16;
          const int slot = (lq & 1) * 8 + (lq >> 1) * 4;
          u32x2 w = {cvtpk(acc[mi][ni][0], acc[mi][ni][1]), cvtpk(acc[mi][ni][2], acc[mi][ni][3])};
          size_t idx;
          if constexpr (EP == EP_KV) { const int b = row0 >> 12, t0 = row0 & (TSEQ - 1); idx = ((size_t)((b * 4 + bgidx) * 128 + d)) * TSEQ + t0 + slot; }
          else { const int bg = row0 >> 8, c0 = row0 & 255; idx = ((size_t)(bg * 128 + d)) * 256 + c0 + slot; }
          *(u32x2*)(dst + idx) = w;
        }
    } else {
      const float* gb = p.b_gate_b + c.j * 48;
#pragma unroll
      for (int mi = 0; mi < 4; ++mi)
#pragma unroll
        for (int ni = 0; ni < NI; ++ni) {
          const int n = cl + ni * 16;
          if (n < 48) {
#pragma unroll
            for (int j = 0; j < 4; ++j) p.gates[(size_t)(rbase + mi * 16 + j) * 48 + n] = sigmoidf_(acc[mi][ni][j] + gb[n]);
          }
        }
    }
  } else if constexpr (EP == EP_CMP1) {
    bf16_t* dst = p.hc + (size_t)c.j * 4096 * 256;
#pragma unroll
    for (int mi = 0; mi < 4; ++mi)
#pragma unroll
      for (int ni = 0; ni < NI; ++ni)
#pragma unroll
        for (int j = 0; j < 4; ++j) dst[(size_t)(rbase + mi * 16 + j) * 256 + n0 + cl + ni * 16] = f2bf(siluf_(acc[mi][ni][j]));
  }
  __syncthreads();
}

template <int AL, int EP>
__device__ __forceinline__ void gemm_tile(const P& p, const GemmCtx& c, const int mt, const int nt, char* lds) {
  const int tid = threadIdx.x, lane = tid & 63, wid = tid >> 6;
  const int wr = wid >> 1, wc = wid & 1, lr = lane & 15, lq = lane >> 4;
  const int m0 = mt * 128, n0 = nt * 128;
  const int K = c.K, nk = K >> 6;
  const int lc = tid & 7, lrow = tid >> 3;
  f32x4 acc[4][4];
#pragma unroll
  for (int i = 0; i < 4; ++i)
#pragma unroll
    for (int j = 0; j < 4; ++j) acc[i][j] = f32x4{0.f, 0.f, 0.f, 0.f};
  bf16x8 ra[4], rp[4], rb[4]; f32x4 ax0, ax1;

  auto load_tile = [&](int kt) {
#pragma unroll
    for (int i = 0; i < 4; ++i) {
      const int row = lrow + 32 * i;
      rb[i] = *(const bf16x8*)(c.Bt + (size_t)(n0 + row) * K + kt * 64 + lc * 8);
      if constexpr (AL == AL_PLAIN) {
        ra[i] = *(const bf16x8*)(c.A + (size_t)(m0 + row) * c.lda + kt * 64 + lc * 8);
      } else if constexpr (AL == AL_MIX) {
        const int m = m0 + row;
        const bf16_t* src = c.A + (size_t)m * DM + kt * 64 + lc * 8;
        ra[i] = *(const bf16x8*)src;
        if ((m & (TSEQ - 1)) != 0) rp[i] = *(const bf16x8*)(src - DM); else rp[i] = bf16x8{0, 0, 0, 0, 0, 0, 0, 0};
      } else {
        const int R = m0 + row, bg = R >> 8, cc = R & 255, b = bg >> 2, g = bg & 3;
        const int l = kt >> 1, d = (kt & 1) * 64 + lc * 8;
        int t = 16 * cc + l; if (t > TSEQ - 1) t = TSEQ - 1;
        ra[i] = *(const bf16x8*)(c.A + ((size_t)(b * TSEQ + t)) * 512 + g * 128 + d);
      }
    }
    if constexpr (AL == AL_MIX) { const float* mu = c.aux + kt * 64 + lc * 8; ax0 = *(const f32x4*)mu; ax1 = *(const f32x4*)(mu + 4); }
    if constexpr (AL == AL_CMP) { const float* pe = c.aux + (kt >> 1) * 128 + (kt & 1) * 64 + lc * 8; ax0 = *(const f32x4*)pe; ax1 = *(const f32x4*)(pe + 4); }
  };
  auto store_tile = [&](int buf) {
    char* Ab = lds + buf * 32768; char* Bb = Ab + 16384;
#pragma unroll
    for (int i = 0; i < 4; ++i) {
      const int row = lrow + 32 * i;
      const int off = row * 128 + ((lc ^ (row & 7)) << 4);
      *(bf16x8*)(Bb + off) = rb[i];
      if constexpr (AL == AL_PLAIN) { *(bf16x8*)(Ab + off) = ra[i]; }
      else {
        float f[8]; unpack8(ra[i], f);
        const float mu[8] = {ax0[0], ax0[1], ax0[2], ax0[3], ax1[0], ax1[1], ax1[2], ax1[3]};
        if constexpr (AL == AL_MIX) {
          float fp[8]; unpack8(rp[i], fp);
#pragma unroll
          for (int e = 0; e < 8; ++e) f[e] = f[e] + (fp[e] - f[e]) * mu[e];
        } else {
#pragma unroll
          for (int e = 0; e < 8; ++e) f[e] = f[e] + mu[e];
        }
        *(bf16x8*)(Ab + off) = pack8f(f);
      }
    }
  };
  auto compute = [&](int buf) {
    const char* Ab = lds + buf * 32768; const char* Bb = Ab + 16384;
#pragma unroll
    for (int ks = 0; ks < 2; ++ks) {
      bf16x8 af[4], bfr[4];
#pragma unroll
      for (int mi = 0; mi < 4; ++mi) { const int row = wr * 64 + mi * 16 + lr; af[mi] = *(const bf16x8*)(Ab + row * 128 + (((ks * 4 + lq) ^ (row & 7)) << 4)); }
#pragma unroll
      for (int ni = 0; ni < 4; ++ni) { const int row = wc * 64 + ni * 16 + lr; bfr[ni] = *(const bf16x8*)(Bb + row * 128 + (((ks * 4 + lq) ^ (row & 7)) << 4)); }
#pragma unroll
      for (int mi = 0; mi < 4; ++mi)
#pragma unroll
        for (int ni = 0; ni < 4; ++ni) acc[mi][ni] = __builtin_amdgcn_mfma_f32_16x16x32_bf16(af[mi], bfr[ni], acc[mi][ni], 0, 0, 0);
    }
  };

  load_tile(0);
  store_tile(0);
  __syncthreads();
  for (int kt = 0; kt < nk; ++kt) {
    if (kt + 1 < nk) load_tile(kt + 1);
    __builtin_amdgcn_sched_barrier(0);
    compute(kt & 1);
    __builtin_amdgcn_sched_barrier(0);
    if (kt + 1 < nk) store_tile((kt + 1) & 1);
    __syncthreads();
  }

  gemm_epilogue<EP, 4>(p, c, nt, m0, wr, lq, lr, wc * 64, acc, lds);
}


template <int AL, int EP>
__device__ __forceinline__ void gemm_wide(const P& p, const GemmCtx& c, const int mt, const int nt2, char* lds) {
  const int tid = threadIdx.x, lane = tid & 63, wid = tid >> 6;
  const int wr = wid >> 1, wc = wid & 1, lr = lane & 15, lq = lane >> 4;
  const int m0 = mt * 128, n0 = nt2 * 256;
  const int K = c.K, nk = K >> 5;
  const bf16_t* A = c.A;
  const bf16_t* Bt = c.Bt;
  const float* mu = c.aux;
  const int lc = tid & 3, lrow = tid >> 2;
  f32x4 acc[4][8];
#pragma unroll
  for (int i = 0; i < 4; ++i)
#pragma unroll
    for (int j = 0; j < 8; ++j) acc[i][j] = f32x4{0.f, 0.f, 0.f, 0.f};
  bf16x8 ra[2], rp[2], rb[4]; f32x4 ax0, ax1;
  auto load_tile = [&](int kt) {
#pragma unroll
    for (int i = 0; i < 4; ++i) rb[i] = *(const bf16x8*)(Bt + (size_t)(n0 + lrow + 64 * i) * K + kt * 32 + lc * 8);
#pragma unroll
    for (int i = 0; i < 2; ++i) {
      const int m = m0 + lrow + 64 * i;
      const bf16_t* src = A + (size_t)m * c.lda + kt * 32 + lc * 8;
      ra[i] = *(const bf16x8*)src;
      if constexpr (AL == AL_MIX) { if ((m & (TSEQ - 1)) != 0) rp[i] = *(const bf16x8*)(src - DM); else rp[i] = bf16x8{0, 0, 0, 0, 0, 0, 0, 0}; }
    }
    if constexpr (AL == AL_MIX) { ax0 = *(const f32x4*)(mu + kt * 32 + lc * 8); ax1 = *(const f32x4*)(mu + kt * 32 + lc * 8 + 4); }
  };
  auto store_tile = [&](int buf) {
    char* Ab = lds + buf * 24576; char* Bb = Ab + 8192;
#pragma unroll
    for (int i = 0; i < 4; ++i) { const int row = lrow + 64 * i; *(bf16x8*)(Bb + row * 64 + ((lc ^ ((-(row >> 2)) & 3)) << 4)) = rb[i]; }
#pragma unroll
    for (int i = 0; i < 2; ++i) {
      const int row = lrow + 64 * i;
      if constexpr (AL == AL_MIX) {
        const float muv[8] = {ax0[0], ax0[1], ax0[2], ax0[3], ax1[0], ax1[1], ax1[2], ax1[3]};
        float f[8], fp[8]; unpack8(ra[i], f); unpack8(rp[i], fp);
#pragma unroll
        for (int e = 0; e < 8; ++e) f[e] = f[e] + (fp[e] - f[e]) * muv[e];
        *(bf16x8*)(Ab + row * 64 + ((lc ^ ((-(row >> 2)) & 3)) << 4)) = pack8f(f);
      } else {
        *(bf16x8*)(Ab + row * 64 + ((lc ^ ((-(row >> 2)) & 3)) << 4)) = ra[i];
      }
    }
  };
  auto compute = [&](int buf) {
    const char* Ab = lds + buf * 24576; const char* Bb = Ab + 8192;
    const int sw = (lq ^ ((-(lr >> 2)) & 3)) << 4;
    bf16x8 af[4];
#pragma unroll
    for (int mi = 0; mi < 4; ++mi) af[mi] = *(const bf16x8*)(Ab + (wr * 64 + mi * 16 + lr) * 64 + sw);
#pragma unroll
    for (int nh = 0; nh < 2; ++nh) {
      bf16x8 bfr[4];
#pragma unroll
      for (int ni = 0; ni < 4; ++ni) bfr[ni] = *(const bf16x8*)(Bb + (wc * 128 + (nh * 4 + ni) * 16 + lr) * 64 + sw);
#pragma unroll
      for (int mi = 0; mi < 4; ++mi)
#pragma unroll
        for (int ni = 0; ni < 4; ++ni) acc[mi][nh * 4 + ni] = __builtin_amdgcn_mfma_f32_16x16x32_bf16(af[mi], bfr[ni], acc[mi][nh * 4 + ni], 0, 0, 0);
    }
  };
  load_tile(0);
  store_tile(0);
  __syncthreads();
  for (int kt = 0; kt < nk; ++kt) {
    if (kt + 1 < nk) load_tile(kt + 1);
    __builtin_amdgcn_sched_barrier(0);
    compute(kt & 1);
    __builtin_amdgcn_sched_barrier(0);
    if (kt + 1 < nk) store_tile((kt + 1) & 1);
    __syncthreads();
  }
  gemm_epilogue<EP, 8>(p, c, 2 * nt2 + wc, m0, wr, lq, lr, 0, acc, lds);
}

__device__ __forceinline__ float sum16(float x) {
  x += DPP(x, 0xB1); x += DPP(x, 0x4E); x += DPP(x, 0x141); x += DPP(x, 0x140); return x;
}
__device__ __forceinline__ void scan_item(const P& p, const int layer, const int item, char* lds) {
  const int quarter = item & 3, h = (item >> 2) & 31, b = item >> 7;
  const int tid = threadIdx.x, lane = tid & 63, wid = tid >> 6;
  float* R = (float*)lds;
  float* W = R + 2048; float* Kk = W + 2048; float* Aa = Kk + 2048; float* Bv = Aa + 2048;
  float* V = Bv + 2048;
  float* Vg = V + 512;
  float* O = Vg + 512;
  float* KKp = O + 528; float* KAp = KKp + 64; float* RKp = KAp + 64;
  float* LBp = RKp + 64;
  const bf16_t* vsrc = p.vA + (size_t)layer * (64u << 20);
  bf16_t* vdst = p.vB;
  const int tl = tid >> 3, c8 = tid & 7;
  const int ch0 = h * 64 + c8 * 8;
  const int vc0 = h * 64 + quarter * 16;
  const int lr = lane & 15, lq = lane >> 4;
  const int ten = wid >> 1, lmi = wid & 1;
  const bf16_t* lA = p.lw + (size_t)ten * (2u << 20);
  const bf16_t* lB = p.W2w + (size_t)ten * (256u << 10);
  if (tid < 64) {
    KKp[tid] = p.a_k_k[layer * DM + h * 64 + tid]; KAp[tid] = p.a_k_a[layer * DM + h * 64 + tid]; RKp[tid] = p.a_r_k[layer * DM + h * 64 + tid];
  }
  if (tid < 128) { const float b0_ = p.a_w0[layer * DM + h * 64 + (tid & 63)], b1_ = p.a_a0[layer * DM + h * 64 + (tid & 63)]; LBp[tid] = tid < 64 ? b0_ : b1_; }
  if (tid >= 128 && tid < 144) LBp[tid] = layer == 1 ? p.a_v0[vc0 + (tid - 128)] : 0.f;
  const int row = tid >> 4, kq = tid & 15;
  f32x2 S01 = {0.f, 0.f}, S23 = {0.f, 0.f};

  const size_t tok0 = (size_t)b * TSEQ;
  bf16x8 rr, rk, rv, rvf;
  bf16x8 wB[3][4], wBv[2], fA[3], fAv[2];
#pragma unroll
  for (int ks = 0; ks < 3; ++ks)
#pragma unroll
    for (int ni = 0; ni < 4; ++ni) wB[ks][ni] = *(const bf16x8*)(lB + (size_t)(h * 64 + ni * 16 + lr) * 128 + ks * 32 + lq * 8);
  if (layer == 1) {
#pragma unroll
    for (int ks = 0; ks < 2; ++ks) wBv[ks] = *(const bf16x8*)(p.W2v + (size_t)(vc0 + lr) * 128 + ks * 32 + lq * 8);
  }
  auto load_raw = [&](int c) {
    const size_t m = tok0 + c * 32 + tl;
    {
      const size_t ml = tok0 + c * 32 + lmi * 16 + lr;
#pragma unroll
      for (int ks = 0; ks < 3; ++ks) fA[ks] = *(const bf16x8*)(lA + ml * 128 + ks * 32 + lq * 8);
      if (layer == 1) {
#pragma unroll
        for (int ks = 0; ks < 2; ++ks) fAv[ks] = *(const bf16x8*)(p.lv + ml * 128 + ks * 32 + lq * 8);
      }
    }
    rr = *(const bf16x8*)(p.r + m * DM + ch0);
    rk = *(const bf16x8*)(p.k + m * DM + ch0);
    if (c8 < 2) {
      rv = *(const bf16x8*)(vsrc + m * DM + vc0 + c8 * 8);
      if (layer == 1) rvf = *(const bf16x8*)(p.vA + m * DM + vc0 + c8 * 8);
    }
  };
  load_raw(0);
  __syncthreads();
  for (int c = 0; c < TSEQ / 32; ++c) {
    const size_t mc = tok0 + c * 32;
    {
      f32x4 acc[4];
#pragma unroll
      for (int ni = 0; ni < 4; ++ni) acc[ni] = f32x4{0.f, 0.f, 0.f, 0.f};
#pragma unroll
      for (int ks = 0; ks < 3; ++ks) {
#pragma unroll
        for (int ni = 0; ni < 4; ++ni) acc[ni] = __builtin_amdgcn_mfma_f32_16x16x32_bf16(fA[ks], wB[ks][ni], acc[ni], 0, 0, 0);
      }
      float* dstL = ten == 0 ? W : Bv;
#pragma unroll
      for (int ni = 0; ni < 4; ++ni)
#pragma unroll
        for (int j = 0; j < 4; ++j) {
          float sg = sigmoidf_(acc[ni][j] + LBp[ten * 64 + ni * 16 + lr]);
          float val = ten == 0 ? __expf(-0.6065306597126334f * sg) : sg;
          dstL[(lmi * 16 + lq * 4 + j) * 64 + ni * 16 + lr] = val;
        }
      if (layer == 1 && wid < 2) {
        f32x4 av = f32x4{0.f, 0.f, 0.f, 0.f};
#pragma unroll
        for (int ks = 0; ks < 2; ++ks) av = __builtin_amdgcn_mfma_f32_16x16x32_bf16(fAv[ks], wBv[ks], av, 0, 0, 0);
#pragma unroll
        for (int j = 0; j < 4; ++j) Vg[(wid * 16 + lq * 4 + j) * 16 + lr] = sigmoidf_(av[j] + LBp[128 + lr]);
      }
    }
    if (c > 0) {
      const float o0 = O[(c8 * 2) * 33 + tl], o1 = O[(c8 * 2 + 1) * 33 + tl];
      *(unsigned*)(p.ubuf + (mc - 32 + tl) * DM + vc0 + c8 * 2) = cvtpk(o0, o1);
    }
    __syncthreads();
    {
      float fr[8], fk[8], fa[8];
      unpack8(rr, fr); unpack8(rk, fk);
      { f32x4 a0 = *(const f32x4*)(Bv + tl * 64 + c8 * 8), a1 = *(const f32x4*)(Bv + tl * 64 + c8 * 8 + 4);
        fa[0] = a0[0]; fa[1] = a0[1]; fa[2] = a0[2]; fa[3] = a0[3]; fa[4] = a1[0]; fa[5] = a1[1]; fa[6] = a1[2]; fa[7] = a1[3]; }
      float kk[8], ss = 0.f, bsum = 0.f;
      float kkv[8], kav[8], rkv[8];
      { f32x4 t0 = *(const f32x4*)(KKp + c8 * 8), t1 = *(const f32x4*)(KKp + c8 * 8 + 4);
        kkv[0] = t0[0]; kkv[1] = t0[1]; kkv[2] = t0[2]; kkv[3] = t0[3]; kkv[4] = t1[0]; kkv[5] = t1[1]; kkv[6] = t1[2]; kkv[7] = t1[3];
        t0 = *(const f32x4*)(KAp + c8 * 8); t1 = *(const f32x4*)(KAp + c8 * 8 + 4);
        kav[0] = t0[0]; kav[1] = t0[1]; kav[2] = t0[2]; kav[3] = t0[3]; kav[4] = t1[0]; kav[5] = t1[1]; kav[6] = t1[2]; kav[7] = t1[3];
        t0 = *(const f32x4*)(RKp + c8 * 8); t1 = *(const f32x4*)(RKp + c8 * 8 + 4);
        rkv[0] = t0[0]; rkv[1] = t0[1]; rkv[2] = t0[2]; rkv[3] = t0[3]; rkv[4] = t1[0]; rkv[5] = t1[1]; rkv[6] = t1[2]; rkv[7] = t1[3]; }
#pragma unroll
      for (int e = 0; e < 8; ++e) { kk[e] = fk[e] * kkv[e]; ss += kk[e] * kk[e]; }
      ss = sum8(ss);
      const float inv = __builtin_amdgcn_rsqf(fmaxf(ss, 1e-24f));
      float kp[8], na[8], bb[8];
#pragma unroll
      for (int e = 0; e < 8; ++e) {
        kk[e] *= inv;
        kp[e] = fk[e] * (1.f + (fa[e] - 1.f) * kav[e]);
        na[e] = -kk[e]; bb[e] = kk[e] * fa[e];
        bsum += fr[e] * kp[e] * rkv[e];
      }
      bsum = sum8(bsum);
      float* d;
      d = R + tl * 64 + c8 * 8;  *(f32x4*)d = f32x4{fr[0], fr[1], fr[2], fr[3]}; *(f32x4*)(d + 4) = f32x4{fr[4], fr[5], fr[6], fr[7]};
      d = Kk + tl * 64 + c8 * 8; *(f32x4*)d = f32x4{kp[0], kp[1], kp[2], kp[3]}; *(f32x4*)(d + 4) = f32x4{kp[4], kp[5], kp[6], kp[7]};
      d = Aa + tl * 64 + c8 * 8; *(f32x4*)d = f32x4{na[0], na[1], na[2], na[3]}; *(f32x4*)(d + 4) = f32x4{na[4], na[5], na[6], na[7]};
      d = Bv + tl * 64 + c8 * 8; *(f32x4*)d = f32x4{bb[0], bb[1], bb[2], bb[3]}; *(f32x4*)(d + 4) = f32x4{bb[4], bb[5], bb[6], bb[7]};
      if (quarter == 0 && c8 == 0) p.bon[(mc + tl) * 32 + h] = bsum;
      if (c8 < 2) {
        float fv[8]; unpack8(rv, fv);
        if (layer == 1) {
          float ff[8]; unpack8(rvf, ff);
          f32x4 g0 = *(const f32x4*)(Vg + tl * 16 + c8 * 8), g1 = *(const f32x4*)(Vg + tl * 16 + c8 * 8 + 4);
          const float gg[8] = {g0[0], g0[1], g0[2], g0[3], g1[0], g1[1], g1[2], g1[3]};
#pragma unroll
          for (int e = 0; e < 8; ++e) fv[e] = fv[e] + (ff[e] - fv[e]) * gg[e];
          *(bf16x8*)(vdst + (mc + tl) * DM + vc0 + c8 * 8) = pack8f(fv);
        }
        d = V + tl * 16 + c8 * 8; *(f32x4*)d = f32x4{fv[0], fv[1], fv[2], fv[3]}; *(f32x4*)(d + 4) = f32x4{fv[4], fv[5], fv[6], fv[7]};
      }
    }
    __syncthreads();
    if (c + 1 < TSEQ / 32) load_raw(c + 1);
    {
      f32x4 xa, xw, xk, xb, xr, na_, nw_, nk_, nb_, nr_; float xv, nv;
      const float* bA = Aa + kq * 4; const float* bW = W + kq * 4; const float* bK = Kk + kq * 4; const float* bB = Bv + kq * 4; const float* bR = R + kq * 4;
      xa = *(const f32x4*)bA; xw = *(const f32x4*)bW; xk = *(const f32x4*)bK; xb = *(const f32x4*)bB; xr = *(const f32x4*)bR; xv = V[row];
      float opend = 0.f;
#pragma unroll 8
      for (int t = 0; t < 32; ++t) {
        const f32x2 xa01 = {xa[0], xa[1]}, xa23 = {xa[2], xa[3]};
        f32x2 pa = S01 * xa01; pa = __builtin_elementwise_fma(S23, xa23, pa);
        float ra_ = pa[0] + pa[1];
        __builtin_amdgcn_sched_barrier(0);
        {
          const int o_ = ((t + 1) & 31) * 64;
          na_ = *(const f32x4*)(bA + o_); nw_ = *(const f32x4*)(bW + o_); nk_ = *(const f32x4*)(bK + o_); nb_ = *(const f32x4*)(bB + o_); nr_ = *(const f32x4*)(bR + o_);
          nv = V[((t + 1) & 31) * 16 + row];
        }
        float ro_ = opend;
        ra_ += DPP(ra_, 0xB1); ro_ += DPP(ro_, 0xB1);
        ra_ += DPP(ra_, 0x4E); ro_ += DPP(ro_, 0x4E);
        ra_ += DPP(ra_, 0x141); ro_ += DPP(ro_, 0x141);
        ra_ += DPP(ra_, 0x140); ro_ += DPP(ro_, 0x140);
        O[row * 33 + ((t - 1) & 31)] = ro_;
        const f32x2 sa2 = {ra_, ra_}, xv2 = {xv, xv};
        const f32x2 xk01 = {xk[0], xk[1]}, xk23 = {xk[2], xk[3]}, xb01 = {xb[0], xb[1]}, xb23 = {xb[2], xb[3]};
        const f32x2 xw01 = {xw[0], xw[1]}, xw23 = {xw[2], xw[3]}, xr01 = {xr[0], xr[1]}, xr23 = {xr[2], xr[3]};
        S01 = __builtin_elementwise_fma(S01, xw01, __builtin_elementwise_fma(sa2, xb01, xv2 * xk01));
        S23 = __builtin_elementwise_fma(S23, xw23, __builtin_elementwise_fma(sa2, xb23, xv2 * xk23));
        f32x2 po = S01 * xr01; po = __builtin_elementwise_fma(S23, xr23, po);
        opend = po[0] + po[1];
        xa = na_; xw = nw_; xk = nk_; xb = nb_; xr = nr_; xv = nv;
      }
      { const float ro_ = sum16(opend); O[row * 33 + 31] = ro_; }
    }
    __syncthreads();
  }
  {
    const size_t mp = tok0 + (TSEQ - 32);
    const float o0 = O[(c8 * 2) * 33 + tl], o1 = O[(c8 * 2 + 1) * 33 + tl];
    *(unsigned*)(p.ubuf + (mp + tl) * DM + vc0 + c8 * 2) = cvtpk(o0, o1);
  }
  __syncthreads();
}

__device__ __forceinline__ void postscan_phase(const P& p, const int layer) {
  const int tid = threadIdx.x, head = tid >> 3, ch = tid * 8;
  const bf16_t* vsrc = p.vA + (size_t)layer * (64u << 20);
  float lg[8], lb[8];
  {
    const float* pg = p.a_ln_g + layer * DM + ch; const float* pb = p.a_ln_b + layer * DM + ch;
#pragma unroll
    for (int e = 0; e < 8; ++e) { lg[e] = pg[e]; lb[e] = pb[e]; }
  }
  for (int m0 = blockIdx.x; m0 < MTOK; m0 += 4 * gridDim.x) {
    bf16x8 ro[4], rv[4], rz[4]; float bn[4];
#pragma unroll
    for (int u = 0; u < 4; ++u) {
      const int m = m0 + u * gridDim.x;
      if (m < MTOK) {
        ro[u] = *(const bf16x8*)(p.ubuf + (size_t)m * DM + ch);
        rv[u] = *(const bf16x8*)(vsrc + (size_t)m * DM + ch);
        rz[u] = *(const bf16x8*)(p.z + (size_t)m * DM + ch);
        bn[u] = p.bon[(size_t)m * 32 + head];
      }
    }
#pragma unroll
    for (int u = 0; u < 4; ++u) {
      const int m = m0 + u * gridDim.x;
      if (m < MTOK) {
        float fo[8], fv[8], fz[8];
        unpack8(ro[u], fo); unpack8(rv[u], fv); unpack8(rz[u], fz);
        float sm = 0.f;
#pragma unroll
        for (int e = 0; e < 8; ++e) sm += fo[e];
        const float mean = sum8(sm) * (1.f / 64.f);
        float sv = 0.f;
#pragma unroll
        for (int e = 0; e < 8; ++e) { fo[e] -= mean; sv += fo[e] * fo[e]; }
        const float rstd = rsqrtf(sum8(sv) * (1.f / 64.f) + 64e-5f);
#pragma unroll
        for (int e = 0; e < 8; ++e) fo[e] = (fo[e] * rstd * lg[e] + lb[e] + bn[u] * fv[e]) * siluf_(fz[e]);
        *(bf16x8*)(p.ubuf + (size_t)m * DM + ch) = pack8f(fo);
      }
    }
  }
}

__device__ __forceinline__ void cmp_item(const P& p, const int item, char* lds) {
  const int qb = (item & 512) ? 63 - (item & 63) : (item & 63), g = (item >> 6) & 3, b = item >> 8;
  const int bg = b * 4 + g;
  const int tid = threadIdx.x, lane = tid & 63, w = tid >> 6;
  const int n = lane & 31, hi = lane >> 5;
  float* impM = (float*)lds;
  float* impS = impM + 64 * 68;
  for (int e = lane; e < 16 * 68; e += 64) { impM[w * 16 * 68 + e] = 0.f; impS[w * 16 * 68 + e] = 0.f; }
  const int ql = 16 * w + (n & 15);
  const int tq = qb * 64 + ql;
  const size_t m = (size_t)b * TSEQ + tq;
  const int cmaxq = (tq - 31) >> 4;
  const int nkt = (4 * qb + 3 + 31) >> 5;
  const bf16_t* Kc = p.kcmp + (size_t)bg * 256 * 128;
  const bf16_t* Vc = p.vcmpT + (size_t)bg * 128 * 256;
  const float NEG = -__builtin_inff();
#pragma unroll 1
  for (int ct = 0; ct < 2; ++ct) {
    const int head = g * 4 + 2 * ct + (n >> 4);
    bf16x8 qf[8];
#pragma unroll
    for (int d0 = 0; d0 < 8; ++d0) qf[d0] = *(const bf16x8*)(p.q + m * DM + head * 128 + d0 * 16 + hi * 8);
    float mx = -1e30f, l = 0.f;
#pragma unroll 1
    for (int kt = 0; kt < nkt; ++kt) {
      f32x16 sc; for (int r = 0; r < 16; ++r) sc[r] = 0.f;
#pragma unroll
      for (int d0 = 0; d0 < 8; ++d0) {
        bf16x8 kf = *(const bf16x8*)(Kc + (size_t)(kt * 32 + n) * 128 + d0 * 16 + hi * 8);
        sc = __builtin_amdgcn_mfma_f32_32x32x16_bf16(kf, qf[d0], sc, 0, 0, 0);
      }
      float tm = NEG;
#pragma unroll
      for (int r = 0; r < 16; ++r) { const int cc = kt * 32 + crow(r, hi); if (cc > cmaxq) sc[r] = NEG; tm = fmaxf(tm, sc[r]); }
      tm = swap32_max(tm);
      const float mn = fmaxf(mx, tm);
      float ps = 0.f;
#pragma unroll
      for (int r = 0; r < 16; ++r) ps += __builtin_amdgcn_exp2f(sc[r] - mn);
      ps = swap32_sum(ps);
      l = l * __builtin_amdgcn_exp2f(mx - mn) + ps; mx = mn;
    }
    const float inv_l = l > 0.f ? 1.f / l : 0.f;
    f32x16 o[4];
#pragma unroll
    for (int dt = 0; dt < 4; ++dt) for (int r = 0; r < 16; ++r) o[dt][r] = 0.f;
#pragma unroll 1
    for (int kt = 0; kt < nkt; ++kt) {
      f32x16 sc; for (int r = 0; r < 16; ++r) sc[r] = 0.f;
#pragma unroll
      for (int d0 = 0; d0 < 8; ++d0) {
        bf16x8 kf = *(const bf16x8*)(Kc + (size_t)(kt * 32 + n) * 128 + d0 * 16 + hi * 8);
        sc = __builtin_amdgcn_mfma_f32_32x32x16_bf16(kf, qf[d0], sc, 0, 0, 0);
      }
      float pr[16];
#pragma unroll
      for (int r = 0; r < 16; ++r) { const int cc = kt * 32 + crow(r, hi); pr[r] = (cc > cmaxq) ? 0.f : __builtin_amdgcn_exp2f(sc[r] - mx) * inv_l; }
#pragma unroll
      for (int a = 0; a < 4; ++a) {
        float mainv = pr[4 * a] + pr[4 * a + 1] + pr[4 * a + 2] + 0.5f * pr[4 * a + 3];
        float spill = 0.5f * pr[4 * a + 3];
        mainv += __shfl_xor(mainv, 16); spill += __shfl_xor(spill, 16);
        if ((n & 16) == 0) {
          const int jj = 8 * kt + 2 * a + hi;
          impM[ql * 68 + jj] += mainv; impS[ql * 68 + jj + 1] += spill;
        }
      }
      const float pf0[8] = {pr[0], pr[1], pr[2], pr[3], pr[4], pr[5], pr[6], pr[7]};
      const float pf1[8] = {pr[8], pr[9], pr[10], pr[11], pr[12], pr[13], pr[14], pr[15]};
      const bf16x8 pb0 = pack8f(pf0), pb1 = pack8f(pf1);
#pragma unroll
      for (int dt = 0; dt < 4; ++dt) {
        const bf16_t* vp = Vc + (size_t)(dt * 32 + n) * 256 + kt * 32 + hi * 8;
        bf16x8 v0 = *(const bf16x8*)vp, v1 = *(const bf16x8*)(vp + 16);
        o[dt] = __builtin_amdgcn_mfma_f32_32x32x16_bf16(v0, pb0, o[dt], 0, 0, 0);
        o[dt] = __builtin_amdgcn_mfma_f32_32x32x16_bf16(v1, pb1, o[dt], 0, 0, 0);
      }
    }
    const float gt = p.gates[m * 48 + head * 3 + 0];
#pragma unroll
    for (int dt = 0; dt < 4; ++dt)
#pragma unroll
      for (int a = 0; a < 4; ++a) {
        u32x2 wv = {cvtpk(o[dt][4 * a] * gt, o[dt][4 * a + 1] * gt), cvtpk(o[dt][4 * a + 2] * gt, o[dt][4 * a + 3] * gt)};
        *(u32x2*)(p.ocmp + m * DM + head * 128 + dt * 32 + 8 * a + 4 * hi) = wv;
      }
  }
  __syncthreads();
  {
    const int qq = 16 * w + (lane >> 2), part = lane & 3;
    const int cur = qb;
    unsigned lo, hi32;
    if (cur < 16) { lo = (2u << cur) - 1u; hi32 = 0u; }
    else {
      float* rowp = impM + qq * 68; const float* rows = impS + qq * 68;
      for (int e = 0; e < 16; ++e) { const int j = part * 16 + e; rowp[j] = rowp[j] + rows[j]; }
      __builtin_amdgcn_fence(__ATOMIC_RELEASE, "wavefront");
      __builtin_amdgcn_wave_barrier();
      float vj[16]; int rank[16];
#pragma unroll
      for (int e = 0; e < 16; ++e) { vj[e] = rowp[part * 16 + e]; rank[e] = 0; }
      for (int j2 = 1; j2 <= cur - 2; ++j2) {
        const float v2 = rowp[j2];
#pragma unroll
        for (int e = 0; e < 16; ++e) { const int j = part * 16 + e; rank[e] += (v2 > vj[e] || (v2 == vj[e] && j2 < j)) ? 1 : 0; }
      }
      unsigned bits = 0;
#pragma unroll
      for (int e = 0; e < 16; ++e) { const int j = part * 16 + e; if (j >= 1 && j <= cur - 2 && rank[e] < 13) bits |= 1u << e; }
      const int base = lane & ~3;
      const unsigned b0 = __shfl(bits, base), b1 = __shfl(bits, base + 1), b2 = __shfl(bits, base + 2), b3 = __shfl(bits, base + 3);
      lo = b0 | (b1 << 16); hi32 = b2 | (b3 << 16);
      lo |= 1u;
      { const int j = cur - 1; if (j < 32) lo |= 1u << j; else hi32 |= 1u << (j - 32); }
      { const int j = cur; if (j < 32) lo |= 1u << j; else hi32 |= 1u << (j - 32); }
    }
    if (part == 0) {
      unsigned* sp = p.selmask + ((size_t)bg * TSEQ + qb * 64 + qq) * 2;
      sp[0] = lo; sp[1] = hi32;
    }
  }
  __syncthreads();
}

template <int BR>
__device__ __forceinline__ void attn_pass(const P& p, const int b, const int g, const int qb, const int head, const int tq, const bf16x8* qf,
                                          unsigned long long tiles, const unsigned long long mysel, char* lds) {
  const int tid = threadIdx.x, lane = tid & 63;
  const int kl = lane & 31, hi = lane >> 5;
  const int bg = b * 4 + g;
  const bf16_t* Kg = (BR == 0 ? p.kw : p.ks) + (size_t)bg * TSEQ * 128;
  const bf16_t* Vg = (BR == 0 ? p.vwT : p.vsT) + (size_t)bg * 128 * TSEQ;
  const unsigned Wlim = BR == 0 ? 512u : 0x80000000u;
  const float NEG = -__builtin_inff();
  f32x16 o[4];
#pragma unroll
  for (int dt = 0; dt < 4; ++dt) for (int r = 0; r < 16; ++r) o[dt][r] = 0.f;
  float mx = -1e30f, l = 0.f;
  bf16x8 sk[4], sv[4];
  auto load_tile = [&](int j) {
#pragma unroll
    for (int i = 0; i < 4; ++i) {
      const int id = tid + 256 * i;
      sk[i] = *(const bf16x8*)(Kg + (size_t)(j * 64 + (id >> 4)) * 128 + (id & 15) * 8);
      sv[i] = *(const bf16x8*)(Vg + (size_t)(id >> 3) * TSEQ + j * 64 + (id & 7) * 8);
    }
  };
  auto store_tile = [&](int buf) {
    char* Kb = lds + buf * ATT_BUF; char* Vb = Kb + ATT_KSZ;
#pragma unroll
    for (int i = 0; i < 4; ++i) {
      const int id = tid + 256 * i;
      { const int row = id >> 4, c16 = id & 15; *(bf16x8*)(Kb + row * 272 + (c16 << 4)) = sk[i]; }
      { const int d = id >> 3, cx = id & 7; *(bf16x8*)(Vb + d * 144 + (cx << 4)) = sv[i]; }
    }
  };
  int j = __builtin_ctzll(tiles); tiles &= tiles - 1;
  load_tile(j);
  store_tile(0);
  __syncthreads();
  int buf = 0;
  while (true) {
    const bool more = tiles != 0ull;
    int jn = 0;
    if (more) { jn = __builtin_ctzll(tiles); tiles &= tiles - 1; load_tile(jn); }
    {
      const char* Kb = lds + buf * ATT_BUF + kl * 272 + hi * 16; const char* Vb = lds + buf * ATT_BUF + ATT_KSZ + kl * 144 + hi * 16;
      const bool lane_ok = BR == 0 ? true : ((mysel >> j) & 1ull) != 0ull;
      const bool wave_any = __any(lane_ok);
      const bool boundary = BR == 0 ? (j == qb || j + 8 == qb) : (j == qb);
      if (wave_any) {
#pragma unroll
        for (int hs = 0; hs < 2; ++hs) {
          f32x16 sc; for (int r = 0; r < 16; ++r) sc[r] = 0.f;
#pragma unroll
          for (int d0 = 0; d0 < 8; ++d0) {
            bf16x8 kf = *(const bf16x8*)(Kb + hs * 32 * 272 + d0 * 32);
            sc = __builtin_amdgcn_mfma_f32_32x32x16_bf16(kf, qf[d0], sc, 0, 0, 0);
          }
          if (boundary) {
            const int dq = tq - (j * 64 + hs * 32 + 4 * hi);
#pragma unroll
            for (int r = 0; r < 16; ++r) { const int cidx = (r & 3) + 8 * (r >> 2); if ((unsigned)(dq - cidx) >= Wlim) sc[r] = NEG; }
          }
          if (BR == 1) {
#pragma unroll
            for (int r = 0; r < 16; ++r) sc[r] = lane_ok ? sc[r] : NEG;
          }
          float tm = sc[0];
#pragma unroll
          for (int r = 1; r < 16; ++r) tm = fmaxf(tm, sc[r]);
          tm = swap32_max(tm);
          if (!__all(tm <= mx + 8.f)) {
            const float mn = fmaxf(mx, tm);
            const float alpha = __builtin_amdgcn_exp2f(mx - mn);
            l *= alpha; mx = mn;
#pragma unroll
            for (int dt = 0; dt < 4; ++dt)
#pragma unroll
              for (int r = 0; r < 16; ++r) o[dt][r] *= alpha;
          }
          float pr[16]; float ps = 0.f;
#pragma unroll
          for (int r = 0; r < 16; ++r) { pr[r] = __builtin_amdgcn_exp2f(sc[r] - mx); ps += pr[r]; }
          ps = swap32_sum(ps);
          l += ps;
          const float pf0[8] = {pr[0], pr[1], pr[2], pr[3], pr[4], pr[5], pr[6], pr[7]};
          const float pf1[8] = {pr[8], pr[9], pr[10], pr[11], pr[12], pr[13], pr[14], pr[15]};
          const bf16x8 pb0 = pack8f(pf0), pb1 = pack8f(pf1);
#pragma unroll
          for (int dt = 0; dt < 4; ++dt) {
            bf16x8 v0 = *(const bf16x8*)(Vb + dt * 32 * 144 + hs * 64);
            bf16x8 v1 = *(const bf16x8*)(Vb + dt * 32 * 144 + hs * 64 + 32);
            o[dt] = __builtin_amdgcn_mfma_f32_32x32x16_bf16(v0, pb0, o[dt], 0, 0, 0);
            o[dt] = __builtin_amdgcn_mfma_f32_32x32x16_bf16(v1, pb1, o[dt], 0, 0, 0);
          }
        }
      }
    }
    if (more) store_tile(buf ^ 1);
    __syncthreads();
    if (!more) break;
    j = jn; buf ^= 1;
  }
  const size_t m = (size_t)b * TSEQ + tq;
  const float gt = p.gates[m * 48 + head * 3 + (BR == 0 ? 2 : 1)];
  const float sc_ = gt / l;
  if (BR == 0) {
#pragma unroll
    for (int dt = 0; dt < 4; ++dt)
#pragma unroll
      for (int a = 0; a < 4; ++a) {
        const size_t idx = m * DM + head * 128 + dt * 32 + 8 * a + 4 * hi;
        *(u32x2*)(p.ubuf + idx) = u32x2{cvtpk(o[dt][4 * a] * sc_, o[dt][4 * a + 1] * sc_), cvtpk(o[dt][4 * a + 2] * sc_, o[dt][4 * a + 3] * sc_)};
      }
  } else {
#pragma unroll
    for (int dt = 0; dt < 4; ++dt)
#pragma unroll
      for (int a = 0; a < 4; ++a) {
        const size_t idx = m * DM + head * 128 + dt * 32 + 8 * a + 4 * hi;
        const u32x2 oc = *(const u32x2*)(p.ocmp + idx);
        const u32x2 zz = *(const u32x2*)(p.sz + idx);
        const u32x2 ww = *(const u32x2*)(p.ubuf + idx);
        const float y0 = (o[dt][4 * a] * sc_ + bflo(ww[0]) + bflo(oc[0])) * bflo(zz[0]);
        const float y1 = (o[dt][4 * a + 1] * sc_ + bfhi(ww[0]) + bfhi(oc[0])) * bfhi(zz[0]);
        const float y2 = (o[dt][4 * a + 2] * sc_ + bflo(ww[1]) + bflo(oc[1])) * bflo(zz[1]);
        const float y3 = (o[dt][4 * a + 3] * sc_ + bfhi(ww[1]) + bfhi(oc[1])) * bfhi(zz[1]);
        *(u32x2*)(p.ubuf + idx) = u32x2{cvtpk(y0, y1), cvtpk(y2, y3)};
      }
  }
}

__device__ __forceinline__ void attn_item(const P& p, const int item, char* lds, unsigned long long* uni) {
  const int half = item & 1, g = (item >> 1) & 3, b = (item >> 3) & 3, qb = 63 - (item >> 5);
  const int tid = threadIdx.x, lane = tid & 63, w = tid >> 6;
  const int kl = lane & 31, hi = lane >> 5;
  const int head = g * 4 + half * 2 + (w >> 1);
  const int tq = qb * 64 + (w & 1) * 32 + kl;
  const size_t m = (size_t)b * TSEQ + tq;
  bf16x8 qf[8];
#pragma unroll
  for (int d0 = 0; d0 < 8; ++d0) qf[d0] = *(const bf16x8*)(p.q + m * DM + head * 128 + d0 * 16 + hi * 8);
  const unsigned* sp = p.selmask + ((size_t)(b * 4 + g) * TSEQ + tq) * 2;
  const unsigned long long mysel = (unsigned long long)sp[0] | ((unsigned long long)sp[1] << 32);
  unsigned long long u = mysel;
#pragma unroll
  for (int o = 16; o >= 1; o >>= 1) { u |= (unsigned long long)__shfl_xor((unsigned)u, o) | ((unsigned long long)__shfl_xor((unsigned)(u >> 32), o) << 32); }
  if (lane == 0) uni[w] = u;
  __syncthreads();
  const unsigned long long U = (uni[0] | uni[1] | uni[2] | uni[3]) & (qb == 63 ? ~0ull : ((2ull << qb) - 1ull));
  const int jlo = qb >= 8 ? qb - 8 : 0;
  const unsigned long long wt = (qb == 63 ? ~0ull : ((2ull << qb) - 1ull)) & ~((1ull << jlo) - 1ull);
  attn_pass<0>(p, b, g, qb, head, tq, qf, wt, mysel, lds);
  attn_pass<1>(p, b, g, qb, head, tq, qf, U, mysel, lds);
}

typedef __attribute__((address_space(1))) unsigned gunsigned;
__device__ __forceinline__ unsigned gb_ld(unsigned* p) { return __hip_atomic_load((gunsigned*)p, __ATOMIC_RELAXED, __HIP_MEMORY_SCOPE_AGENT); }
__device__ __forceinline__ unsigned gb_add(unsigned* p, unsigned v) { return __hip_atomic_fetch_add((gunsigned*)p, v, __ATOMIC_RELAXED, __HIP_MEMORY_SCOPE_AGENT); }
__device__ __forceinline__ void grid_barrier(unsigned* bar, const unsigned e) {
  __builtin_amdgcn_fence(__ATOMIC_RELEASE, "workgroup");
  __builtin_amdgcn_s_waitcnt(0);
  __syncthreads();
  if (threadIdx.x == 0) {
    const unsigned G = gridDim.x, g = blockIdx.x & 7u;
    const unsigned ngrp = G < 8u ? G : 8u, nloc = (G + 7u - g) >> 3;
    __builtin_amdgcn_fence(__ATOMIC_RELEASE, "agent");
    __builtin_amdgcn_s_waitcnt(0);
    const unsigned old = gb_add(&bar[64u * (1u + g)], 1u);
    if (old + 1u == (e + 1u) * nloc) {
      const unsigned og = gb_add(&bar[0], 1u);
      if (og + 1u == (e + 1u) * ngrp) gb_add(&bar[64u * 20u], 1u);
      else { unsigned sp = 0; while (gb_ld(&bar[64u * 20u]) <= e && ++sp < (1u << 24)) __builtin_amdgcn_s_sleep(1); }
      gb_add(&bar[64u * (10u + g)], 1u);
    } else {
      unsigned sp = 0; while (gb_ld(&bar[64u * (10u + g)]) <= e && ++sp < (1u << 24)) __builtin_amdgcn_s_sleep(1);
    }
    __builtin_amdgcn_fence(__ATOMIC_ACQUIRE, "agent");
    __builtin_amdgcn_s_waitcnt(0);
  }
  __syncthreads();
}

#define NPHASE 23
#ifndef GRP
#define GRP 0xFFFF
#endif
#define EN(b) ((GRP >> (b)) & 1)
#ifndef DUPMASK
#define DUPMASK 0
#endif
#define PHASE(n, en, ...) if (ph_lo <= (n) && (n) < ph_hi) { if (EN(en)) { __VA_ARGS__ if ((DUPMASK >> (n)) & 1) { __syncthreads(); __VA_ARGS__ } } if ((n) + 1 < ph_hi) { if ((n) == 0) cg::this_grid().sync(); else grid_barrier(bar, (unsigned)((n) - 1)); } }

__device__ __forceinline__ bool deal_tile(int r, int NT, int& mt, int& nt) {
  const int G = gridDim.x, bid = blockIdx.x;
  if (G == 512) {
    const int x = bid & 7, lb = bid >> 3;
    const int NG = NT >> 3, rem = NT & 7;
    if (r < 2 * NG) { mt = 16 * x + (r & 1) * 8 + (lb >> 3); nt = (r >> 1) * 8 + (lb & 7); return true; }
    const int idx = (r - 2 * NG) * 64 + lb;
    if (idx < 16 * rem) { mt = 16 * x + idx / rem; nt = NG * 8 + idx % rem; return true; }
    return false;
  }
  const int t = bid + r * G;
  if (t < 128 * NT) { mt = t / NT; nt = t % NT; return true; }
  return false;
}
__device__ __forceinline__ int deal_rounds(int NT) {
  const int G = gridDim.x;
  if (G == 512) return 2 * (NT >> 3) + (16 * (NT & 7) + 63) / 64;
  return (128 * NT + G - 1) / G;
}
__device__ __forceinline__ void ph_proj(const P& p, int layer, char* lds) {
  {
    const int nr = deal_rounds(32);
    for (int r = 0; r < nr; ++r) {
      int mt, nt2;
      if (!deal_tile(r, 32, mt, nt2)) continue;
      GemmCtx cw; cw.A = p.ubuf; cw.lda = DM; cw.K = DM; cw.layer = layer; cw.j = 0; cw.Bt = p.Wp;
      cw.aux = p.a_mu + (size_t)(layer * 6 + (nt2 >> 3)) * DM;
      gemm_wide<AL_MIX, EP_PROJ>(p, cw, mt, nt2, lds);
    }
  }
  const int NL = layer == 0 ? 2 : 3;
  GemmCtx c; c.A = p.ubuf; c.lda = DM; c.K = DM; c.layer = layer; c.j = 0; c.Bt = p.Wp;
  const int nr = deal_rounds(NL);
  for (int r = 0; r < nr; ++r) {
    int mt, ntl;
    if (!deal_tile(r, NL, mt, ntl)) continue;
    const int nt = 64 + ntl;
    const int mui = nt == 64 ? 4 : nt == 65 ? 5 : 2;
    c.aux = p.a_mu + (size_t)(layer * 6 + mui) * DM;
    gemm_tile<AL_MIX, EP_PROJ>(p, c, mt, nt, lds);
  }
}
__device__ __forceinline__ void ph_wo(const P& p, int layer, const bf16_t* Wt, char* lds) {
  GemmCtx c; c.A = p.ubuf; c.lda = DM; c.Bt = Wt; c.K = DM; c.layer = layer; c.j = 0; c.aux = nullptr;
  const int nr = deal_rounds(8);
  for (int r = 0; r < nr; ++r) {
    int mt, nt2;
    if (!deal_tile(r, 8, mt, nt2)) continue;
    gemm_wide<AL_PLAIN, EP_RESID>(p, c, mt, nt2, lds);
  }
}
__device__ __forceinline__ void ph_kvwin(const P& p, int jl, int NTK, char* lds) {
  const int NK2 = NTK >> 1, NT2 = NK2 + 16;
  {
    const int nr = deal_rounds(NT2);
    for (int r = 0; r < nr; ++r) {
      int mt, nt2;
      if (!deal_tile(r, NT2, mt, nt2)) continue;
      GemmCtx c; c.lda = DM; c.K = DM; c.layer = 1; c.j = jl; c.aux = nullptr;
      if (nt2 < NK2) { c.A = p.hn; c.Bt = p.Wkv; gemm_wide<AL_PLAIN, EP_KV>(p, c, mt, nt2, lds); }
      else { c.A = p.ubuf; c.Bt = p.Win; gemm_wide<AL_PLAIN, EP_WIN>(p, c, mt, nt2 - NK2, lds); }
    }
  }
  if (jl != 0) {
    GemmCtx c; c.lda = DM; c.K = DM; c.layer = 1; c.j = jl; c.aux = nullptr; c.A = p.ubuf; c.Bt = p.Win;
    const int nr = deal_rounds(1);
    for (int r = 0; r < nr; ++r) {
      int mt, ntl;
      if (!deal_tile(r, 1, mt, ntl)) continue;
      gemm_tile<AL_PLAIN, EP_WIN>(p, c, mt, 32, lds);
    }
  }
}
__device__ __forceinline__ void ph_attn(const P& p, char* lds, unsigned long long* uni) {
  const int G = gridDim.x, bid = blockIdx.x;
  int rnd = 0;
  for (int base = 0; base < 2048; base += G, ++rnd) {
    const int idx = base + ((rnd & 1) ? (G - 1 - bid) : bid);
    if (idx < 2048) attn_item(p, idx, lds, uni);
    __syncthreads();
  }
}

__global__ void __launch_bounds__(NTHREADS, 2) fwd_kernel(const P p, const PJ pj, unsigned* bar, const int ph_lo, const int ph_hi) {
  __shared__ __attribute__((aligned(16))) char lds[LDS_BYTES];
  __shared__ unsigned long long uni[4];
  const int G = gridDim.x, bid = blockIdx.x;
  PHASE(0, 0, norm_phase<0, 0>(p, pj, false, p.a_norm_g, p.ubuf, nullptr, nullptr, nullptr, lds);)
  PHASE(1, 1, ph_proj(p, 0, lds);)
  PHASE(2, 2, for (int it = bid; it < 512; it += G) scan_item(p, 0, it, lds);)
  PHASE(3, 3, postscan_phase(p, 0);)
  PHASE(4, 4, ph_wo(p, 0, p.Wo, lds);)
  PHASE(5, 0, norm_phase<0, 1>(p, pj, true, p.a_norm_g + DM, p.ubuf, nullptr, nullptr, nullptr, lds);)
  PHASE(6, 1, ph_proj(p, 1, lds);)
  PHASE(7, 2, for (int it = bid; it < 512; it += G) scan_item(p, 1, it, lds);)
  PHASE(8, 3, postscan_phase(p, 1);)
  PHASE(9, 4, ph_wo(p, 1, p.Wo, lds);)
  PHASE(10, 0, norm_phase<1, 2>(p, pj, true, p.kv_norm_g, p.hn, p.b_norm_g, p.ubuf, nullptr, lds);)
  PHASE(11, 5, ph_kvwin(p, 0, 24, lds);)
  PHASE(12, 6,
    for (int t = bid; t < 256; t += G) {
      if (t >= 128) {
        GemmCtx cg; cg.lda = DM; cg.K = DM; cg.layer = 1; cg.j = 0; cg.aux = nullptr; cg.A = p.ubuf; cg.Bt = p.Win;
        gemm_tile<AL_PLAIN, EP_WIN>(p, cg, t - 128, 32, lds);
        continue;
      }
      const int j = t >> 6, r = t & 63, mt = r >> 1, nt = r & 1;
      GemmCtx c; c.A = p.kc + (size_t)j * (8u << 20); c.lda = 0; c.Bt = p.Wc1 + (size_t)j * 256 * 4096; c.K = 4096; c.layer = 0; c.j = j;
      c.aux = p.cmp_pe + (size_t)j * 32 * 128;
      gemm_tile<AL_CMP, EP_CMP1>(p, c, mt, nt, lds);
    })
  PHASE(13, 7,
    for (int t = bid; t < 64; t += G) {
      const int j = t >> 5, mt = t & 31;
      GemmCtx c; c.A = p.hc + (size_t)j * 4096 * 256; c.lda = 256; c.Bt = p.Wc2 + (size_t)j * 128 * 256; c.K = 256; c.layer = 0; c.j = j; c.aux = nullptr;
      gemm_tile<AL_PLAIN, EP_CMP2>(p, c, mt, 0, lds);
    })
  PHASE(14, 8, for (int t = bid; t < 1024; t += G) cmp_item(p, t, lds);)
  PHASE(15, 9, ph_attn(p, lds, uni);)
  PHASE(16, 4, ph_wo(p, 1, p.Wob, lds);)
  PHASE(17, 0, norm_phase<0, 3>(p, pj, true, p.b_norm_g + DM, p.ubuf, nullptr, nullptr, nullptr, lds);)
  PHASE(18, 5, ph_kvwin(p, 1, 0, lds);)
  PHASE(19, 8, for (int t = bid; t < 1024; t += G) cmp_item(p, t, lds);)
  PHASE(20, 9, ph_attn(p, lds, uni);)
  PHASE(21, 4, ph_wo(p, 1, p.Wob, lds);)
  PHASE(22, 0, norm_phase<2, -1>(p, pj, true, p.final_g, nullptr, nullptr, nullptr, p.out, lds);)
}

static inline size_t MiB(double x) { return (size_t)(x * 1048576.0); }

extern "C" void kernel_launch(void* const* d_in, const int* in_sizes, int n_in, void* d_out, int out_size, void* d_ws, size_t ws_size, hipStream_t stream) {
  (void)in_sizes; (void)n_in; (void)out_size;
  P p; memset(&p, 0, sizeof(P));
  PJ pj; memset(&pj, 0, sizeof(PJ));
  const float* const* in = (const float* const*)d_in;
  p.x = in[0]; p.a_norm_g = in[1]; p.a_mu = in[2];
  const float* a_w_rkvz = in[3];
  p.a_w0 = in[4]; const float* a_w1 = in[5]; const float* a_w2 = in[6];
  p.a_a0 = in[7]; const float* a_a1 = in[8]; const float* a_a2 = in[9];
  p.a_v0 = in[10]; const float* a_v1 = in[11]; const float* a_v2 = in[12];
  p.a_k_k = in[13]; p.a_k_a = in[14]; p.a_r_k = in[15]; p.a_ln_g = in[16]; p.a_ln_b = in[17];
  const float* a_w_o = in[18];
  p.kv_norm_g = in[19]; const float* kv_w = in[20]; p.cmp_pe = in[21]; const float* cmp_w1 = in[22]; const float* cmp_w2 = in[23];
  p.b_norm_g = in[24]; const float* b_w_in = in[25]; p.b_gate_b = in[26]; const float* b_w_o = in[27]; p.final_g = in[28];
  p.out = (float*)d_out;
  if (ws_size < MiB(512)) { fprintf(stderr, "workspace too small: %zu\n", ws_size); return; }
  char* ws = (char*)d_ws;
  p.ysum = (bf16_t*)(ws + MiB(0)); p.ubuf = (bf16_t*)(ws + MiB(64)); p.r = (bf16_t*)(ws + MiB(128)); p.k = (bf16_t*)(ws + MiB(192));
  p.vA = (bf16_t*)(ws + MiB(256)); p.z = (bf16_t*)(ws + MiB(320)); p.vB = (bf16_t*)(ws + MiB(384));
  p.hn = (bf16_t*)(ws + MiB(128)); p.ocmp = p.hn; p.q = (bf16_t*)(ws + MiB(192)); p.sz = (bf16_t*)(ws + MiB(256));
  p.kc = (bf16_t*)(ws + MiB(320)); p.vc = (bf16_t*)(ws + MiB(336)); p.ks = (bf16_t*)(ws + MiB(352)); p.vsT = (bf16_t*)(ws + MiB(368));
  p.kw = (bf16_t*)(ws + MiB(384)); p.vwT = (bf16_t*)(ws + MiB(400));
  p.hc = (bf16_t*)(ws + MiB(416)); p.kcmp = (bf16_t*)(ws + MiB(420)); p.vcmpT = (bf16_t*)(ws + MiB(421));
  p.gates = (float*)(ws + MiB(422)); p.selmask = (unsigned*)(ws + MiB(425));
  char* ar = ws + MiB(448);
  p.Wp = (bf16_t*)ar;
  p.W2w = (bf16_t*)(ar + MiB(33.5)); p.W2a = (bf16_t*)(ar + MiB(34)); p.W2v = (bf16_t*)(ar + MiB(34.5));
  p.Wo = (bf16_t*)(ar + MiB(35));
  p.Wkv = (bf16_t*)ar;
  p.Win = (bf16_t*)(ar + MiB(12));
  p.Wc1 = (bf16_t*)(ar + MiB(28.5));
  p.Wc2 = (bf16_t*)(ar + MiB(32.5));
  p.Wob = (bf16_t*)(ar + MiB(33));
  p.lw = (bf16_t*)(ws + MiB(492)); p.la = (bf16_t*)(ws + MiB(496)); p.lv = (bf16_t*)(ws + MiB(500));
  unsigned* bar = (unsigned*)(ws + MiB(508));
  p.bon = (float*)(ws + MiB(504)); p.ropec = (float*)(ws + MiB(506)); p.ropes = (float*)(ws + MiB(506.5));

  int nj = 0, tile = 0;
  auto add = [&](const float* src, bf16_t* dst, int K, int N, int ld, int Kpad, int Npad) {
    ConvJob& j = pj.jobs[nj++]; j.src = src; j.dst = dst; j.K = K; j.N = N; j.ld = ld; j.Kpad = Kpad; j.Npad = Npad; j.tile0 = tile;
    tile += (Kpad / 64) * (Npad / 64);
  };
  const size_t DD = (size_t)DM * DM;
  for (int L = 0; L < 2; ++L) {
    tile = 0;
    for (int n4 = 0; n4 < 4; ++n4) add(a_w_rkvz + (size_t)(L * 4 + n4) * DD, p.Wp + (size_t)n4 * DD, DM, DM, DM, DM, DM);
    add(a_w1 + (size_t)L * DM * 96, p.Wp + (size_t)8192 * DM, DM, 96, 96, DM, 128);
    add(a_a1 + (size_t)L * DM * 96, p.Wp + (size_t)8320 * DM, DM, 96, 96, DM, 128);
    if (L == 1) add(a_v1, p.Wp + (size_t)8448 * DM, DM, 64, 64, DM, 128);
    add(a_w2 + (size_t)L * 96 * DM, p.W2w, 96, DM, DM, 128, DM);
    add(a_a2 + (size_t)L * 96 * DM, p.W2a, 96, DM, DM, 128, DM);
    if (L == 1) add(a_v2, p.W2v, 64, DM, DM, 128, DM);
    add(a_w_o + (size_t)L * DD, p.Wo, DM, DM, DM, DM, DM);
    pj.stage_tiles[L] = tile;
  }
  tile = 0;
  add(kv_w, p.Wkv, DM, 3072, 3072, DM, 3072);
  for (int j = 0; j < 2; ++j) add(cmp_w1 + (size_t)j * 4096 * 256, p.Wc1 + (size_t)j * 256 * 4096, 4096, 256, 256, 4096, 256);
  for (int j = 0; j < 2; ++j) add(cmp_w2 + (size_t)j * 256 * 128, p.Wc2 + (size_t)j * 128 * 256, 256, 128, 128, 256, 128);
  for (int L = 0; L < 2; ++L) {
    if (L == 1) { pj.stage_tiles[2] = tile; tile = 0; }
    const float* wi = b_w_in + (size_t)L * DM * 4144;
    add(wi, p.Win, DM, 2048, 4144, DM, 2048);
    add(wi + 2096, p.Win + (size_t)2048 * DM, DM, 2048, 4144, DM, 2048);
    add(wi + 2048, p.Win + (size_t)4096 * DM, DM, 48, 4144, DM, 128);
    add(b_w_o + (size_t)L * DD, p.Wob, DM, DM, DM, DM, DM);
  }
  pj.stage_tiles[3] = tile;
  for (int i = 0; i < 16; ++i) pj.rope_inv[i] = (float)pow(500000.0, -(double)i / 16.0);

  static int grid_blocks = 0;
  if (!grid_blocks) {
    int dev = 0, cus = 0, per_cu = 0;
    hipGetDevice(&dev);
    hipDeviceGetAttribute(&cus, hipDeviceAttributeMultiprocessorCount, dev);
    hipOccupancyMaxActiveBlocksPerMultiprocessor(&per_cu, fwd_kernel, NTHREADS, 0);
    if (per_cu > 2) per_cu = 2;
    if (per_cu < 1) per_cu = 1;
    grid_blocks = cus * per_cu;
  }
#if ONE_LAUNCH
  hipMemsetAsync(bar, 0, 64 * 32 * 4, stream);
  int lo = 0, hi = NPHASE;
  void* args[] = {(void*)&p, (void*)&pj, (void*)&bar, (void*)&lo, (void*)&hi};
  hipError_t e = hipLaunchCooperativeKernel((void*)fwd_kernel, dim3(grid_blocks), dim3(NTHREADS), args, 0, stream);
  if (e != hipSuccess) fprintf(stderr, "cooperative launch failed: %s (grid %d)\n", hipGetErrorString(e), grid_blocks);
#else
  for (int ph = 0; ph < NPHASE; ++ph) {
    hipLaunchKernelGGL(fwd_kernel, dim3(grid_blocks), dim3(NTHREADS), 0, stream, p, pj, bar, ph, ph + 1);
  }

#endif
}
```

```cpp
#include <hip/hip_runtime.h>
#include <hip/hip_cooperative_groups.h>
#include <cstdio>
#include <cstdint>
#include <cstring>
#include <cmath>
namespace cg = cooperative_groups;

#ifndef ONE_LAUNCH
#define ONE_LAUNCH 1
#endif

typedef unsigned short bf16_t;
typedef short bf16x8 __attribute__((ext_vector_type(8)));
typedef float f32x4 __attribute__((ext_vector_type(4)));
typedef float f32x16 __attribute__((ext_vector_type(16)));
typedef unsigned u32x4 __attribute__((ext_vector_type(4)));
typedef unsigned u32x2 __attribute__((ext_vector_type(2)));

#define MTOK 16384
#define TSEQ 4096
#define DM 2048
#define NTHREADS 256
#define QSCALE 0.12751743f
#define ATT_KSZ 17408
#define ATT_BUF 35840
#define LDS_BYTES 71680

struct ConvJob { const float* src; bf16_t* dst; int K, N, ld, Kpad, Npad, tile0; };

struct P {
  const float *x, *a_norm_g, *a_mu, *a_w0, *a_a0, *a_v0, *a_k_k, *a_k_a, *a_r_k, *a_ln_g, *a_ln_b;
  const float *kv_norm_g, *cmp_pe, *b_norm_g, *b_gate_b, *final_g;
  float* out;
  bf16_t *ysum, *ubuf, *r, *k, *vA, *z, *vB;
  bf16_t *lw, *la, *lv; float *bon; float *ropec, *ropes;
  bf16_t *Wp, *W2w, *W2a, *W2v, *Wo;
  bf16_t *Wkv, *Win, *Wc1, *Wc2, *Wob;
  bf16_t *hn, *q, *sz, *ocmp;
  bf16_t *kc, *vc, *ks, *vsT, *kw, *vwT, *hc, *kcmp, *vcmpT;
  float *gates; unsigned *selmask;
};
struct PJ {
  ConvJob jobs[33];
  float rope_inv[16];
  int stage_tiles[4];
};

typedef __bf16 bf16x2_t __attribute__((ext_vector_type(2)));
typedef float f32x2 __attribute__((ext_vector_type(2)));
__device__ __forceinline__ unsigned cvtpk(float lo, float hi) {
  f32x2 v = {lo, hi};
  bf16x2_t b = __builtin_convertvector(v, bf16x2_t);
  return __builtin_bit_cast(unsigned, b);
}
__device__ __forceinline__ bf16_t f2bf(float x) { return (bf16_t)(cvtpk(x, x) & 0xffffu); }
__device__ __forceinline__ float bflo(unsigned w) { return __uint_as_float(w << 16); }
__device__ __forceinline__ float bfhi(unsigned w) { return __uint_as_float(w & 0xffff0000u); }
__device__ __forceinline__ float bf2f(bf16_t v) { return __uint_as_float(((unsigned)v) << 16); }
__device__ __forceinline__ void unpack8(bf16x8 v, float* f) {
  u32x4 w = *reinterpret_cast<u32x4*>(&v);
#pragma unroll
  for (int i = 0; i < 4; ++i) { f[2 * i] = bflo(w[i]); f[2 * i + 1] = bfhi(w[i]); }
}
__device__ __forceinline__ bf16x8 pack8f(const float* f) {
  u32x4 w = {cvtpk(f[0], f[1]), cvtpk(f[2], f[3]), cvtpk(f[4], f[5]), cvtpk(f[6], f[7])};
  return *reinterpret_cast<bf16x8*>(&w);
}
__device__ __forceinline__ float sigmoidf_(float x) { return __builtin_amdgcn_rcpf(1.f + __expf(-x)); }
__device__ __forceinline__ float siluf_(float x) { return x * __builtin_amdgcn_rcpf(1.f + __expf(-x)); }
#define DPP(x, ctrl) __int_as_float(__builtin_amdgcn_mov_dpp(__float_as_int(x), ctrl, 0xF, 0xF, true))
__device__ __forceinline__ float sum8(float x) {
  x += DPP(x, 0xB1); x += DPP(x, 0x4E); x += DPP(x, 0x141); return x;
}
__device__ __forceinline__ float wave_sum(float x) {
#pragma unroll
  for (int o = 32; o >= 1; o >>= 1) x += __shfl_xor(x, o);
  return x;
}
__device__ __forceinline__ float swap32_max(float x) {
  auto rr = __builtin_amdgcn_permlane32_swap(__float_as_uint(x), __float_as_uint(x), false, false);
  return fmaxf(__uint_as_float(rr[0]), __uint_as_float(rr[1]));
}
__device__ __forceinline__ float swap32_sum(float x) {
  auto rr = __builtin_amdgcn_permlane32_swap(__float_as_uint(x), __float_as_uint(x), false, false);
  return __uint_as_float(rr[0]) + __uint_as_float(rr[1]);
}
__device__ __forceinline__ int crow(int r, int hi) { return (r & 3) + 8 * (r >> 2) + 4 * hi; }

__device__ __forceinline__ void conv_tile(const ConvJob& jb, int tile, char* lds) {
  float* T = (float*)lds;
  const int nkt = jb.Kpad >> 6;
  const int n0 = (tile / nkt) * 64, k0 = (tile % nkt) * 64;
  const int tx = threadIdx.x & 63, ty = threadIdx.x >> 6;
#pragma unroll 4
  for (int rr = 0; rr < 16; ++rr) {
    int kl = ty * 16 + rr, kk = k0 + kl, n = n0 + tx;
    float v = (kk < jb.K && n < jb.N) ? jb.src[(size_t)kk * jb.ld + n] : 0.f;
    T[kl * 65 + tx] = v;
  }
  __syncthreads();
  const int nl = threadIdx.x >> 2, kc = (threadIdx.x & 3) * 16;
  unsigned w[8];
#pragma unroll
  for (int i = 0; i < 8; ++i) w[i] = cvtpk(T[(kc + 2 * i) * 65 + nl], T[(kc + 2 * i + 1) * 65 + nl]);
  bf16_t* d = jb.dst + (size_t)(n0 + nl) * jb.Kpad + k0 + kc;
  *(u32x4*)d = u32x4{w[0], w[1], w[2], w[3]};
  *(u32x4*)(d + 8) = u32x4{w[4], w[5], w[6], w[7]};
  __syncthreads();
}

template <int MODE>
__device__ __forceinline__ void rmsnorm_row(const P& p, int row, bool has_y, const float* g1, bf16_t* o1, const float* g2, bf16_t* o2, float* of) {
  const int lane = threadIdx.x & 63;
  const float* xr = p.x + (size_t)row * DM;
  const bf16_t* yr = p.ysum + (size_t)row * DM;
  f32x4 v[8]; float ss = 0.f;
#pragma unroll
  for (int i = 0; i < 8; ++i) {
    int c = (lane + 64 * i) * 4;
    v[i] = *(const f32x4*)(xr + c);
    if (has_y) { u32x2 w = *(const u32x2*)(yr + c); v[i][0] += bflo(w[0]); v[i][1] += bfhi(w[0]); v[i][2] += bflo(w[1]); v[i][3] += bfhi(w[1]); }
    ss += v[i][0] * v[i][0] + v[i][1] * v[i][1] + v[i][2] * v[i][2] + v[i][3] * v[i][3];
  }
  ss = wave_sum(ss);
  const float rs = rsqrtf(ss * (1.f / DM) + 1e-6f);
#pragma unroll
  for (int i = 0; i < 8; ++i) {
    int c = (lane + 64 * i) * 4;
    f32x4 g = *(const f32x4*)(g1 + c);
    if (MODE == 2) {
      f32x4 y = {v[i][0] * rs * g[0], v[i][1] * rs * g[1], v[i][2] * rs * g[2], v[i][3] * rs * g[3]};
      *(f32x4*)(of + (size_t)row * DM + c) = y;
    } else {
      u32x2 w = {cvtpk(v[i][0] * rs * g[0], v[i][1] * rs * g[1]), cvtpk(v[i][2] * rs * g[2], v[i][3] * rs * g[3])};
      *(u32x2*)(o1 + (size_t)row * DM + c) = w;
      if (MODE == 1) {
        f32x4 gg = *(const f32x4*)(g2 + c);
        u32x2 w2 = {cvtpk(v[i][0] * rs * gg[0], v[i][1] * rs * gg[1]), cvtpk(v[i][2] * rs * gg[2], v[i][3] * rs * gg[3])};
        *(u32x2*)(o2 + (size_t)row * DM + c) = w2;
      }
    }
  }
}

template <int MODE, int STAGE>
__device__ __forceinline__ void norm_phase(const P& p, const PJ& pj, bool has_y, const float* g1, bf16_t* o1, const float* g2, bf16_t* o2, float* of, char* lds) {
  if constexpr (STAGE >= 0) {
    constexpr int J0 = STAGE == 0 ? 0 : STAGE == 1 ? 9 : STAGE == 2 ? 20 : 29;
    constexpr int J1 = STAGE == 0 ? 9 : STAGE == 1 ? 20 : STAGE == 2 ? 29 : 33;
    const int nt = pj.stage_tiles[STAGE];
    for (int t = blockIdx.x; t < nt; t += gridDim.x) {
      const float* jsrc = pj.jobs[J0].src; bf16_t* jdst = pj.jobs[J0].dst;
      int jK = pj.jobs[J0].K, jN = pj.jobs[J0].N, jld = pj.jobs[J0].ld, jKp = pj.jobs[J0].Kpad, jNp = pj.jobs[J0].Npad, jt0 = pj.jobs[J0].tile0;
#pragma unroll
      for (int j = J0 + 1; j < J1; ++j) {
        const bool cnd = t >= pj.jobs[j].tile0;
        jsrc = cnd ? pj.jobs[j].src : jsrc; jdst = cnd ? pj.jobs[j].dst : jdst;
        jK = cnd ? pj.jobs[j].K : jK; jN = cnd ? pj.jobs[j].N : jN; jld = cnd ? pj.jobs[j].ld : jld;
        jKp = cnd ? pj.jobs[j].Kpad : jKp; jNp = cnd ? pj.jobs[j].Npad : jNp; jt0 = cnd ? pj.jobs[j].tile0 : jt0;
      }
      ConvJob jb; jb.src = jsrc; jb.dst = jdst; jb.K = jK; jb.N = jN; jb.ld = jld; jb.Kpad = jKp; jb.Npad = jNp; jb.tile0 = jt0;
      conv_tile(jb, t - jt0, lds);
    }
    if constexpr (STAGE == 0) {
      for (int pos = blockIdx.x * NTHREADS + threadIdx.x; pos < TSEQ; pos += gridDim.x * NTHREADS) {
#pragma unroll
        for (int i = 0; i < 16; ++i) {
          const float ang = (float)pos * pj.rope_inv[i];
          const double a = (double)ang * 0.15915494309189535;
          const float fr = (float)(a - rint(a));
          p.ropec[pos * 16 + i] = __builtin_amdgcn_cosf(fr); p.ropes[pos * 16 + i] = __builtin_amdgcn_sinf(fr);
        }
      }
    }
  }
  const int gw = blockIdx.x * 4 + (threadIdx.x >> 6), nw = gridDim.x * 4;
  for (int row = gw; row < MTOK; row += nw) rmsnorm_row<MODE>(p, row, has_y, g1, o1, g2, o2, of);
}

enum { AL_PLAIN = 0, AL_MIX = 1, AL_CMP = 2 };
enum { EP_PROJ = 0, EP_RESID = 1, EP_KV = 2, EP_CMP1 = 3, EP_CMP2 = 4, EP_WIN = 5 };

struct GemmCtx {
  const bf16_t* A; int lda;
  const bf16_t* Bt; int K;
  const float* aux;
  int layer, j;
};

template <int NI>
__device__ __forceinline__ void store_rows_lds(bf16_t* base, const size_t ld, const int row0, const int cbase, f32x4 (&acc)[4][NI], char* lds, const bool rmw) {
  constexpr int RB = NI * 32 + 16;
  constexpr int CPR = NI * 2;
  const int lane = threadIdx.x & 63, wid = threadIdx.x >> 6, lr = lane & 15, lq = lane >> 4;
  char* W = lds + wid * (64 * RB);
#pragma unroll
  for (int mi = 0; mi < 4; ++mi)
#pragma unroll
    for (int ni = 0; ni < NI; ++ni)
#pragma unroll
      for (int j = 0; j < 4; ++j) *(bf16_t*)(W + (mi * 16 + lq * 4 + j) * RB + (ni * 16 + lr) * 2) = f2bf(acc[mi][ni][j]);
  __builtin_amdgcn_fence(__ATOMIC_RELEASE, "wavefront");
  __builtin_amdgcn_wave_barrier();
#pragma unroll 4
  for (int i = 0; i < CPR; ++i) {
    const int id = lane + 64 * i, row = id / CPR, cc = id % CPR;
    bf16x8 v = *(const bf16x8*)(W + row * RB + cc * 16);
    bf16_t* g = base + (size_t)(row0 + row) * ld + cbase + cc * 8;
    if (rmw) {
      float fa[8], fb[8]; unpack8(v, fa); unpack8(*(const bf16x8*)g, fb);
#pragma unroll
      for (int e = 0; e < 8; ++e) fa[e] += fb[e];
      v = pack8f(fa);
    }
    *(bf16x8*)g = v;
  }
}

template <int EP, int NI>
__device__ __forceinline__ void gemm_epilogue(const P& p, const GemmCtx& c, const int nt, const int m0, const int wr, const int lq, const int lr, const int cbase, f32x4 (&acc)[4][NI], char* lds) {
  const int rbase = m0 + wr * 64 + lq * 4; const int n0 = nt * 128;
  const int cl = cbase + lr;
  if constexpr (EP == EP_PROJ) {
    if (nt < 64) {
      const int which = nt >> 4;
      const int slab = which < 2 ? which : which == 3 ? 3 : (c.layer == 0 ? 2 : 4);
      bf16_t* dst = p.r + (size_t)slab * (32u << 20);
      store_rows_lds<NI>(dst + (nt & 15) * 128, DM, m0 + wr * 64, cbase, acc, lds, false);
    } else {
      bf16_t* dst = p.lw + (size_t)(nt - 64) * (2u << 20);
#pragma unroll
      for (int mi = 0; mi < 4; ++mi)
#pragma unroll
        for (int ni = 0; ni < NI; ++ni)
#pragma unroll
          for (int j = 0; j < 4; ++j) {
            float v = acc[mi][ni][j];
            if (nt == 64) v = 1.f - 2.f * __builtin_amdgcn_rcpf(1.f + __expf(2.f * v));
            dst[(size_t)(rbase + mi * 16 + j) * 128 + cl + ni * 16] = f2bf(v);
          }
    }
  } else if constexpr (EP == EP_RESID) {
    const bool has_y = c.layer != 0;
    store_rows_lds<NI>(p.ysum + n0, DM, m0 + wr * 64, cbase, acc, lds, has_y);
  } else if constexpr (EP == EP_KV || EP == EP_WIN || EP == EP_CMP2) {
    int kind;
    bool rope = false; float qs = 1.f;
    bf16_t* dst = nullptr; int bgidx = 0;
    if constexpr (EP == EP_KV) {
      const int i = nt >> 2, g = nt & 3; bgidx = g;
      kind = (i == 3 || i == 5) ? 1 : 0; rope = (i == 2 || i == 4);
      dst = p.kc + (size_t)i * (8u << 20);
    } else if constexpr (EP == EP_WIN) {
      kind = nt < 16 ? 0 : nt < 32 ? 2 : 3; rope = nt < 16; qs = nt < 16 ? QSCALE : 1.f;
      dst = p.q + (nt < 16 ? (size_t)0 : (size_t)(32u << 20));
    } else {
      kind = c.j == 0 ? 0 : 1; rope = c.j == 0; dst = p.kcmp + (size_t)c.j * (512u << 10);
    }
    if (rope && cbase == 0) {
#pragma unroll
      for (int mi = 0; mi < 4; ++mi)
#pragma unroll
        for (int j = 0; j < 4; ++j) {
          const int row = rbase + mi * 16 + j;
          int pos;
          if constexpr (EP == EP_CMP2) { pos = 16 * (row & 255) + 31; if (pos > TSEQ - 1) pos = TSEQ - 1; } else pos = row & (TSEQ - 1);
          const float cs = p.ropec[pos * 16 + lr], sn = p.ropes[pos * 16 + lr];
          const float x1 = acc[mi][0][j], x2 = acc[mi][1][j];
          acc[mi][0][j] = x1 * cs - x2 * sn; acc[mi][1][j] = x2 * cs + x1 * sn;
        }
    }
    if (kind == 0 || kind == 2) {
      const bool sil = kind == 2;
#pragma unroll
      for (int mi = 0; mi < 4; ++mi)
#pragma unroll
        for (int ni = 0; ni < NI; ++ni)
#pragma unroll
          for (int j = 0; j < 4; ++j) { const float v = acc[mi][ni][j]; acc[mi][ni][j] = sil ? siluf_(v) : v * qs; }
      bf16_t* base; size_t ld;
      if constexpr (EP == EP_KV) {
        const int i = nt >> 2;
        if (i < 2) { base = dst + bgidx * 128; ld = 512; }
        else { const int b = m0 >> 12; base = dst + (size_t)(3 * b + bgidx) * TSEQ * 128; ld = 128; }
      } else if constexpr (EP == EP_WIN) { base = dst + (nt & 15) * 128; ld = DM; }
      else { base = dst; ld = 128; }
      store_rows_lds<NI>(base, ld, m0 + wr * 64, cbase, acc, lds, false);
    } else if (kind == 1) {
#pragma unroll
      for (int mi = 0; mi < 4; ++mi)
#pragma unroll
        for (int ni = 0; ni < NI; ++ni) {
          const int row0 = m0 + wr * 64 + mi * 16;
          const int d = cl + ni * 16;
          const int slot = (lq & 1) * 8 + (lq >> 1) * 4;
          u32x2 w = {cvtpk(acc[mi][ni][0], acc[mi][ni][1]), cvtpk(acc[mi][ni][2], acc[mi][ni][3])};
          size_t idx;
          if constexpr (EP == EP_KV) { const int b = row0 >> 12, t0 = row0 & (TSEQ - 1); idx = ((size_t)((b * 4 + bgidx) * 128 + d)) * TSEQ + t0 + slot; }
          else { const int bg = row0 >> 8, c0 = row0 & 255; idx = ((size_t)(bg * 128 + d)) * 256 + c0 + slot; }
          *(u32x2*)(dst + idx) = w;
        }
    } else {
      const float* gb = p.b_gate_b + c.j * 48;
#pragma unroll
      for (int mi = 0; mi < 4; ++mi)
#pragma unroll
        for (int ni = 0; ni < NI; ++ni) {
          const int n = cl + ni * 16;
          if (n < 48) {
#pragma unroll
            for (int j = 0; j < 4; ++j) p.gates[(size_t)(rbase + mi * 16 + j) * 48 + n] = sigmoidf_(acc[mi][ni][j] + gb[n]);
          }
        }
    }
  } else if constexpr (EP == EP_CMP1) {
    bf16_t* dst = p.hc + (size_t)c.j * 4096 * 256;
#pragma unroll
    for (int mi = 0; mi < 4; ++mi)
#pragma unroll
      for (int ni = 0; ni < NI; ++ni)
#pragma unroll
        for (int j = 0; j < 4; ++j) dst[(size_t)(rbase + mi * 16 + j) * 256 + n0 + cl + ni * 16] = f2bf(siluf_(acc[mi][ni][j]));
  }
  __syncthreads();
}

template <int AL, int EP>
__device__ __forceinline__ void gemm_tile(const P& p, const GemmCtx& c, const int mt, const int nt, char* lds) {
  const int tid = threadIdx.x, lane = tid & 63, wid = tid >> 6;
  const int wr = wid >> 1, wc = wid & 1, lr = lane & 15, lq = lane >> 4;
  const int m0 = mt * 128, n0 = nt * 128;
  const int K = c.K, nk = K >> 6;
  const int lc = tid & 7, lrow = tid >> 3;
  f32x4 acc[4][4];
#pragma unroll
  for (int i = 0; i < 4; ++i)
#pragma unroll
    for (int j = 0; j < 4; ++j) acc[i][j] = f32x4{0.f, 0.f, 0.f, 0.f};
  bf16x8 ra[4], rp[4], rb[4]; f32x4 ax0, ax1;

  auto load_tile = [&](int kt) {
#pragma unroll
    for (int i = 0; i < 4; ++i) {
      const int row = lrow + 32 * i;
      rb[i] = *(const bf16x8*)(c.Bt + (size_t)(n0 + row) * K + kt * 64 + lc * 8);
      if constexpr (AL == AL_PLAIN) {
        ra[i] = *(const bf16x8*)(c.A + (size_t)(m0 + row) * c.lda + kt * 64 + lc * 8);
      } else if constexpr (AL == AL_MIX) {
        const int m = m0 + row;
        const bf16_t* src = c.A + (size_t)m * DM + kt * 64 + lc * 8;
        ra[i] = *(const bf16x8*)src;
        if ((m & (TSEQ - 1)) != 0) rp[i] = *(const bf16x8*)(src - DM); else rp[i] = bf16x8{0, 0, 0, 0, 0, 0, 0, 0};
      } else {
        const int R = m0 + row, bg = R >> 8, cc = R & 255, b = bg >> 2, g = bg & 3;
        const int l = kt >> 1, d = (kt & 1) * 64 + lc * 8;
        int t = 16 * cc + l; if (t > TSEQ - 1) t = TSEQ - 1;
        ra[i] = *(const bf16x8*)(c.A + ((size_t)(b * TSEQ + t)) * 512 + g * 128 + d);
      }
    }
    if constexpr (AL == AL_MIX) { const float* mu = c.aux + kt * 64 + lc * 8; ax0 = *(const f32x4*)mu; ax1 = *(const f32x4*)(mu + 4); }
    if constexpr (AL == AL_CMP) { const float* pe = c.aux + (kt >> 1) * 128 + (kt & 1) * 64 + lc * 8; ax0 = *(const f32x4*)pe; ax1 = *(const f32x4*)(pe + 4); }
  };
  auto store_tile = [&](int buf) {
    char* Ab = lds + buf * 32768; char* Bb = Ab + 16384;
#pragma unroll
    for (int i = 0; i < 4; ++i) {
      const int row = lrow + 32 * i;
      const int off = row * 128 + ((lc ^ (row & 7)) << 4);
      *(bf16x8*)(Bb + off) = rb[i];
      if constexpr (AL == AL_PLAIN) { *(bf16x8*)(Ab + off) = ra[i]; }
      else {
        float f[8]; unpack8(ra[i], f);
        const float mu[8] = {ax0[0], ax0[1], ax0[2], ax0[3], ax1[0], ax1[1], ax1[2], ax1[3]};
        if constexpr (AL == AL_MIX) {
          float fp[8]; unpack8(rp[i], fp);
#pragma unroll
          for (int e = 0; e < 8; ++e) f[e] = f[e] + (fp[e] - f[e]) * mu[e];
        } else {
#pragma unroll
          for (int e = 0; e < 8; ++e) f[e] = f[e] + mu[e];
        }
        *(bf16x8*)(Ab + off) = pack8f(f);
      }
    }
  };
  auto compute = [&](int buf) {
    const char* Ab = lds + buf * 32768; const char* Bb = Ab + 16384;
#pragma unroll
    for (int ks = 0; ks < 2; ++ks) {
      bf16x8 af[4], bfr[4];
#pragma unroll
      for (int mi = 0; mi < 4; ++mi) { const int row = wr * 64 + mi * 16 + lr; af[mi] = *(const bf16x8*)(Ab + row * 128 + (((ks * 4 + lq) ^ (row & 7)) << 4)); }
#pragma unroll
      for (int ni = 0; ni < 4; ++ni) { const int row = wc * 64 + ni * 16 + lr; bfr[ni] = *(const bf16x8*)(Bb + row * 128 + (((ks * 4 + lq) ^ (row & 7)) << 4)); }
#pragma unroll
      for (int mi = 0; mi < 4; ++mi)
#pragma unroll
        for (int ni = 0; ni < 4; ++ni) acc[mi][ni] = __builtin_amdgcn_mfma_f32_16x16x32_bf16(af[mi], bfr[ni], acc[mi][ni], 0, 0, 0);
    }
  };

  load_tile(0);
  store_tile(0);
  __syncthreads();
  for (int kt = 0; kt < nk; ++kt) {
    if (kt + 1 < nk) load_tile(kt + 1);
    __builtin_amdgcn_sched_barrier(0);
    compute(kt & 1);
    __builtin_amdgcn_sched_barrier(0);
    if (kt + 1 < nk) store_tile((kt + 1) & 1);
    __syncthreads();
  }

  gemm_epilogue<EP, 4>(p, c, nt, m0, wr, lq, lr, wc * 64, acc, lds);
}


template <int AL, int EP>
__device__ __forceinline__ void gemm_wide(const P& p, const GemmCtx& c, const int mt, const int nt2, char* lds) {
  const int tid = threadIdx.x, lane = tid & 63, wid = tid >> 6;
  const int wr = wid >> 1, wc = wid & 1, lr = lane & 15, lq = lane >> 4;
  const int m0 = mt * 128, n0 = nt2 * 256;
  const int K = c.K, nk = K >> 5;
  const bf16_t* A = c.A;
  const bf16_t* Bt = c.Bt;
  const float* mu = c.aux;
  const int lc = tid & 3, lrow = tid >> 2;
  f32x4 acc[4][8];
#pragma unroll
  for (int i = 0; i < 4; ++i)
#pragma unroll
    for (int j = 0; j < 8; ++j) acc[i][j] = f32x4{0.f, 0.f, 0.f, 0.f};
  bf16x8 ra[2], rp[2], rb[4]; f32x4 ax0, ax1;
  auto load_tile = [&](int kt) {
#pragma unroll
    for (int i = 0; i < 4; ++i) rb[i] = *(const bf16x8*)(Bt + (size_t)(n0 + lrow + 64 * i) * K + kt * 32 + lc * 8);
#pragma unroll
    for (int i = 0; i < 2; ++i) {
      const int m = m0 + lrow + 64 * i;
      const bf16_t* src = A + (size_t)m * c.lda + kt * 32 + lc * 8;
      ra[i] = *(const bf16x8*)src;
      if constexpr (AL == AL_MIX) { if ((m & (TSEQ - 1)) != 0) rp[i] = *(const bf16x8*)(src - DM); else rp[i] = bf16x8{0, 0, 0, 0, 0, 0, 0, 0}; }
    }
    if constexpr (AL == AL_MIX) { ax0 = *(const f32x4*)(mu + kt * 32 + lc * 8); ax1 = *(const f32x4*)(mu + kt * 32 + lc * 8 + 4); }
  };
  auto store_tile = [&](int buf) {
    char* Ab = lds + buf * 24576; char* Bb = Ab + 8192;
#pragma unroll
    for (int i = 0; i < 4; ++i) { const int row = lrow + 64 * i; *(bf16x8*)(Bb + row * 64 + ((lc ^ ((-(row >> 2)) & 3)) << 4)) = rb[i]; }
#pragma unroll
    for (int i = 0; i < 2; ++i) {
      const int row = lrow + 64 * i;
      if constexpr (AL == AL_MIX) {
        const float muv[8] = {ax0[0], ax0[1], ax0[2], ax0[3], ax1[0], ax1[1], ax1[2], ax1[3]};
        float f[8], fp[8]; unpack8(ra[i], f); unpack8(rp[i], fp);
#pragma unroll
        for (int e = 0; e < 8; ++e) f[e] = f[e] + (fp[e] - f[e]) * muv[e];
        *(bf16x8*)(Ab + row * 64 + ((lc ^ ((-(row >> 2)) & 3)) << 4)) = pack8f(f);
      } else {
        *(bf16x8*)(Ab + row * 64 + ((lc ^ ((-(row >> 2)) & 3)) << 4)) = ra[i];
      }
    }
  };
  auto compute = [&](int buf) {
    const char* Ab = lds + buf * 24576; const char* Bb = Ab + 8192;
    const int sw = (lq ^ ((-(lr >> 2)) & 3)) << 4;
    bf16x8 af[4];
#pragma unroll
    for (int mi = 0; mi < 4; ++mi) af[mi] = *(const bf16x8*)(Ab + (wr * 64 + mi * 16 + lr) * 64 + sw);
#pragma unroll
    for (int nh = 0; nh < 2; ++nh) {
      bf16x8 bfr[4];
#pragma unroll
      for (int ni = 0; ni < 4; ++ni) bfr[ni] = *(const bf16x8*)(Bb + (wc * 128 + (nh * 4 + ni) * 16 + lr) * 64 + sw);
#pragma unroll
      for (int mi = 0; mi < 4; ++mi)
#pragma unroll
        for (int ni = 0; ni < 4; ++ni) acc[mi][nh * 4 + ni] = __builtin_amdgcn_mfma_f32_16x16x32_bf16(af[mi], bfr[ni], acc[mi][nh * 4 + ni], 0, 0, 0);
    }
  };
  load_tile(0);
  store_tile(0);
  __syncthreads();
  for (int kt = 0; kt < nk; ++kt) {
    if (kt + 1 < nk) load_tile(kt + 1);
    __builtin_amdgcn_sched_barrier(0);
    compute(kt & 1);
    __builtin_amdgcn_sched_barrier(0);
    if (kt + 1 < nk) store_tile((kt + 1) & 1);
    __syncthreads();
  }
  gemm_epilogue<EP, 8>(p, c, 2 * nt2 + wc, m0, wr, lq, lr, 0, acc, lds);
}

__device__ __forceinline__ float sum16(float x) {
  x += DPP(x, 0xB1); x += DPP(x, 0x4E); x += DPP(x, 0x141); x += DPP(x, 0x140); return x;
}
__device__ __forceinline__ void scan_item(const P& p, const int layer, const int item, char* lds) {
  const int quarter = item & 3, h = (item >> 2) & 31, b = item >> 7;
  const int tid = threadIdx.x, lane = tid & 63, wid = tid >> 6;
  float* R = (float*)lds;
  float* W = R + 2048; float* Kk = W + 2048; float* Aa = Kk + 2048; float* Bv = Aa + 2048;
  float* V = Bv + 2048;
  float* Vg = V + 512;
  float* O = Vg + 512;
  float* KKp = O + 528; float* KAp = KKp + 64; float* RKp = KAp + 64;
  float* LBp = RKp + 64;
  const bf16_t* vsrc = p.vA + (size_t)layer * (64u << 20);
  bf16_t* vdst = p.vB;
  const int tl = tid >> 3, c8 = tid & 7;
  const int ch0 = h * 64 + c8 * 8;
  const int vc0 = h * 64 + quarter * 16;
  const int lr = lane & 15, lq = lane >> 4;
  const int ten = wid >> 1, lmi = wid & 1;
  const bf16_t* lA = p.lw + (size_t)ten * (2u << 20);
  const bf16_t* lB = p.W2w + (size_t)ten * (256u << 10);
  if (tid < 64) {
    KKp[tid] = p.a_k_k[layer * DM + h * 64 + tid]; KAp[tid] = p.a_k_a[layer * DM + h * 64 + tid]; RKp[tid] = p.a_r_k[layer * DM + h * 64 + tid];
  }
  if (tid < 128) { const float b0_ = p.a_w0[layer * DM + h * 64 + (tid & 63)], b1_ = p.a_a0[layer * DM + h * 64 + (tid & 63)]; LBp[tid] = tid < 64 ? b0_ : b1_; }
  if (tid >= 128 && tid < 144) LBp[tid] = layer == 1 ? p.a_v0[vc0 + (tid - 128)] : 0.f;
  const int row = tid >> 4, kq = tid & 15;
  f32x2 S01 = {0.f, 0.f}, S23 = {0.f, 0.f};

  const size_t tok0 = (size_t)b * TSEQ;
  bf16x8 rr, rk, rv, rvf;
  bf16x8 wB[3][4], wBv[2], fA[3], fAv[2];
#pragma unroll
  for (int ks = 0; ks < 3; ++ks)
#pragma unroll
    for (int ni = 0; ni < 4; ++ni) wB[ks][ni] = *(const bf16x8*)(lB + (size_t)(h * 64 + ni * 16 + lr) * 128 + ks * 32 + lq * 8);
  if (layer == 1) {
#pragma unroll
    for (int ks = 0; ks < 2; ++ks) wBv[ks] = *(const bf16x8*)(p.W2v + (size_t)(vc0 + lr) * 128 + ks * 32 + lq * 8);
  }
  auto load_raw = [&](int c) {
    const size_t m = tok0 + c * 32 + tl;
    {
      const size_t ml = tok0 + c * 32 + lmi * 16 + lr;
#pragma unroll
      for (int ks = 0; ks < 3; ++ks) fA[ks] = *(const bf16x8*)(lA + ml * 128 + ks * 32 + lq * 8);
      if (layer == 1) {
#pragma unroll
        for (int ks = 0; ks < 2; ++ks) fAv[ks] = *(const bf16x8*)(p.lv + ml * 128 + ks * 32 + lq * 8);
      }
    }
    rr = *(const bf16x8*)(p.r + m * DM + ch0);
    rk = *(const bf16x8*)(p.k + m * DM + ch0);
    if (c8 < 2) {
      rv = *(const bf16x8*)(vsrc + m * DM + vc0 + c8 * 8);
      if (layer == 1) rvf = *(const bf16x8*)(p.vA + m * DM + vc0 + c8 * 8);
    }
  };
  load_raw(0);
  __syncthreads();
  for (int c = 0; c < TSEQ / 32; ++c) {
    const size_t mc = tok0 + c * 32;
    {
      f32x4 acc[4];
#pragma unroll
      for (int ni = 0; ni < 4; ++ni) acc[ni] = f32x4{0.f, 0.f, 0.f, 0.f};
#pragma unroll
      for (int ks = 0; ks < 3; ++ks) {
#pragma unroll
        for (int ni = 0; ni < 4; ++ni) acc[ni] = __builtin_amdgcn_mfma_f32_16x16x32_bf16(fA[ks], wB[ks][ni], acc[ni], 0, 0, 0);
      }
      float* dstL = ten == 0 ? W : Bv;
#pragma unroll
      for (int ni = 0; ni < 4; ++ni)
#pragma unroll
        for (int j = 0; j < 4; ++j) {
          float sg = sigmoidf_(acc[ni][j] + LBp[ten * 64 + ni * 16 + lr]);
          float val = ten == 0 ? __expf(-0.6065306597126334f * sg) : sg;
          dstL[(lmi * 16 + lq * 4 + j) * 64 + ni * 16 + lr] = val;
        }
      if (layer == 1 && wid < 2) {
        f32x4 av = f32x4{0.f, 0.f, 0.f, 0.f};
#pragma unroll
        for (int ks = 0; ks < 2; ++ks) av = __builtin_amdgcn_mfma_f32_16x16x32_bf16(fAv[ks], wBv[ks], av, 0, 0, 0);
#pragma unroll
        for (int j = 0; j < 4; ++j) Vg[(wid * 16 + lq * 4 + j) * 16 + lr] = sigmoidf_(av[j] + LBp[128 + lr]);
      }
    }
    if (c > 0) {
      const float o0 = O[(c8 * 2) * 33 + tl], o1 = O[(c8 * 2 + 1) * 33 + tl];
      *(unsigned*)(p.ubuf + (mc - 32 + tl) * DM + vc0 + c8 * 2) = cvtpk(o0, o1);
    }
    __syncthreads();
    {
      float fr[8], fk[8], fa[8];
      unpack8(rr, fr); unpack8(rk, fk);
      { f32x4 a0 = *(const f32x4*)(Bv + tl * 64 + c8 * 8), a1 = *(const f32x4*)(Bv + tl * 64 + c8 * 8 + 4);
        fa[0] = a0[0]; fa[1] = a0[1]; fa[2] = a0[2]; fa[3] = a0[3]; fa[4] = a1[0]; fa[5] = a1[1]; fa[6] = a1[2]; fa[7] = a1[3]; }
      float kk[8], ss = 0.f, bsum = 0.f;
      float kkv[8], kav[8], rkv[8];
      { f32x4 t0 = *(const f32x4*)(KKp + c8 * 8), t1 = *(const f32x4*)(KKp + c8 * 8 + 4);
        kkv[0] = t0[0]; kkv[1] = t0[1]; kkv[2] = t0[2]; kkv[3] = t0[3]; kkv[4] = t1[0]; kkv[5] = t1[1]; kkv[6] = t1[2]; kkv[7] = t1[3];
        t0 = *(const f32x4*)(KAp + c8 * 8); t1 = *(const f32x4*)(KAp + c8 * 8 + 4);
        kav[0] = t0[0]; kav[1] = t0[1]; kav[2] = t0[2]; kav[3] = t0[3]; kav[4] = t1[0]; kav[5] = t1[1]; kav[6] = t1[2]; kav[7] = t1[3];
        t0 = *(const f32x4*)(RKp + c8 * 8); t1 = *(const f32x4*)(RKp + c8 * 8 + 4);
        rkv[0] = t0[0]; rkv[1] = t0[1]; rkv[2] = t0[2]; rkv[3] = t0[3]; rkv[4] = t1[0]; rkv[5] = t1[1]; rkv[6] = t1[2]; rkv[7] = t1[3]; }
#pragma unroll
      for (int e = 0; e < 8; ++e) { kk[e] = fk[e] * kkv[e]; ss += kk[e] * kk[e]; }
      ss = sum8(ss);
      const float inv = __builtin_amdgcn_rsqf(fmaxf(ss, 1e-24f));
      float kp[8], na[8], bb[8];
#pragma unroll
      for (int e = 0; e < 8; ++e) {
        kk[e] *= inv;
        kp[e] = fk[e] * (1.f + (fa[e] - 1.f) * kav[e]);
        na[e] = -kk[e]; bb[e] = kk[e] * fa[e];
        bsum += fr[e] * kp[e] * rkv[e];
      }
      bsum = sum8(bsum);
      float* d;
      d = R + tl * 64 + c8 * 8;  *(f32x4*)d = f32x4{fr[0], fr[1], fr[2], fr[3]}; *(f32x4*)(d + 4) = f32x4{fr[4], fr[5], fr[6], fr[7]};
      d = Kk + tl * 64 + c8 * 8; *(f32x4*)d = f32x4{kp[0], kp[1], kp[2], kp[3]}; *(f32x4*)(d + 4) = f32x4{kp[4], kp[5], kp[6], kp[7]};
      d = Aa + tl * 64 + c8 * 8; *(f32x4*)d = f32x4{na[0], na[1], na[2], na[3]}; *(f32x4*)(d + 4) = f32x4{na[4], na[5], na[6], na[7]};
      d = Bv + tl * 64 + c8 * 8; *(f32x4*)d = f32x4{bb[0], bb[1], bb[2], bb[3]}; *(f32x4*)(d + 4) = f32x4{bb[4], bb[5], bb[6], bb[7]};
      if (quarter == 0 && c8 == 0) p.bon[(mc + tl) * 32 + h] = bsum;
      if (c8 < 2) {
        float fv[8]; unpack8(rv, fv);
        if (layer == 1) {
          float ff[8]; unpack8(rvf, ff);
          f32x4 g0 = *(const f32x4*)(Vg + tl * 16 + c8 * 8), g1 = *(const f32x4*)(Vg + tl * 16 + c8 * 8 + 4);
          const float gg[8] = {g0[0], g0[1], g0[2], g0[3], g1[0], g1[1], g1[2], g1[3]};
#pragma unroll
          for (int e = 0; e < 8; ++e) fv[e] = fv[e] + (ff[e] - fv[e]) * gg[e];
          *(bf16x8*)(vdst + (mc + tl) * DM + vc0 + c8 * 8) = pack8f(fv);
        }
        d = V + tl * 16 + c8 * 8; *(f32x4*)d = f32x4{fv[0], fv[1], fv[2], fv[3]}; *(f32x4*)(d + 4) = f32x4{fv[4], fv[5], fv[6], fv[7]};
      }
    }
    __syncthreads();
    if (c + 1 < TSEQ / 32) load_raw(c + 1);
    {
      f32x4 xa, xw, xk, xb, xr, na_, nw_, nk_, nb_, nr_; float xv, nv;
      const float* bA = Aa + kq * 4; const float* bW = W + kq * 4; const float* bK = Kk + kq * 4; const float* bB = Bv + kq * 4; const float* bR = R + kq * 4;
      xa = *(const f32x4*)bA; xw = *(const f32x4*)bW; xk = *(const f32x4*)bK; xb = *(const f32x4*)bB; xr = *(const f32x4*)bR; xv = V[row];
      float opend = 0.f;
#pragma unroll 8
      for (int t = 0; t < 32; ++t) {
        const f32x2 xa01 = {xa[0], xa[1]}, xa23 = {xa[2], xa[3]};
        f32x2 pa = S01 * xa01; pa = __builtin_elementwise_fma(S23, xa23, pa);
        float ra_ = pa[0] + pa[1];
        __builtin_amdgcn_sched_barrier(0);
        {
          const int o_ = ((t + 1) & 31) * 64;
          na_ = *(const f32x4*)(bA + o_); nw_ = *(const f32x4*)(bW + o_); nk_ = *(const f32x4*)(bK + o_); nb_ = *(const f32x4*)(bB + o_); nr_ = *(const f32x4*)(bR + o_);
          nv = V[((t + 1) & 31) * 16 + row];
        }
        float ro_ = opend;
        ra_ += DPP(ra_, 0xB1); ro_ += DPP(ro_, 0xB1);
        ra_ += DPP(ra_, 0x4E); ro_ += DPP(ro_, 0x4E);
        ra_ += DPP(ra_, 0x141); ro_ += DPP(ro_, 0x141);
        ra_ += DPP(ra_, 0x140); ro_ += DPP(ro_, 0x140);
        O[row * 33 + ((t - 1) & 31)] = ro_;
        const f32x2 sa2 = {ra_, ra_}, xv2 = {xv, xv};
        const f32x2 xk01 = {xk[0], xk[1]}, xk23 = {xk[2], xk[3]}, xb01 = {xb[0], xb[1]}, xb23 = {xb[2], xb[3]};
        const f32x2 xw01 = {xw[0], xw[1]}, xw23 = {xw[2], xw[3]}, xr01 = {xr[0], xr[1]}, xr23 = {xr[2], xr[3]};
        S01 = __builtin_elementwise_fma(S01, xw01, __builtin_elementwise_fma(sa2, xb01, xv2 * xk01));
        S23 = __builtin_elementwise_fma(S23, xw23, __builtin_elementwise_fma(sa2, xb23, xv2 * xk23));
        f32x2 po = S01 * xr01; po = __builtin_elementwise_fma(S23, xr23, po);
        opend = po[0] + po[1];
        xa = na_; xw = nw_; xk = nk_; xb = nb_; xr = nr_; xv = nv;
      }
      { const float ro_ = sum16(opend); O[row * 33 + 31] = ro_; }
    }
    __syncthreads();
  }
  {
    const size_t mp = tok0 + (TSEQ - 32);
    const float o0 = O[(c8 * 2) * 33 + tl], o1 = O[(c8 * 2 + 1) * 33 + tl];
    *(unsigned*)(p.ubuf + (mp + tl) * DM + vc0 + c8 * 2) = cvtpk(o0, o1);
  }
  __syncthreads();
}

__device__ __forceinline__ void postscan_phase(const P& p, const int layer) {
  const int tid = threadIdx.x, head = tid >> 3, ch = tid * 8;
  const bf16_t* vsrc = p.vA + (size_t)layer * (64u << 20);
  float lg[8], lb[8];
  {
    const float* pg = p.a_ln_g + layer * DM + ch; const float* pb = p.a_ln_b + layer * DM + ch;
#pragma unroll
    for (int e = 0; e < 8; ++e) { lg[e] = pg[e]; lb[e] = pb[e]; }
  }
  for (int m0 = blockIdx.x; m0 < MTOK; m0 += 4 * gridDim.x) {
    bf16x8 ro[4], rv[4], rz[4]; float bn[4];
#pragma unroll
    for (int u = 0; u < 4; ++u) {
      const int m = m0 + u * gridDim.x;
      if (m < MTOK) {
        ro[u] = *(const bf16x8*)(p.ubuf + (size_t)m * DM + ch);
        rv[u] = *(const bf16x8*)(vsrc + (size_t)m * DM + ch);
        rz[u] = *(const bf16x8*)(p.z + (size_t)m * DM + ch);
        bn[u] = p.bon[(size_t)m * 32 + head];
      }
    }
#pragma unroll
    for (int u = 0; u < 4; ++u) {
      const int m = m0 + u * gridDim.x;
      if (m < MTOK) {
        float fo[8], fv[8], fz[8];
        unpack8(ro[u], fo); unpack8(rv[u], fv); unpack8(rz[u], fz);
        float sm = 0.f;
#pragma unroll
        for (int e = 0; e < 8; ++e) sm += fo[e];
        const float mean = sum8(sm) * (1.f / 64.f);
        float sv = 0.f;
#pragma unroll
        for (int e = 0; e < 8; ++e) { fo[e] -= mean; sv += fo[e] * fo[e]; }
        const float rstd = rsqrtf(sum8(sv) * (1.f / 64.f) + 64e-5f);
#pragma unroll
        for (int e = 0; e < 8; ++e) fo[e] = (fo[e] * rstd * lg[e] + lb[e] + bn[u] * fv[e]) * siluf_(fz[e]);
        *(bf16x8*)(p.ubuf + (size_t)m * DM + ch) = pack8f(fo);
      }
    }
  }
}

__device__ __forceinline__ void cmp_item(const P& p, const int item, char* lds) {
  const int qb = (item & 512) ? 63 - (item & 63) : (item & 63), g = (item >> 6) & 3, b = item >> 8;
  const int bg = b * 4 + g;
  const int tid = threadIdx.x, lane = tid & 63, w = tid >> 6;
  const int n = lane & 31, hi = lane >> 5;
  float* impM = (float*)lds;
  float* impS = impM + 64 * 68;
  for (int e = lane; e < 16 * 68; e += 64) { impM[w * 16 * 68 + e] = 0.f; impS[w * 16 * 68 + e] = 0.f; }
  const int ql = 16 * w + (n & 15);
  const int tq = qb * 64 + ql;
  const size_t m = (size_t)b * TSEQ + tq;
  const int cmaxq = (tq - 31) >> 4;
  const int nkt = (4 * qb + 3 + 31) >> 5;
  const bf16_t* Kc = p.kcmp + (size_t)bg * 256 * 128;
  const bf16_t* Vc = p.vcmpT + (size_t)bg * 128 * 256;
  const float NEG = -__builtin_inff();
#pragma unroll 1
  for (int ct = 0; ct < 2; ++ct) {
    const int head = g * 4 + 2 * ct + (n >> 4);
    bf16x8 qf[8];
#pragma unroll
    for (int d0 = 0; d0 < 8; ++d0) qf[d0] = *(const bf16x8*)(p.q + m * DM + head * 128 + d0 * 16 + hi * 8);
    float mx = -1e30f, l = 0.f;
#pragma unroll 1
    for (int kt = 0; kt < nkt; ++kt) {
      f32x16 sc; for (int r = 0; r < 16; ++r) sc[r] = 0.f;
#pragma unroll
      for (int d0 = 0; d0 < 8; ++d0) {
        bf16x8 kf = *(const bf16x8*)(Kc + (size_t)(kt * 32 + n) * 128 + d0 * 16 + hi * 8);
        sc = __builtin_amdgcn_mfma_f32_32x32x16_bf16(kf, qf[d0], sc, 0, 0, 0);
      }
      float tm = NEG;
#pragma unroll
      for (int r = 0; r < 16; ++r) { const int cc = kt * 32 + crow(r, hi); if (cc > cmaxq) sc[r] = NEG; tm = fmaxf(tm, sc[r]); }
      tm = swap32_max(tm);
      const float mn = fmaxf(mx, tm);
      float ps = 0.f;
#pragma unroll
      for (int r = 0; r < 16; ++r) ps += __builtin_amdgcn_exp2f(sc[r] - mn);
      ps = swap32_sum(ps);
      l = l * __builtin_amdgcn_exp2f(mx - mn) + ps; mx = mn;
    }
    const float inv_l = l > 0.f ? 1.f / l : 0.f;
    f32x16 o[4];
#pragma unroll
    for (int dt = 0; dt < 4; ++dt) for (int r = 0; r < 16; ++r) o[dt][r] = 0.f;
#pragma unroll 1
    for (int kt = 0; kt < nkt; ++kt) {
      f32x16 sc; for (int r = 0; r < 16; ++r) sc[r] = 0.f;
#pragma unroll
      for (int d0 = 0; d0 < 8; ++d0) {
        bf16x8 kf = *(const bf16x8*)(Kc + (size_t)(kt * 32 + n) * 128 + d0 * 16 + hi * 8);
        sc = __builtin_amdgcn_mfma_f32_32x32x16_bf16(kf, qf[d0], sc, 0, 0, 0);
      }
      float pr[16];
#pragma unroll
      for (int r = 0; r < 16; ++r) { const int cc = kt * 32 + crow(r, hi); pr[r] = (cc > cmaxq) ? 0.f : __builtin_amdgcn_exp2f(sc[r] - mx) * inv_l; }
#pragma unroll
      for (int a = 0; a < 4; ++a) {
        float mainv = pr[4 * a] + pr[4 * a + 1] + pr[4 * a + 2] + 0.5f * pr[4 * a + 3];
        float spill = 0.5f * pr[4 * a + 3];
        mainv += __shfl_xor(mainv, 16); spill += __shfl_xor(spill, 16);
        if ((n & 16) == 0) {
          const int jj = 8 * kt + 2 * a + hi;
          impM[ql * 68 + jj] += mainv; impS[ql * 68 + jj + 1] += spill;
        }
      }
      const float pf0[8] = {pr[0], pr[1], pr[2], pr[3], pr[4], pr[5], pr[6], pr[7]};
      const float pf1[8] = {pr[8], pr[9], pr[10], pr[11], pr[12], pr[13], pr[14], pr[15]};
      const bf16x8 pb0 = pack8f(pf0), pb1 = pack8f(pf1);
#pragma unroll
      for (int dt = 0; dt < 4; ++dt) {
        const bf16_t* vp = Vc + (size_t)(dt * 32 + n) * 256 + kt * 32 + hi * 8;
        bf16x8 v0 = *(const bf16x8*)vp, v1 = *(const bf16x8*)(vp + 16);
        o[dt] = __builtin_amdgcn_mfma_f32_32x32x16_bf16(v0, pb0, o[dt], 0, 0, 0);
        o[dt] = __builtin_amdgcn_mfma_f32_32x32x16_bf16(v1, pb1, o[dt], 0, 0, 0);
      }
    }
    const float gt = p.gates[m * 48 + head * 3 + 0];
#pragma unroll
    for (int dt = 0; dt < 4; ++dt)
#pragma unroll
      for (int a = 0; a < 4; ++a) {
        u32x2 wv = {cvtpk(o[dt][4 * a] * gt, o[dt][4 * a + 1] * gt), cvtpk(o[dt][4 * a + 2] * gt, o[dt][4 * a + 3] * gt)};
        *(u32x2*)(p.ocmp + m * DM + head * 128 + dt * 32 + 8 * a + 4 * hi) = wv;
      }
  }
  __syncthreads();
  {
    const int qq = 16 * w + (lane >> 2), part = lane & 3;
    const int cur = qb;
    unsigned lo, hi32;
    if (cur < 16) { lo = (2u << cur) - 1u; hi32 = 0u; }
    else {
      float* rowp = impM + qq * 68; const float* rows = impS + qq * 68;
      for (int e = 0; e < 16; ++e) { const int j = part * 16 + e; rowp[j] = rowp[j] + rows[j]; }
      __builtin_amdgcn_fence(__ATOMIC_RELEASE, "wavefront");
      __builtin_amdgcn_wave_barrier();
      float vj[16]; int rank[16];
#pragma unroll
      for (int e = 0; e < 16; ++e) { vj[e] = rowp[part * 16 + e]; rank[e] = 0; }
      for (int j2 = 1; j2 <= cur - 2; ++j2) {
        const float v2 = rowp[j2];
#pragma unroll
        for (int e = 0; e < 16; ++e) { const int j = part * 16 + e; rank[e] += (v2 > vj[e] || (v2 == vj[e] && j2 < j)) ? 1 : 0; }
      }
      unsigned bits = 0;
#pragma unroll
      for (int e = 0; e < 16; ++e) { const int j = part * 16 + e; if (j >= 1 && j <= cur - 2 && rank[e] < 13) bits |= 1u << e; }
      const int base = lane & ~3;
      const unsigned b0 = __shfl(bits, base), b1 = __shfl(bits, base + 1), b2 = __shfl(bits, base + 2), b3 = __shfl(bits, base + 3);
      lo = b0 | (b1 << 16); hi32 = b2 | (b3 << 16);
      lo |= 1u;
      { const int j = cur - 1; if (j < 32) lo |= 1u << j; else hi32 |= 1u << (j - 32); }
      { const int j = cur; if (j < 32) lo |= 1u << j; else hi32 |= 1u << (j - 32); }
    }
    if (part == 0) {
      unsigned* sp = p.selmask + ((size_t)bg * TSEQ + qb * 64 + qq) * 2;
      sp[0] = lo; sp[1] = hi32;
    }
  }
  __syncthreads();
}

template <int BR>
__device__ __forceinline__ void attn_pass(const P& p, const int b, const int g, const int qb, const int head, const int tq, const bf16x8* qf,
                                          unsigned long long tiles, const unsigned long long mysel, char* lds) {
  const int tid = threadIdx.x, lane = tid & 63;
  const int kl = lane & 31, hi = lane >> 5;
  const int bg = b * 4 + g;
  const bf16_t* Kg = (BR == 0 ? p.kw : p.ks) + (size_t)bg * TSEQ * 128;
  const bf16_t* Vg = (BR == 0 ? p.vwT : p.vsT) + (size_t)bg * 128 * TSEQ;
  const unsigned Wlim = BR == 0 ? 512u : 0x80000000u;
  const float NEG = -__builtin_inff();
  f32x16 o[4];
#pragma unroll
  for (int dt = 0; dt < 4; ++dt) for (int r = 0; r < 16; ++r) o[dt][r] = 0.f;
  float mx = -1e30f, l = 0.f;
  bf16x8 sk[4], sv[4];
  auto load_tile = [&](int j) {
#pragma unroll
    for (int i = 0; i < 4; ++i) {
      const int id = tid + 256 * i;
      sk[i] = *(const bf16x8*)(Kg + (size_t)(j * 64 + (id >> 4)) * 128 + (id & 15) * 8);
      sv[i] = *(const bf16x8*)(Vg + (size_t)(id >> 3) * TSEQ + j * 64 + (id & 7) * 8);
    }
  };
  auto store_tile = [&](int buf) {
    char* Kb = lds + buf * ATT_BUF; char* Vb = Kb + ATT_KSZ;
#pragma unroll
    for (int i = 0; i < 4; ++i) {
      const int id = tid + 256 * i;
      { const int row = id >> 4, c16 = id & 15; *(bf16x8*)(Kb + row * 272 + (c16 << 4)) = sk[i]; }
      { const int d = id >> 3, cx = id & 7; *(bf16x8*)(Vb + d * 144 + (cx << 4)) = sv[i]; }
    }
  };
  int j = __builtin_ctzll(tiles); tiles &= tiles - 1;
  load_tile(j);
  store_tile(0);
  __syncthreads();
  int buf = 0;
  while (true) {
    const bool more = tiles != 0ull;
    int jn = 0;
    if (more) { jn = __builtin_ctzll(tiles); tiles &= tiles - 1; load_tile(jn); }
    {
      const char* Kb = lds + buf * ATT_BUF + kl * 272 + hi * 16; const char* Vb = lds + buf * ATT_BUF + ATT_KSZ + kl * 144 + hi * 16;
      const bool lane_ok = BR == 0 ? true : ((mysel >> j) & 1ull) != 0ull;
      const bool wave_any = __any(lane_ok);
      const bool boundary = BR == 0 ? (j == qb || j + 8 == qb) : (j == qb);
      if (wave_any) {
#pragma unroll
        for (int hs = 0; hs < 2; ++hs) {
          f32x16 sc; for (int r = 0; r < 16; ++r) sc[r] = 0.f;
#pragma unroll
          for (int d0 = 0; d0 < 8; ++d0) {
            bf16x8 kf = *(const bf16x8*)(Kb + hs * 32 * 272 + d0 * 32);
            sc = __builtin_amdgcn_mfma_f32_32x32x16_bf16(kf, qf[d0], sc, 0, 0, 0);
          }
          if (boundary) {
            const int dq = tq - (j * 64 + hs * 32 + 4 * hi);
#pragma unroll
            for (int r = 0; r < 16; ++r) { const int cidx = (r & 3) + 8 * (r >> 2); if ((unsigned)(dq - cidx) >= Wlim) sc[r] = NEG; }
          }
          if (BR == 1) {
#pragma unroll
            for (int r = 0; r < 16; ++r) sc[r] = lane_ok ? sc[r] : NEG;
          }
          float tm = sc[0];
#pragma unroll
          for (int r = 1; r < 16; ++r) tm = fmaxf(tm, sc[r]);
          tm = swap32_max(tm);
          if (!__all(tm <= mx + 8.f)) {
            const float mn = fmaxf(mx, tm);
            const float alpha = __builtin_amdgcn_exp2f(mx - mn);
            l *= alpha; mx = mn;
#pragma unroll
            for (int dt = 0; dt < 4; ++dt)
#pragma unroll
              for (int r = 0; r < 16; ++r) o[dt][r] *= alpha;
          }
          float pr[16]; float ps = 0.f;
#pragma unroll
          for (int r = 0; r < 16; ++r) { pr[r] = __builtin_amdgcn_exp2f(sc[r] - mx); ps += pr[r]; }
          ps = swap32_sum(ps);
          l += ps;
          const float pf0[8] = {pr[0], pr[1], pr[2], pr[3], pr[4], pr[5], pr[6], pr[7]};
          const float pf1[8] = {pr[8], pr[9], pr[10], pr[11], pr[12], pr[13], pr[14], pr[15]};
          const bf16x8 pb0 = pack8f(pf0), pb1 = pack8f(pf1);
#pragma unroll
          for (int dt = 0; dt < 4; ++dt) {
            bf16x8 v0 = *(const bf16x8*)(Vb + dt * 32 * 144 + hs * 64);
            bf16x8 v1 = *(const bf16x8*)(Vb + dt * 32 * 144 + hs * 64 + 32);
            o[dt] = __builtin_amdgcn_mfma_f32_32x32x16_bf16(v0, pb0, o[dt], 0, 0, 0);
            o[dt] = __builtin_amdgcn_mfma_f32_32x32x16_bf16(v1, pb1, o[dt], 0, 0, 0);
          }
        }
      }
    }
    if (more) store_tile(buf ^ 1);
    __syncthreads();
    if (!more) break;
    j = jn; buf ^= 1;
  }
  const size_t m = (size_t)b * TSEQ + tq;
  const float gt = p.gates[m * 48 + head * 3 + (BR == 0 ? 2 : 1)];
  const float sc_ = gt / l;
  if (BR == 0) {
#pragma unroll
    for (int dt = 0; dt < 4; ++dt)
#pragma unroll
      for (int a = 0; a < 4; ++a) {
        const size_t idx = m * DM + head * 128 + dt * 32 + 8 * a + 4 * hi;
        *(u32x2*)(p.ubuf + idx) = u32x2{cvtpk(o[dt][4 * a] * sc_, o[dt][4 * a + 1] * sc_), cvtpk(o[dt][4 * a + 2] * sc_, o[dt][4 * a + 3] * sc_)};
      }
  } else {
#pragma unroll
    for (int dt = 0; dt < 4; ++dt)
#pragma unroll
      for (int a = 0; a < 4; ++a) {
        const size_t idx = m * DM + head * 128 + dt * 32 + 8 * a + 4 * hi;
        const u32x2 oc = *(const u32x2*)(p.ocmp + idx);
        const u32x2 zz = *(const u32x2*)(p.sz + idx);
        const u32x2 ww = *(const u32x2*)(p.ubuf + idx);
        const float y0 = (o[dt][4 * a] * sc_ + bflo(ww[0]) + bflo(oc[0])) * bflo(zz[0]);
        const float y1 = (o[dt][4 * a + 1] * sc_ + bfhi(ww[0]) + bfhi(oc[0])) * bfhi(zz[0]);
        const float y2 = (o[dt][4 * a + 2] * sc_ + bflo(ww[1]) + bflo(oc[1])) * bflo(zz[1]);
        const float y3 = (o[dt][4 * a + 3] * sc_ + bfhi(ww[1]) + bfhi(oc[1])) * bfhi(zz[1]);
        *(u32x2*)(p.ubuf + idx) = u32x2{cvtpk(y0, y1), cvtpk(y2, y3)};
      }
  }
}

__device__ __forceinline__ void attn_item(const P& p, const int item, char* lds, unsigned long long* uni) {
  const int half = item & 1, g = (item >> 1) & 3, b = (item >> 3) & 3, qb = 63 - (item >> 5);
  const int tid = threadIdx.x, lane = tid & 63, w = tid >> 6;
  const int kl = lane & 31, hi = lane >> 5;
  const int head = g * 4 + half * 2 + (w >> 1);
  const int tq = qb * 64 + (w & 1) * 32 + kl;
  const size_t m = (size_t)b * TSEQ + tq;
  bf16x8 qf[8];
#pragma unroll
  for (int d0 = 0; d0 < 8; ++d0) qf[d0] = *(const bf16x8*)(p.q + m * DM + head * 128 + d0 * 16 + hi * 8);
  const unsigned* sp = p.selmask + ((size_t)(b * 4 + g) * TSEQ + tq) * 2;
  const unsigned long long mysel = (unsigned long long)sp[0] | ((unsigned long long)sp[1] << 32);
  unsigned long long u = mysel;
#pragma unroll
  for (int o = 16; o >= 1; o >>= 1) { u |= (unsigned long long)__shfl_xor((unsigned)u, o) | ((unsigned long long)__shfl_xor((unsigned)(u >> 32), o) << 32); }
  if (lane == 0) uni[w] = u;
  __syncthreads();
  const unsigned long long U = (uni[0] | uni[1] | uni[2] | uni[3]) & (qb == 63 ? ~0ull : ((2ull << qb) - 1ull));
  const int jlo = qb >= 8 ? qb - 8 : 0;
  const unsigned long long wt = (qb == 63 ? ~0ull : ((2ull << qb) - 1ull)) & ~((1ull << jlo) - 1ull);
  attn_pass<0>(p, b, g, qb, head, tq, qf, wt, mysel, lds);
  attn_pass<1>(p, b, g, qb, head, tq, qf, U, mysel, lds);
}

typedef __attribute__((address_space(1))) unsigned gunsigned;
__device__ __forceinline__ unsigned gb_ld(unsigned* p) { return __hip_atomic_load((gunsigned*)p, __ATOMIC_RELAXED, __HIP_MEMORY_SCOPE_AGENT); }
__device__ __forceinline__ unsigned gb_add(unsigned* p, unsigned v) { return __hip_atomic_fetch_add((gunsigned*)p, v, __ATOMIC_RELAXED, __HIP_MEMORY_SCOPE_AGENT); }
__device__ __forceinline__ void grid_barrier(unsigned* bar, const unsigned e) {
  __builtin_amdgcn_fence(__ATOMIC_RELEASE, "workgroup");
  __builtin_amdgcn_s_waitcnt(0);
  __syncthreads();
  if (threadIdx.x == 0) {
    const unsigned G = gridDim.x, g = blockIdx.x & 7u;
    const unsigned ngrp = G < 8u ? G : 8u, nloc = (G + 7u - g) >> 3;
    __builtin_amdgcn_fence(__ATOMIC_RELEASE, "agent");
    __builtin_amdgcn_s_waitcnt(0);
    const unsigned old = gb_add(&bar[64u * (1u + g)], 1u);
    if (old + 1u == (e + 1u) * nloc) {
      const unsigned og = gb_add(&bar[0], 1u);
      if (og + 1u == (e + 1u) * ngrp) gb_add(&bar[64u * 20u], 1u);
      else { unsigned sp = 0; while (gb_ld(&bar[64u * 20u]) <= e && ++sp < (1u << 24)) __builtin_amdgcn_s_sleep(1); }
      gb_add(&bar[64u * (10u + g)], 1u);
    } else {
      unsigned sp = 0; while (gb_ld(&bar[64u * (10u + g)]) <= e && ++sp < (1u << 24)) __builtin_amdgcn_s_sleep(1);
    }
    __builtin_amdgcn_fence(__ATOMIC_ACQUIRE, "agent");
    __builtin_amdgcn_s_waitcnt(0);
  }
  __syncthreads();
}

#define NPHASE 23
#ifndef GRP
#define GRP 0xFFFF
#endif
#define EN(b) ((GRP >> (b)) & 1)
#ifndef DUPMASK
#define DUPMASK 0
#endif
#define PHASE(n, en, ...) if (ph_lo <= (n) && (n) < ph_hi) { if (EN(en)) { __VA_ARGS__ if ((DUPMASK >> (n)) & 1) { __syncthreads(); __VA_ARGS__ } } if ((n) + 1 < ph_hi) { if ((n) == 0) cg::this_grid().sync(); else grid_barrier(bar, (unsigned)((n) - 1)); } }

__device__ __forceinline__ bool deal_tile(int r, int NT, int& mt, int& nt) {
  const int G = gridDim.x, bid = blockIdx.x;
  if (G == 512) {
    const int x = bid & 7, lb = bid >> 3;
    const int NG = NT >> 3, rem = NT & 7;
    if (r < 2 * NG) { mt = 16 * x + (r & 1) * 8 + (lb >> 3); nt = (r >> 1) * 8 + (lb & 7); return true; }
    const int idx = (r - 2 * NG) * 64 + lb;
    if (idx < 16 * rem) { mt = 16 * x + idx / rem; nt = NG * 8 + idx % rem; return true; }
    return false;
  }
  const int t = bid + r * G;
  if (t < 128 * NT) { mt = t / NT; nt = t % NT; return true; }
  return false;
}
__device__ __forceinline__ int deal_rounds(int NT) {
  const int G = gridDim.x;
  if (G == 512) return 2 * (NT >> 3) + (16 * (NT & 7) + 63) / 64;
  return (128 * NT + G - 1) / G;
}
__device__ __forceinline__ void ph_proj(const P& p, int layer, char* lds) {
  {
    const int nr = deal_rounds(32);
    for (int r = 0; r < nr; ++r) {
      int mt, nt2;
      if (!deal_tile(r, 32, mt, nt2)) continue;
      GemmCtx cw; cw.A = p.ubuf; cw.lda = DM; cw.K = DM; cw.layer = layer; cw.j = 0; cw.Bt = p.Wp;
      cw.aux = p.a_mu + (size_t)(layer * 6 + (nt2 >> 3)) * DM;
      gemm_wide<AL_MIX, EP_PROJ>(p, cw, mt, nt2, lds);
    }
  }
  const int NL = layer == 0 ? 2 : 3;
  GemmCtx c; c.A = p.ubuf; c.lda = DM; c.K = DM; c.layer = layer; c.j = 0; c.Bt = p.Wp;
  const int nr = deal_rounds(NL);
  for (int r = 0; r < nr; ++r) {
    int mt, ntl;
    if (!deal_tile(r, NL, mt, ntl)) continue;
    const int nt = 64 + ntl;
    const int mui = nt == 64 ? 4 : nt == 65 ? 5 : 2;
    c.aux = p.a_mu + (size_t)(layer * 6 + mui) * DM;
    gemm_tile<AL_MIX, EP_PROJ>(p, c, mt, nt, lds);
  }
}
__device__ __forceinline__ void ph_wo(const P& p, int layer, const bf16_t* Wt, char* lds) {
  GemmCtx c; c.A = p.ubuf; c.lda = DM; c.Bt = Wt; c.K = DM; c.layer = layer; c.j = 0; c.aux = nullptr;
  const int nr = deal_rounds(8);
  for (int r = 0; r < nr; ++r) {
    int mt, nt2;
    if (!deal_tile(r, 8, mt, nt2)) continue;
    gemm_wide<AL_PLAIN, EP_RESID>(p, c, mt, nt2, lds);
  }
}
__device__ __forceinline__ void ph_kvwin(const P& p, int jl, int NTK, char* lds) {
  const int NK2 = NTK >> 1, NT2 = NK2 + 16;
  {
    const int nr = deal_rounds(NT2);
    for (int r = 0; r < nr; ++r) {
      int mt, nt2;
      if (!deal_tile(r, NT2, mt, nt2)) continue;
      GemmCtx c; c.lda = DM; c.K = DM; c.layer = 1; c.j = jl; c.aux = nullptr;
      if (nt2 < NK2) { c.A = p.hn; c.Bt = p.Wkv; gemm_wide<AL_PLAIN, EP_KV>(p, c, mt, nt2, lds); }
      else { c.A = p.ubuf; c.Bt = p.Win; gemm_wide<AL_PLAIN, EP_WIN>(p, c, mt, nt2 - NK2, lds); }
    }
  }
  if (jl != 0) {
    GemmCtx c; c.lda = DM; c.K = DM; c.layer = 1; c.j = jl; c.aux = nullptr; c.A = p.ubuf; c.Bt = p.Win;
    const int nr = deal_rounds(1);
    for (int r = 0; r < nr; ++r) {
      int mt, ntl;
      if (!deal_tile(r, 1, mt, ntl)) continue;
      gemm_tile<AL_PLAIN, EP_WIN>(p, c, mt, 32, lds);
    }
  }
}
__device__ __forceinline__ void ph_attn(const P& p, char* lds, unsigned long long* uni) {
  const int G = gridDim.x, bid = blockIdx.x;
  const bool xcd = G == 512;
  const int x = bid & 7, lb = bid >> 3, a = lb >> 1, half = lb & 1;
  int rnd = 0;
  for (int base = 0; base < 2048; base += G, ++rnd) {
    int idx;
    if (xcd) {
      const int bg = x * 2 + (rnd >> 1), b = bg >> 2, g = bg & 3;
      const int qb = (rnd & 1) ? a : 63 - a;
      idx = ((63 - qb) << 5) | (b << 3) | (g << 1) | half;
    } else idx = base + ((rnd & 1) ? (G - 1 - bid) : bid);
    if (idx < 2048) attn_item(p, idx, lds, uni);
    __syncthreads();
  }
}

__global__ void __launch_bounds__(NTHREADS, 2) fwd_kernel(const P p, const PJ pj, unsigned* bar, const int ph_lo, const int ph_hi) {
  __shared__ __attribute__((aligned(16))) char lds[LDS_BYTES];
  __shared__ unsigned long long uni[4];
  const int G = gridDim.x, bid = blockIdx.x;
  PHASE(0, 0, norm_phase<0, 0>(p, pj, false, p.a_norm_g, p.ubuf, nullptr, nullptr, nullptr, lds);)
  PHASE(1, 1, ph_proj(p, 0, lds);)
  PHASE(2, 2, for (int it = bid; it < 512; it += G) scan_item(p, 0, it, lds);)
  PHASE(3, 3, postscan_phase(p, 0);)
  PHASE(4, 4, ph_wo(p, 0, p.Wo, lds);)
  PHASE(5, 0, norm_phase<0, 1>(p, pj, true, p.a_norm_g + DM, p.ubuf, nullptr, nullptr, nullptr, lds);)
  PHASE(6, 1, ph_proj(p, 1, lds);)
  PHASE(7, 2, for (int it = bid; it < 512; it += G) scan_item(p, 1, it, lds);)
  PHASE(8, 3, postscan_phase(p, 1);)
  PHASE(9, 4, ph_wo(p, 1, p.Wo, lds);)
  PHASE(10, 0, norm_phase<1, 2>(p, pj, true, p.kv_norm_g, p.hn, p.b_norm_g, p.ubuf, nullptr, lds);)
  PHASE(11, 5, ph_kvwin(p, 0, 24, lds);)
  PHASE(12, 6,
    for (int t = bid; t < 256; t += G) {
      if (t >= 128) {
        GemmCtx cg; cg.lda = DM; cg.K = DM; cg.layer = 1; cg.j = 0; cg.aux = nullptr; cg.A = p.ubuf; cg.Bt = p.Win;
        gemm_tile<AL_PLAIN, EP_WIN>(p, cg, t - 128, 32, lds);
        continue;
      }
      const int j = t >> 6, r = t & 63, mt = r >> 1, nt = r & 1;
      GemmCtx c; c.A = p.kc + (size_t)j * (8u << 20); c.lda = 0; c.Bt = p.Wc1 + (size_t)j * 256 * 4096; c.K = 4096; c.layer = 0; c.j = j;
      c.aux = p.cmp_pe + (size_t)j * 32 * 128;
      gemm_tile<AL_CMP, EP_CMP1>(p, c, mt, nt, lds);
    })
  PHASE(13, 7,
    for (int t = bid; t < 64; t += G) {
      const int j = t >> 5, mt = t & 31;
      GemmCtx c; c.A = p.hc + (size_t)j * 4096 * 256; c.lda = 256; c.Bt = p.Wc2 + (size_t)j * 128 * 256; c.K = 256; c.layer = 0; c.j = j; c.aux = nullptr;
      gemm_tile<AL_PLAIN, EP_CMP2>(p, c, mt, 0, lds);
    })
  PHASE(14, 8, for (int t = bid; t < 1024; t += G) cmp_item(p, t, lds);)
  PHASE(15, 9, ph_attn(p, lds, uni);)
  PHASE(16, 4, ph_wo(p, 1, p.Wob, lds);)
  PHASE(17, 0, norm_phase<0, 3>(p, pj, true, p.b_norm_g + DM, p.ubuf, nullptr, nullptr, nullptr, lds);)
  PHASE(18, 5, ph_kvwin(p, 1, 0, lds);)
  PHASE(19, 8, for (int t = bid; t < 1024; t += G) cmp_item(p, t, lds);)
  PHASE(20, 9, ph_attn(p, lds, uni);)
  PHASE(21, 4, ph_wo(p, 1, p.Wob, lds);)
  PHASE(22, 0, norm_phase<2, -1>(p, pj, true, p.final_g, nullptr, nullptr, nullptr, p.out, lds);)
}

static inline size_t MiB(double x) { return (size_t)(x * 1048576.0); }

extern "C" void kernel_launch(void* const* d_in, const int* in_sizes, int n_in, void* d_out, int out_size, void* d_ws, size_t ws_size, hipStream_t stream) {
  (void)in_sizes; (void)n_in; (void)out_size;
  P p; memset(&p, 0, sizeof(P));
  PJ pj; memset(&pj, 0, sizeof(PJ));
  const float* const* in = (const float* const*)d_in;
  p.x = in[0]; p.a_norm_g = in[1]; p.a_mu = in[2];
  const float* a_w_rkvz = in[3];
  p.a_w0 = in[4]; const float* a_w1 = in[5]; const float* a_w2 = in[6];
  p.a_a0 = in[7]; const float* a_a1 = in[8]; const float* a_a2 = in[9];
  p.a_v0 = in[10]; const float* a_v1 = in[11]; const float* a_v2 = in[12];
  p.a_k_k = in[13]; p.a_k_a = in[14]; p.a_r_k = in[15]; p.a_ln_g = in[16]; p.a_ln_b = in[17];
  const float* a_w_o = in[18];
  p.kv_norm_g = in[19]; const float* kv_w = in[20]; p.cmp_pe = in[21]; const float* cmp_w1 = in[22]; const float* cmp_w2 = in[23];
  p.b_norm_g = in[24]; const float* b_w_in = in[25]; p.b_gate_b = in[26]; const float* b_w_o = in[27]; p.final_g = in[28];
  p.out = (float*)d_out;
  if (ws_size < MiB(512)) { fprintf(stderr, "workspace too small: %zu\n", ws_size); return; }
  char* ws = (char*)d_ws;
  p.ysum = (bf16_t*)(ws + MiB(0)); p.ubuf = (bf16_t*)(ws + MiB(64)); p.r = (bf16_t*)(ws + MiB(128)); p.k = (bf16_t*)(ws + MiB(192));
  p.vA = (bf16_t*)(ws + MiB(256)); p.z = (bf16_t*)(ws + MiB(320)); p.vB = (bf16_t*)(ws + MiB(384));
  p.hn = (bf16_t*)(ws + MiB(128)); p.ocmp = p.hn; p.q = (bf16_t*)(ws + MiB(192)); p.sz = (bf16_t*)(ws + MiB(256));
  p.kc = (bf16_t*)(ws + MiB(320)); p.vc = (bf16_t*)(ws + MiB(336)); p.ks = (bf16_t*)(ws + MiB(352)); p.vsT = (bf16_t*)(ws + MiB(368));
  p.kw = (bf16_t*)(ws + MiB(384)); p.vwT = (bf16_t*)(ws + MiB(400));
  p.hc = (bf16_t*)(ws + MiB(416)); p.kcmp = (bf16_t*)(ws + MiB(420)); p.vcmpT = (bf16_t*)(ws + MiB(421));
  p.gates = (float*)(ws + MiB(422)); p.selmask = (unsigned*)(ws + MiB(425));
  char* ar = ws + MiB(448);
  p.Wp = (bf16_t*)ar;
  p.W2w = (bf16_t*)(ar + MiB(33.5)); p.W2a = (bf16_t*)(ar + MiB(34)); p.W2v = (bf16_t*)(ar + MiB(34.5));
  p.Wo = (bf16_t*)(ar + MiB(35));
  p.Wkv = (bf16_t*)ar;
  p.Win = (bf16_t*)(ar + MiB(12));
  p.Wc1 = (bf16_t*)(ar + MiB(28.5));
  p.Wc2 = (bf16_t*)(ar + MiB(32.5));
  p.Wob = (bf16_t*)(ar + MiB(33));
  p.lw = (bf16_t*)(ws + MiB(492)); p.la = (bf16_t*)(ws + MiB(496)); p.lv = (bf16_t*)(ws + MiB(500));
  unsigned* bar = (unsigned*)(ws + MiB(508));
  p.bon = (float*)(ws + MiB(504)); p.ropec = (float*)(ws + MiB(506)); p.ropes = (float*)(ws + MiB(506.5));

  int nj = 0, tile = 0;
  auto add = [&](const float* src, bf16_t* dst, int K, int N, int ld, int Kpad, int Npad) {
    ConvJob& j = pj.jobs[nj++]; j.src = src; j.dst = dst; j.K = K; j.N = N; j.ld = ld; j.Kpad = Kpad; j.Npad = Npad; j.tile0 = tile;
    tile += (Kpad / 64) * (Npad / 64);
  };
  const size_t DD = (size_t)DM * DM;
  for (int L = 0; L < 2; ++L) {
    tile = 0;
    for (int n4 = 0; n4 < 4; ++n4) add(a_w_rkvz + (size_t)(L * 4 + n4) * DD, p.Wp + (size_t)n4 * DD, DM, DM, DM, DM, DM);
    add(a_w1 + (size_t)L * DM * 96, p.Wp + (size_t)8192 * DM, DM, 96, 96, DM, 128);
    add(a_a1 + (size_t)L * DM * 96, p.Wp + (size_t)8320 * DM, DM, 96, 96, DM, 128);
    if (L == 1) add(a_v1, p.Wp + (size_t)8448 * DM, DM, 64, 64, DM, 128);
    add(a_w2 + (size_t)L * 96 * DM, p.W2w, 96, DM, DM, 128, DM);
    add(a_a2 + (size_t)L * 96 * DM, p.W2a, 96, DM, DM, 128, DM);
    if (L == 1) add(a_v2, p.W2v, 64, DM, DM, 128, DM);
    add(a_w_o + (size_t)L * DD, p.Wo, DM, DM, DM, DM, DM);
    pj.stage_tiles[L] = tile;
  }
  tile = 0;
  add(kv_w, p.Wkv, DM, 3072, 3072, DM, 3072);
  for (int j = 0; j < 2; ++j) add(cmp_w1 + (size_t)j * 4096 * 256, p.Wc1 + (size_t)j * 256 * 4096, 4096, 256, 256, 4096, 256);
  for (int j = 0; j < 2; ++j) add(cmp_w2 + (size_t)j * 256 * 128, p.Wc2 + (size_t)j * 128 * 256, 256, 128, 128, 256, 128);
  for (int L = 0; L < 2; ++L) {
    if (L == 1) { pj.stage_tiles[2] = tile; tile = 0; }
    const float* wi = b_w_in + (size_t)L * DM * 4144;
    add(wi, p.Win, DM, 2048, 4144, DM, 2048);
    add(wi + 2096, p.Win + (size_t)2048 * DM, DM, 2048, 4144, DM, 2048);
    add(wi + 2048, p.Win + (size_t)4096 * DM, DM, 48, 4144, DM, 128);
    add(b_w_o + (size_t)L * DD, p.Wob, DM, DM, DM, DM, DM);
  }
  pj.stage_tiles[3] = tile;
  for (int i = 0; i < 16; ++i) pj.rope_inv[i] = (float)pow(500000.0, -(double)i / 16.0);

  static int grid_blocks = 0;
  if (!grid_blocks) {
    int dev = 0, cus = 0, per_cu = 0;
    hipGetDevice(&dev);
    hipDeviceGetAttribute(&cus, hipDeviceAttributeMultiprocessorCount, dev);
    hipOccupancyMaxActiveBlocksPerMultiprocessor(&per_cu, fwd_kernel, NTHREADS, 0);
    if (per_cu > 2) per_cu = 2;
    if (per_cu < 1) per_cu = 1;
    grid_blocks = cus * per_cu;
  }
#if ONE_LAUNCH
  hipMemsetAsync(bar, 0, 64 * 32 * 4, stream);
  int lo = 0, hi = NPHASE;
  void* args[] = {(void*)&p, (void*)&pj, (void*)&bar, (void*)&lo, (void*)&hi};
  hipError_t e = hipLaunchCooperativeKernel((void*)fwd_kernel, dim3(grid_blocks), dim3(NTHREADS), args, 0, stream);
  if (e != hipSuccess) fprintf(stderr, "cooperative launch failed: %s (grid %d)\n", hipGetErrorString(e), grid_blocks);
#else
  for (int ph = 0; ph < NPHASE; ++ph) {
    hipLaunchKernelGGL(fwd_kernel, dim3(grid_blocks), dim3(NTHREADS), 0, stream, p, pj, bar, ph, ph + 1);
  }

#endif
}
```

```cpp
#include <hip/hip_runtime.h>
#include <hip/hip_cooperative_groups.h>
#include <cstdio>
#include <cstdint>
#include <cstring>
#include <cmath>
namespace cg = cooperative_groups;

#ifndef ONE_LAUNCH
#define ONE_LAUNCH 1
#endif

typedef unsigned short bf16_t;
typedef short bf16x8 __attribute__((ext_vector_type(8)));
typedef float f32x4 __attribute__((ext_vector_type(4)));
typedef float f32x16 __attribute__((ext_vector_type(16)));
typedef unsigned u32x4 __attribute__((ext_vector_type(4)));
typedef unsigned u32x2 __attribute__((ext_vector_type(2)));

#define MTOK 16384
#define TSEQ 4096
#define DM 2048
#define NTHREADS 256
#define QSCALE 0.12751743f
#define ATT_KSZ 17408
#define ATT_BUF 35840
#define LDS_BYTES 71680

struct ConvJob { const float* src; bf16_t* dst; int K, N, ld, Kpad, Npad, tile0; };

struct P {
  const float *x, *a_norm_g, *a_mu, *a_w0, *a_a0, *a_v0, *a_k_k, *a_k_a, *a_r_k, *a_ln_g, *a_ln_b;
  const float *kv_norm_g, *cmp_pe, *b_norm_g, *b_gate_b, *final_g;
  float* out;
  bf16_t *ysum, *ubuf, *r, *k, *vA, *z, *vB;
  bf16_t *lw, *la, *lv; float *bon; float *ropec, *ropes;
  bf16_t *Wp, *W2w, *W2a, *W2v, *Wo;
  bf16_t *Wkv, *Win, *Wc1, *Wc2, *Wob;
  bf16_t *hn, *q, *sz, *ocmp;
  bf16_t *kc, *vc, *ks, *vsT, *kw, *vwT, *hc, *kcmp, *vcmpT;
  float *gates; unsigned *selmask;
};
struct PJ {
  ConvJob jobs[33];
  float rope_inv[16];
  int stage_tiles[4];
};

typedef __bf16 bf16x2_t __attribute__((ext_vector_type(2)));
typedef float f32x2 __attribute__((ext_vector_type(2)));
__device__ __forceinline__ unsigned cvtpk(float lo, float hi) {
  f32x2 v = {lo, hi};
  bf16x2_t b = __builtin_convertvector(v, bf16x2_t);
  return __builtin_bit_cast(unsigned, b);
}
__device__ __forceinline__ bf16_t f2bf(float x) { return (bf16_t)(cvtpk(x, x) & 0xffffu); }
__device__ __forceinline__ float bflo(unsigned w) { return __uint_as_float(w << 16); }
__device__ __forceinline__ float bfhi(unsigned w) { return __uint_as_float(w & 0xffff0000u); }
__device__ __forceinline__ float bf2f(bf16_t v) { return __uint_as_float(((unsigned)v) << 16); }
__device__ __forceinline__ void unpack8(bf16x8 v, float* f) {
  u32x4 w = *reinterpret_cast<u32x4*>(&v);
#pragma unroll
  for (int i = 0; i < 4; ++i) { f[2 * i] = bflo(w[i]); f[2 * i + 1] = bfhi(w[i]); }
}
__device__ __forceinline__ bf16x8 pack8f(const float* f) {
  u32x4 w = {cvtpk(f[0], f[1]), cvtpk(f[2], f[3]), cvtpk(f[4], f[5]), cvtpk(f[6], f[7])};
  return *reinterpret_cast<bf16x8*>(&w);
}
__device__ __forceinline__ float sigmoidf_(float x) { return __builtin_amdgcn_rcpf(1.f + __expf(-x)); }
__device__ __forceinline__ float siluf_(float x) { return x * __builtin_amdgcn_rcpf(1.f + __expf(-x)); }
#define DPP(x, ctrl) __int_as_float(__builtin_amdgcn_mov_dpp(__float_as_int(x), ctrl, 0xF, 0xF, true))
__device__ __forceinline__ float sum8(float x) {
  x += DPP(x, 0xB1); x += DPP(x, 0x4E); x += DPP(x, 0x141); return x;
}
__device__ __forceinline__ float wave_sum(float x) {
#pragma unroll
  for (int o = 32; o >= 1; o >>= 1) x += __shfl_xor(x, o);
  return x;
}
__device__ __forceinline__ float swap32_max(float x) {
  auto rr = __builtin_amdgcn_permlane32_swap(__float_as_uint(x), __float_as_uint(x), false, false);
  return fmaxf(__uint_as_float(rr[0]), __uint_as_float(rr[1]));
}
__device__ __forceinline__ float swap32_sum(float x) {
  auto rr = __builtin_amdgcn_permlane32_swap(__float_as_uint(x), __float_as_uint(x), false, false);
  return __uint_as_float(rr[0]) + __uint_as_float(rr[1]);
}
__device__ __forceinline__ int crow(int r, int hi) { return (r & 3) + 8 * (r >> 2) + 4 * hi; }

__device__ __forceinline__ void conv_tile(const ConvJob& jb, int tile, char* lds) {
  float* T = (float*)lds;
  const int nkt = jb.Kpad >> 6;
  const int n0 = (tile / nkt) * 64, k0 = (tile % nkt) * 64;
  const int tx = threadIdx.x & 63, ty = threadIdx.x >> 6;
#pragma unroll 4
  for (int rr = 0; rr < 16; ++rr) {
    int kl = ty * 16 + rr, kk = k0 + kl, n = n0 + tx;
    float v = (kk < jb.K && n < jb.N) ? jb.src[(size_t)kk * jb.ld + n] : 0.f;
    T[kl * 65 + tx] = v;
  }
  __syncthreads();
  const int nl = threadIdx.x >> 2, kc = (threadIdx.x & 3) * 16;
  unsigned w[8];
#pragma unroll
  for (int i = 0; i < 8; ++i) w[i] = cvtpk(T[(kc + 2 * i) * 65 + nl], T[(kc + 2 * i + 1) * 65 + nl]);
  bf16_t* d = jb.dst + (size_t)(n0 + nl) * jb.Kpad + k0 + kc;
  *(u32x4*)d = u32x4{w[0], w[1], w[2], w[3]};
  *(u32x4*)(d + 8) = u32x4{w[4], w[5], w[6], w[7]};
  __syncthreads();
}

template <int MODE>
__device__ __forceinline__ void rmsnorm_row(const P& p, int row, bool has_y, const float* g1, bf16_t* o1, const float* g2, bf16_t* o2, float* of) {
  const int lane = threadIdx.x & 63;
  const float* xr = p.x + (size_t)row * DM;
  const bf16_t* yr = p.ysum + (size_t)row * DM;
  f32x4 v[8]; float ss = 0.f;
#pragma unroll
  for (int i = 0; i < 8; ++i) {
    int c = (lane + 64 * i) * 4;
    v[i] = *(const f32x4*)(xr + c);
    if (has_y) { u32x2 w = *(const u32x2*)(yr + c); v[i][0] += bflo(w[0]); v[i][1] += bfhi(w[0]); v[i][2] += bflo(w[1]); v[i][3] += bfhi(w[1]); }
    ss += v[i][0] * v[i][0] + v[i][1] * v[i][1] + v[i][2] * v[i][2] + v[i][3] * v[i][3];
  }
  ss = wave_sum(ss);
  const float rs = rsqrtf(ss * (1.f / DM) + 1e-6f);
#pragma unroll
  for (int i = 0; i < 8; ++i) {
    int c = (lane + 64 * i) * 4;
    f32x4 g = *(const f32x4*)(g1 + c);
    if (MODE == 2) {
      f32x4 y = {v[i][0] * rs * g[0], v[i][1] * rs * g[1], v[i][2] * rs * g[2], v[i][3] * rs * g[3]};
      *(f32x4*)(of + (size_t)row * DM + c) = y;
    } else {
      u32x2 w = {cvtpk(v[i][0] * rs * g[0], v[i][1] * rs * g[1]), cvtpk(v[i][2] * rs * g[2], v[i][3] * rs * g[3])};
      *(u32x2*)(o1 + (size_t)row * DM + c) = w;
      if (MODE == 1) {
        f32x4 gg = *(const f32x4*)(g2 + c);
        u32x2 w2 = {cvtpk(v[i][0] * rs * gg[0], v[i][1] * rs * gg[1]), cvtpk(v[i][2] * rs * gg[2], v[i][3] * rs * gg[3])};
        *(u32x2*)(o2 + (size_t)row * DM + c) = w2;
      }
    }
  }
}

template <int MODE, int STAGE>
__device__ __forceinline__ void norm_phase(const P& p, const PJ& pj, bool has_y, const float* g1, bf16_t* o1, const float* g2, bf16_t* o2, float* of, char* lds) {
  if constexpr (STAGE >= 0) {
    constexpr int J0 = STAGE == 0 ? 0 : STAGE == 1 ? 9 : STAGE == 2 ? 20 : 29;
    constexpr int J1 = STAGE == 0 ? 9 : STAGE == 1 ? 20 : STAGE == 2 ? 29 : 33;
    const int nt = pj.stage_tiles[STAGE];
    for (int t = blockIdx.x; t < nt; t += gridDim.x) {
      const float* jsrc = pj.jobs[J0].src; bf16_t* jdst = pj.jobs[J0].dst;
      int jK = pj.jobs[J0].K, jN = pj.jobs[J0].N, jld = pj.jobs[J0].ld, jKp = pj.jobs[J0].Kpad, jNp = pj.jobs[J0].Npad, jt0 = pj.jobs[J0].tile0;
#pragma unroll
      for (int j = J0 + 1; j < J1; ++j) {
        const bool cnd = t >= pj.jobs[j].tile0;
        jsrc = cnd ? pj.jobs[j].src : jsrc; jdst = cnd ? pj.jobs[j].dst : jdst;
        jK = cnd ? pj.jobs[j].K : jK; jN = cnd ? pj.jobs[j].N : jN; jld = cnd ? pj.jobs[j].ld : jld;
        jKp = cnd ? pj.jobs[j].Kpad : jKp; jNp = cnd ? pj.jobs[j].Npad : jNp; jt0 = cnd ? pj.jobs[j].tile0 : jt0;
      }
      ConvJob jb; jb.src = jsrc; jb.dst = jdst; jb.K = jK; jb.N = jN; jb.ld = jld; jb.Kpad = jKp; jb.Npad = jNp; jb.tile0 = jt0;
      conv_tile(jb, t - jt0, lds);
    }
    if constexpr (STAGE == 0) {
      for (int pos = blockIdx.x * NTHREADS + threadIdx.x; pos < TSEQ; pos += gridDim.x * NTHREADS) {
#pragma unroll
        for (int i = 0; i < 16; ++i) {
          const float ang = (float)pos * pj.rope_inv[i];
          const double a = (double)ang * 0.15915494309189535;
          const float fr = (float)(a - rint(a));
          p.ropec[pos * 16 + i] = __builtin_amdgcn_cosf(fr); p.ropes[pos * 16 + i] = __builtin_amdgcn_sinf(fr);
        }
      }
    }
  }
  const int gw = blockIdx.x * 4 + (threadIdx.x >> 6), nw = gridDim.x * 4;
  for (int row = gw; row < MTOK; row += nw) rmsnorm_row<MODE>(p, row, has_y, g1, o1, g2, o2, of);
}

enum { AL_PLAIN = 0, AL_MIX = 1, AL_CMP = 2 };
enum { EP_PROJ = 0, EP_RESID = 1, EP_KV = 2, EP_CMP1 = 3, EP_CMP2 = 4, EP_WIN = 5 };

struct GemmCtx {
  const bf16_t* A; int lda;
  const bf16_t* Bt; int K;
  const float* aux;
  int layer, j;
};

template <int NI>
__device__ __forceinline__ void store_rows_lds(bf16_t* base, const size_t ld, const int row0, const int cbase, f32x4 (&acc)[4][NI], char* lds, const bool rmw) {
  constexpr int RB = NI * 32 + 16;
  constexpr int CPR = NI * 2;
  const int lane = threadIdx.x & 63, wid = threadIdx.x >> 6, lr = lane & 15, lq = lane >> 4;
  char* W = lds + wid * (64 * RB);
#pragma unroll
  for (int mi = 0; mi < 4; ++mi)
#pragma unroll
    for (int ni = 0; ni < NI; ++ni)
#pragma unroll
      for (int j = 0; j < 4; ++j) *(bf16_t*)(W + (mi * 16 + lq * 4 + j) * RB + (ni * 16 + lr) * 2) = f2bf(acc[mi][ni][j]);
  __builtin_amdgcn_fence(__ATOMIC_RELEASE, "wavefront");
  __builtin_amdgcn_wave_barrier();
#pragma unroll 4
  for (int i = 0; i < CPR; ++i) {
    const int id = lane + 64 * i, row = id / CPR, cc = id % CPR;
    bf16x8 v = *(const bf16x8*)(W + row * RB + cc * 16);
    bf16_t* g = base + (size_t)(row0 + row) * ld + cbase + cc * 8;
    if (rmw) {
      float fa[8], fb[8]; unpack8(v, fa); unpack8(*(const bf16x8*)g, fb);
#pragma unroll
      for (int e = 0; e < 8; ++e) fa[e] += fb[e];
      v = pack8f(fa);
    }
    *(bf16x8*)g = v;
  }
}

template <int EP, int NI>
__device__ __forceinline__ void gemm_epilogue(const P& p, const GemmCtx& c, const int nt, const int m0, const int wr, const int lq, const int lr, const int cbase, f32x4 (&acc)[4][NI], char* lds) {
  const int rbase = m0 + wr * 64 + lq * 4; const int n0 = nt * 128;
  const int cl = cbase + lr;
  if constexpr (EP == EP_PROJ) {
    if (nt < 64) {
      const int which = nt >> 4;
      const int slab = which < 2 ? which : which == 3 ? 3 : (c.layer == 0 ? 2 : 4);
      bf16_t* dst = p.r + (size_t)slab * (32u << 20);
      store_rows_lds<NI>(dst + (nt & 15) * 128, DM, m0 + wr * 64, cbase, acc, lds, false);
    } else {
      bf16_t* dst = p.lw + (size_t)(nt - 64) * (2u << 20);
#pragma unroll
      for (int mi = 0; mi < 4; ++mi)
#pragma unroll
        for (int ni = 0; ni < NI; ++ni)
#pragma unroll
          for (int j = 0; j < 4; ++j) {
            float v = acc[mi][ni][j];
            if (nt == 64) v = 1.f - 2.f * __builtin_amdgcn_rcpf(1.f + __expf(2.f * v));
            dst[(size_t)(rbase + mi * 16 + j) * 128 + cl + ni * 16] = f2bf(v);
          }
    }
  } else if constexpr (EP == EP_RESID) {
    const bool has_y = c.layer != 0;
    store_rows_lds<NI>(p.ysum + n0, DM, m0 + wr * 64, cbase, acc, lds, has_y);
  } else if constexpr (EP == EP_KV || EP == EP_WIN || EP == EP_CMP2) {
    int kind;
    bool rope = false; float qs = 1.f;
    bf16_t* dst = nullptr; int bgidx = 0;
    if constexpr (EP == EP_KV) {
      const int i = nt >> 2, g = nt & 3; bgidx = g;
      kind = (i == 3 || i == 5) ? 1 : 0; rope = (i == 2 || i == 4);
      dst = p.kc + (size_t)i * (8u << 20);
    } else if constexpr (EP == EP_WIN) {
      kind = nt < 16 ? 0 : nt < 32 ? 2 : 3; rope = nt < 16; qs = nt < 16 ? QSCALE : 1.f;
      dst = p.q + (nt < 16 ? (size_t)0 : (size_t)(32u << 20));
    } else {
      kind = c.j == 0 ? 0 : 1; rope = c.j == 0; dst = p.kcmp + (size_t)c.j * (512u << 10);
    }
    if (rope && cbase == 0) {
#pragma unroll
      for (int mi = 0; mi < 4; ++mi)
#pragma unroll
        for (int j = 0; j < 4; ++j) {
          const int row = rbase + mi * 16 + j;
          int pos;
          if constexpr (EP == EP_CMP2) { pos = 16 * (row & 255) + 31; if (pos > TSEQ - 1) pos = TSEQ - 1; } else pos = row & (TSEQ - 1);
          const float cs = p.ropec[pos * 16 + lr], sn = p.ropes[pos * 16 + lr];
          const float x1 = acc[mi][0][j], x2 = acc[mi][1][j];
          acc[mi][0][j] = x1 * cs - x2 * sn; acc[mi][1][j] = x2 * cs + x1 * sn;
        }
    }
    if (kind == 0 || kind == 2) {
      const bool sil = kind == 2;
#pragma unroll
      for (int mi = 0; mi < 4; ++mi)
#pragma unroll
        for (int ni = 0; ni < NI; ++ni)
#pragma unroll
          for (int j = 0; j < 4; ++j) { const float v = acc[mi][ni][j]; acc[mi][ni][j] = sil ? siluf_(v) : v * qs; }
      bf16_t* base; size_t ld;
      if constexpr (EP == EP_KV) {
        const int i = nt >> 2;
        if (i < 2) { base = dst + bgidx * 128; ld = 512; }
        else { const int b = m0 >> 12; base = dst + (size_t)(3 * b + bgidx) * TSEQ * 128; ld = 128; }
      } else if constexpr (EP == EP_WIN) { base = dst + (nt & 15) * 128; ld = DM; }
      else { base = dst; ld = 128; }
      store_rows_lds<NI>(base, ld, m0 + wr * 64, cbase, acc, lds, false);
    } else if (kind == 1) {
#pragma unroll
      for (int mi = 0; mi < 4; ++mi)
#pragma unroll
        for (int ni = 0; ni < NI; ++ni) {
          const int row0 = m0 + wr * 64 + mi * 16;
          const int d = cl + ni * 16;
          const int slot = (lq & 1) * 8 + (lq >> 1) * 4;
          u32x2 w = {cvtpk(acc[mi][ni][0], acc[mi][ni][1]), cvtpk(acc[mi][ni][2], acc[mi][ni][3])};
          size_t idx;
          if constexpr (EP == EP_KV) { const int b = row0 >> 12, t0 = row0 & (TSEQ - 1); idx = ((size_t)((b * 4 + bgidx) * 128 + d)) * TSEQ + t0 + slot; }
          else { const int bg = row0 >> 8, c0 = row0 & 255; idx = ((size_t)(bg * 128 + d)) * 256 + c0 + slot; }
          *(u32x2*)(dst + idx) = w;
        }
    } else {
      const float* gb = p.b_gate_b + c.j * 48;
#pragma unroll
      for (int mi = 0; mi < 4; ++mi)
#pragma unroll
        for (int ni = 0; ni < NI; ++ni) {
          const int n = cl + ni * 16;
          if (n < 48) {
#pragma unroll
            for (int j = 0; j < 4; ++j) p.gates[(size_t)(rbase + mi * 16 + j) * 48 + n] = sigmoidf_(acc[mi][ni][j] + gb[n]);
          }
        }
    }
  } else if constexpr (EP == EP_CMP1) {
    bf16_t* dst = p.hc + (size_t)c.j * 4096 * 256;
#pragma unroll
    for (int mi = 0; mi < 4; ++mi)
#pragma unroll
      for (int ni = 0; ni < NI; ++ni)
#pragma unroll
        for (int j = 0; j < 4; ++j) dst[(size_t)(rbase + mi * 16 + j) * 256 + n0 + cl + ni * 16] = f2bf(siluf_(acc[mi][ni][j]));
  }
  __syncthreads();
}

template <int AL, int EP>
__device__ __forceinline__ void gemm_tile(const P& p, const GemmCtx& c, const int mt, const int nt, char* lds) {
  const int tid = threadIdx.x, lane = tid & 63, wid = tid >> 6;
  const int wr = wid >> 1, wc = wid & 1, lr = lane & 15, lq = lane >> 4;
  const int m0 = mt * 128, n0 = nt * 128;
  const int K = c.K, nk = K >> 6;
  const int lc = tid & 7, lrow = tid >> 3;
  f32x4 acc[4][4];
#pragma unroll
  for (int i = 0; i < 4; ++i)
#pragma unroll
    for (int j = 0; j < 4; ++j) acc[i][j] = f32x4{0.f, 0.f, 0.f, 0.f};
  bf16x8 ra[4], rp[4], rb[4]; f32x4 ax0, ax1;

  auto load_tile = [&](int kt) {
#pragma unroll
    for (int i = 0; i < 4; ++i) {
      const int row = lrow + 32 * i;
      rb[i] = *(const bf16x8*)(c.Bt + (size_t)(n0 + row) * K + kt * 64 + lc * 8);
      if constexpr (AL == AL_PLAIN) {
        ra[i] = *(const bf16x8*)(c.A + (size_t)(m0 + row) * c.lda + kt * 64 + lc * 8);
      } else if constexpr (AL == AL_MIX) {
        const int m = m0 + row;
        const bf16_t* src = c.A + (size_t)m * DM + kt * 64 + lc * 8;
        ra[i] = *(const bf16x8*)src;
        if ((m & (TSEQ - 1)) != 0) rp[i] = *(const bf16x8*)(src - DM); else rp[i] = bf16x8{0, 0, 0, 0, 0, 0, 0, 0};
      } else {
        const int R = m0 + row, bg = R >> 8, cc = R & 255, b = bg >> 2, g = bg & 3;
        const int l = kt >> 1, d = (kt & 1) * 64 + lc * 8;
        int t = 16 * cc + l; if (t > TSEQ - 1) t = TSEQ - 1;
        ra[i] = *(const bf16x8*)(c.A + ((size_t)(b * TSEQ + t)) * 512 + g * 128 + d);
      }
    }
    if constexpr (AL == AL_MIX) { const float* mu = c.aux + kt * 64 + lc * 8; ax0 = *(const f32x4*)mu; ax1 = *(const f32x4*)(mu + 4); }
    if constexpr (AL == AL_CMP) { const float* pe = c.aux + (kt >> 1) * 128 + (kt & 1) * 64 + lc * 8; ax0 = *(const f32x4*)pe; ax1 = *(const f32x4*)(pe + 4); }
  };
  auto store_tile = [&](int buf) {
    char* Ab = lds + buf * 32768; char* Bb = Ab + 16384;
#pragma unroll
    for (int i = 0; i < 4; ++i) {
      const int row = lrow + 32 * i;
      const int off = row * 128 + ((lc ^ (row & 7)) << 4);
      *(bf16x8*)(Bb + off) = rb[i];
      if constexpr (AL == AL_PLAIN) { *(bf16x8*)(Ab + off) = ra[i]; }
      else {
        float f[8]; unpack8(ra[i], f);
        const float mu[8] = {ax0[0], ax0[1], ax0[2], ax0[3], ax1[0], ax1[1], ax1[2], ax1[3]};
        if constexpr (AL == AL_MIX) {
          float fp[8]; unpack8(rp[i], fp);
#pragma unroll
          for (int e = 0; e < 8; ++e) f[e] = f[e] + (fp[e] - f[e]) * mu[e];
        } else {
#pragma unroll
          for (int e = 0; e < 8; ++e) f[e] = f[e] + mu[e];
        }
        *(bf16x8*)(Ab + off) = pack8f(f);
      }
    }
  };
  auto compute = [&](int buf) {
    const char* Ab = lds + buf * 32768; const char* Bb = Ab + 16384;
#pragma unroll
    for (int ks = 0; ks < 2; ++ks) {
      bf16x8 af[4], bfr[4];
#pragma unroll
      for (int mi = 0; mi < 4; ++mi) { const int row = wr * 64 + mi * 16 + lr; af[mi] = *(const bf16x8*)(Ab + row * 128 + (((ks * 4 + lq) ^ (row & 7)) << 4)); }
#pragma unroll
      for (int ni = 0; ni < 4; ++ni) { const int row = wc * 64 + ni * 16 + lr; bfr[ni] = *(const bf16x8*)(Bb + row * 128 + (((ks * 4 + lq) ^ (row & 7)) << 4)); }
#pragma unroll
      for (int mi = 0; mi < 4; ++mi)
#pragma unroll
        for (int ni = 0; ni < 4; ++ni) acc[mi][ni] = __builtin_amdgcn_mfma_f32_16x16x32_bf16(af[mi], bfr[ni], acc[mi][ni], 0, 0, 0);
    }
  };

  load_tile(0);
  store_tile(0);
  __syncthreads();
  for (int kt = 0; kt < nk; ++kt) {
    if (kt + 1 < nk) load_tile(kt + 1);
    __builtin_amdgcn_sched_barrier(0);
    compute(kt & 1);
    __builtin_amdgcn_sched_barrier(0);
    if (kt + 1 < nk) store_tile((kt + 1) & 1);
    __syncthreads();
  }

  gemm_epilogue<EP, 4>(p, c, nt, m0, wr, lq, lr, wc * 64, acc, lds);
}


template <int AL, int EP>
__device__ __forceinline__ void gemm_wide(const P& p, const GemmCtx& c, const int mt, const int nt2, char* lds) {
  const int tid = threadIdx.x, lane = tid & 63, wid = tid >> 6;
  const int wr = wid >> 1, wc = wid & 1, lr = lane & 15, lq = lane >> 4;
  const int m0 = mt * 128, n0 = nt2 * 256;
  const int K = c.K, nk = K >> 5;
  const bf16_t* A = c.A;
  const bf16_t* Bt = c.Bt;
  const float* mu = c.aux;
  const int lc = tid & 3, lrow = tid >> 2;
  f32x4 acc[4][8];
#pragma unroll
  for (int i = 0; i < 4; ++i)
#pragma unroll
    for (int j = 0; j < 8; ++j) acc[i][j] = f32x4{0.f, 0.f, 0.f, 0.f};
  bf16x8 ra[2], rp[2], rb[4]; f32x4 ax0, ax1;
  auto load_tile = [&](int kt) {
#pragma unroll
    for (int i = 0; i < 4; ++i) rb[i] = *(const bf16x8*)(Bt + (size_t)(n0 + lrow + 64 * i) * K + kt * 32 + lc * 8);
#pragma unroll
    for (int i = 0; i < 2; ++i) {
      const int m = m0 + lrow + 64 * i;
      const bf16_t* src = A + (size_t)m * c.lda + kt * 32 + lc * 8;
      ra[i] = *(const bf16x8*)src;
      if constexpr (AL == AL_MIX) { if ((m & (TSEQ - 1)) != 0) rp[i] = *(const bf16x8*)(src - DM); else rp[i] = bf16x8{0, 0, 0, 0, 0, 0, 0, 0}; }
    }
    if constexpr (AL == AL_MIX) { ax0 = *(const f32x4*)(mu + kt * 32 + lc * 8); ax1 = *(const f32x4*)(mu + kt * 32 + lc * 8 + 4); }
  };
  auto store_tile = [&](int buf) {
    char* Ab = lds + buf * 24576; char* Bb = Ab + 8192;
#pragma unroll
    for (int i = 0; i < 4; ++i) { const int row = lrow + 64 * i; *(bf16x8*)(Bb + row * 64 + ((lc ^ ((-(row >> 2)) & 3)) << 4)) = rb[i]; }
#pragma unroll
    for (int i = 0; i < 2; ++i) {
      const int row = lrow + 64 * i;
      if constexpr (AL == AL_MIX) {
        const float muv[8] = {ax0[0], ax0[1], ax0[2], ax0[3], ax1[0], ax1[1], ax1[2], ax1[3]};
        float f[8], fp[8]; unpack8(ra[i], f); unpack8(rp[i], fp);
#pragma unroll
        for (int e = 0; e < 8; ++e) f[e] = f[e] + (fp[e] - f[e]) * muv[e];
        *(bf16x8*)(Ab + row * 64 + ((lc ^ ((-(row >> 2)) & 3)) << 4)) = pack8f(f);
      } else {
        *(bf16x8*)(Ab + row * 64 + ((lc ^ ((-(row >> 2)) & 3)) << 4)) = ra[i];
      }
    }
  };
  auto compute = [&](int buf) {
    const char* Ab = lds + buf * 24576; const char* Bb = Ab + 8192;
    const int sw = (lq ^ ((-(lr >> 2)) & 3)) << 4;
    bf16x8 af[4];
#pragma unroll
    for (int mi = 0; mi < 4; ++mi) af[mi] = *(const bf16x8*)(Ab + (wr * 64 + mi * 16 + lr) * 64 + sw);
#pragma unroll
    for (int nh = 0; nh < 2; ++nh) {
      bf16x8 bfr[4];
#pragma unroll
      for (int ni = 0; ni < 4; ++ni) bfr[ni] = *(const bf16x8*)(Bb + (wc * 128 + (nh * 4 + ni) * 16 + lr) * 64 + sw);
#pragma unroll
      for (int mi = 0; mi < 4; ++mi)
#pragma unroll
        for (int ni = 0; ni < 4; ++ni) acc[mi][nh * 4 + ni] = __builtin_amdgcn_mfma_f32_16x16x32_bf16(af[mi], bfr[ni], acc[mi][nh * 4 + ni], 0, 0, 0);
    }
  };
  load_tile(0);
  store_tile(0);
  __syncthreads();
  for (int kt = 0; kt < nk; ++kt) {
    if (kt + 1 < nk) load_tile(kt + 1);
    __builtin_amdgcn_sched_barrier(0);
    compute(kt & 1);
    __builtin_amdgcn_sched_barrier(0);
    if (kt + 1 < nk) store_tile((kt + 1) & 1);
    __syncthreads();
  }
  gemm_epilogue<EP, 8>(p, c, 2 * nt2 + wc, m0, wr, lq, lr, 0, acc, lds);
}

__device__ __forceinline__ float sum16(float x) {
  x += DPP(x, 0xB1); x += DPP(x, 0x4E); x += DPP(x, 0x141); x += DPP(x, 0x140); return x;
}
__device__ __forceinline__ void scan_item(const P& p, const int layer, const int item, char* lds) {
  const int quarter = item & 3, h = (item >> 2) & 31, b = item >> 7;
  const int tid = threadIdx.x, lane = tid & 63, wid = tid >> 6;
  float* R = (float*)lds;
  float* W = R + 2048; float* Kk = W + 2048; float* Aa = Kk + 2048; float* Bv = Aa + 2048;
  float* V = Bv + 2048;
  float* Vg = V + 512;
  float* O = Vg + 512;
  float* KKp = O + 528; float* KAp = KKp + 64; float* RKp = KAp + 64;
  float* LBp = RKp + 64;
  const bf16_t* vsrc = p.vA + (size_t)layer * (64u << 20);
  bf16_t* vdst = p.vB;
  const int tl = tid >> 3, c8 = tid & 7;
  const int ch0 = h * 64 + c8 * 8;
  const int vc0 = h * 64 + quarter * 16;
  const int lr = lane & 15, lq = lane >> 4;
  const int ten = wid >> 1, lmi = wid & 1;
  const bf16_t* lA = p.lw + (size_t)ten * (2u << 20);
  const bf16_t* lB = p.W2w + (size_t)ten * (256u << 10);
  if (tid < 64) {
    KKp[tid] = p.a_k_k[layer * DM + h * 64 + tid]; KAp[tid] = p.a_k_a[layer * DM + h * 64 + tid]; RKp[tid] = p.a_r_k[layer * DM + h * 64 + tid];
  }
  if (tid < 128) { const float b0_ = p.a_w0[layer * DM + h * 64 + (tid & 63)], b1_ = p.a_a0[layer * DM + h * 64 + (tid & 63)]; LBp[tid] = tid < 64 ? b0_ : b1_; }
  if (tid >= 128 && tid < 144) LBp[tid] = layer == 1 ? p.a_v0[vc0 + (tid - 128)] : 0.f;
  const int row = tid >> 4, kq = tid & 15;
  f32x2 S01 = {0.f, 0.f}, S23 = {0.f, 0.f};

  const size_t tok0 = (size_t)b * TSEQ;
  bf16x8 rr, rk, rv, rvf;
  bf16x8 wB[3][4], wBv[2], fA[3], fAv[2];
#pragma unroll
  for (int ks = 0; ks < 3; ++ks)
#pragma unroll
    for (int ni = 0; ni < 4; ++ni) wB[ks][ni] = *(const bf16x8*)(lB + (size_t)(h * 64 + ni * 16 + lr) * 128 + ks * 32 + lq * 8);
  if (layer == 1) {
#pragma unroll
    for (int ks = 0; ks < 2; ++ks) wBv[ks] = *(const bf16x8*)(p.W2v + (size_t)(vc0 + lr) * 128 + ks * 32 + lq * 8);
  }
  auto load_raw = [&](int c) {
    const size_t m = tok0 + c * 32 + tl;
    {
      const size_t ml = tok0 + c * 32 + lmi * 16 + lr;
#pragma unroll
      for (int ks = 0; ks < 3; ++ks) fA[ks] = *(const bf16x8*)(lA + ml * 128 + ks * 32 + lq * 8);
      if (layer == 1) {
#pragma unroll
        for (int ks = 0; ks < 2; ++ks) fAv[ks] = *(const bf16x8*)(p.lv + ml * 128 + ks * 32 + lq * 8);
      }
    }
    rr = *(const bf16x8*)(p.r + m * DM + ch0);
    rk = *(const bf16x8*)(p.k + m * DM + ch0);
    if (c8 < 2) {
      rv = *(const bf16x8*)(vsrc + m * DM + vc0 + c8 * 8);
      if (layer == 1) rvf = *(const bf16x8*)(p.vA + m * DM + vc0 + c8 * 8);
    }
  };
  load_raw(0);
  __syncthreads();
  for (int c = 0; c < TSEQ / 32; ++c) {
    const size_t mc = tok0 + c * 32;
    {
      f32x4 acc[4];
#pragma unroll
      for (int ni = 0; ni < 4; ++ni) acc[ni] = f32x4{0.f, 0.f, 0.f, 0.f};
#pragma unroll
      for (int ks = 0; ks < 3; ++ks) {
#pragma unroll
        for (int ni = 0; ni < 4; ++ni) acc[ni] = __builtin_amdgcn_mfma_f32_16x16x32_bf16(fA[ks], wB[ks][ni], acc[ni], 0, 0, 0);
      }
      float* dstL = ten == 0 ? W : Bv;
#pragma unroll
      for (int ni = 0; ni < 4; ++ni)
#pragma unroll
        for (int j = 0; j < 4; ++j) {
          float sg = sigmoidf_(acc[ni][j] + LBp[ten * 64 + ni * 16 + lr]);
          float val = ten == 0 ? __expf(-0.6065306597126334f * sg) : sg;
          dstL[(lmi * 16 + lq * 4 + j) * 64 + ni * 16 + lr] = val;
        }
      if (layer == 1 && wid < 2) {
        f32x4 av = f32x4{0.f, 0.f, 0.f, 0.f};
#pragma unroll
        for (int ks = 0; ks < 2; ++ks) av = __builtin_amdgcn_mfma_f32_16x16x32_bf16(fAv[ks], wBv[ks], av, 0, 0, 0);
#pragma unroll
        for (int j = 0; j < 4; ++j) Vg[(wid * 16 + lq * 4 + j) * 16 + lr] = sigmoidf_(av[j] + LBp[128 + lr]);
      }
    }
    if (c > 0) {
      const float o0 = O[(c8 * 2) * 33 + tl], o1 = O[(c8 * 2 + 1) * 33 + tl];
      *(unsigned*)(p.ubuf + (mc - 32 + tl) * DM + vc0 + c8 * 2) = cvtpk(o0, o1);
    }
    __syncthreads();
    {
      float fr[8], fk[8], fa[8];
      unpack8(rr, fr); unpack8(rk, fk);
      { f32x4 a0 = *(const f32x4*)(Bv + tl * 64 + c8 * 8), a1 = *(const f32x4*)(Bv + tl * 64 + c8 * 8 + 4);
        fa[0] = a0[0]; fa[1] = a0[1]; fa[2] = a0[2]; fa[3] = a0[3]; fa[4] = a1[0]; fa[5] = a1[1]; fa[6] = a1[2]; fa[7] = a1[3]; }
      float kk[8], ss = 0.f, bsum = 0.f;
      float kkv[8], kav[8], rkv[8];
      { f32x4 t0 = *(const f32x4*)(KKp + c8 * 8), t1 = *(const f32x4*)(KKp + c8 * 8 + 4);
        kkv[0] = t0[0]; kkv[1] = t0[1]; kkv[2] = t0[2]; kkv[3] = t0[3]; kkv[4] = t1[0]; kkv[5] = t1[1]; kkv[6] = t1[2]; kkv[7] = t1[3];
        t0 = *(const f32x4*)(KAp + c8 * 8); t1 = *(const f32x4*)(KAp + c8 * 8 + 4);
        kav[0] = t0[0]; kav[1] = t0[1]; kav[2] = t0[2]; kav[3] = t0[3]; kav[4] = t1[0]; kav[5] = t1[1]; kav[6] = t1[2]; kav[7] = t1[3];
        t0 = *(const f32x4*)(RKp + c8 * 8); t1 = *(const f32x4*)(RKp + c8 * 8 + 4);
        rkv[0] = t0[0]; rkv[1] = t0[1]; rkv[2] = t0[2]; rkv[3] = t0[3]; rkv[4] = t1[0]; rkv[5] = t1[1]; rkv[6] = t1[2]; rkv[7] = t1[3]; }
#pragma unroll
      for (int e = 0; e < 8; ++e) { kk[e] = fk[e] * kkv[e]; ss += kk[e] * kk[e]; }
      ss = sum8(ss);
      const float inv = __builtin_amdgcn_rsqf(fmaxf(ss, 1e-24f));
      float kp[8], na[8], bb[8];
#pragma unroll
      for (int e = 0; e < 8; ++e) {
        kk[e] *= inv;
        kp[e] = fk[e] * (1.f + (fa[e] - 1.f) * kav[e]);
        na[e] = -kk[e]; bb[e] = kk[e] * fa[e];
        bsum += fr[e] * kp[e] * rkv[e];
      }
      bsum = sum8(bsum);
      float* d;
      d = R + tl * 64 + c8 * 8;  *(f32x4*)d = f32x4{fr[0], fr[1], fr[2], fr[3]}; *(f32x4*)(d + 4) = f32x4{fr[4], fr[5], fr[6], fr[7]};
      d = Kk + tl * 64 + c8 * 8; *(f32x4*)d = f32x4{kp[0], kp[1], kp[2], kp[3]}; *(f32x4*)(d + 4) = f32x4{kp[4], kp[5], kp[6], kp[7]};
      d = Aa + tl * 64 + c8 * 8; *(f32x4*)d = f32x4{na[0], na[1], na[2], na[3]}; *(f32x4*)(d + 4) = f32x4{na[4], na[5], na[6], na[7]};
      d = Bv + tl * 64 + c8 * 8; *(f32x4*)d = f32x4{bb[0], bb[1], bb[2], bb[3]}; *(f32x4*)(d + 4) = f32x4{bb[4], bb[5], bb[6], bb[7]};
      if (quarter == 0 && c8 == 0) p.bon[(mc + tl) * 32 + h] = bsum;
      if (c8 < 2) {
        float fv[8]; unpack8(rv, fv);
        if (layer == 1) {
          float ff[8]; unpack8(rvf, ff);
          f32x4 g0 = *(const f32x4*)(Vg + tl * 16 + c8 * 8), g1 = *(const f32x4*)(Vg + tl * 16 + c8 * 8 + 4);
          const float gg[8] = {g0[0], g0[1], g0[2], g0[3], g1[0], g1[1], g1[2], g1[3]};
#pragma unroll
          for (int e = 0; e < 8; ++e) fv[e] = fv[e] + (ff[e] - fv[e]) * gg[e];
          *(bf16x8*)(vdst + (mc + tl) * DM + vc0 + c8 * 8) = pack8f(fv);
        }
        d = V + tl * 16 + c8 * 8; *(f32x4*)d = f32x4{fv[0], fv[1], fv[2], fv[3]}; *(f32x4*)(d + 4) = f32x4{fv[4], fv[5], fv[6], fv[7]};
      }
    }
    __syncthreads();
    if (c + 1 < TSEQ / 32) load_raw(c + 1);
    {
      f32x4 xa, xw, xk, xb, xr, na_, nw_, nk_, nb_, nr_; float xv, nv;
      const float* bA = Aa + kq * 4; const float* bW = W + kq * 4; const float* bK = Kk + kq * 4; const float* bB = Bv + kq * 4; const float* bR = R + kq * 4;
      xa = *(const f32x4*)bA; xw = *(const f32x4*)bW; xk = *(const f32x4*)bK; xb = *(const f32x4*)bB; xr = *(const f32x4*)bR; xv = V[row];
      float opend = 0.f;
#pragma unroll 8
      for (int t = 0; t < 32; ++t) {
        const f32x2 xa01 = {xa[0], xa[1]}, xa23 = {xa[2], xa[3]};
        f32x2 pa = S01 * xa01; pa = __builtin_elementwise_fma(S23, xa23, pa);
        float ra_ = pa[0] + pa[1];
        __builtin_amdgcn_sched_barrier(0);
        {
          const int o_ = ((t + 1) & 31) * 64;
          na_ = *(const f32x4*)(bA + o_); nw_ = *(const f32x4*)(bW + o_); nk_ = *(const f32x4*)(bK + o_); nb_ = *(const f32x4*)(bB + o_); nr_ = *(const f32x4*)(bR + o_);
          nv = V[((t + 1) & 31) * 16 + row];
        }
        float ro_ = opend;
        ra_ += DPP(ra_, 0xB1); ro_ += DPP(ro_, 0xB1);
        ra_ += DPP(ra_, 0x4E); ro_ += DPP(ro_, 0x4E);
        ra_ += DPP(ra_, 0x141); ro_ += DPP(ro_, 0x141);
        ra_ += DPP(ra_, 0x140); ro_ += DPP(ro_, 0x140);
        O[row * 33 + ((t - 1) & 31)] = ro_;
        const f32x2 sa2 = {ra_, ra_}, xv2 = {xv, xv};
        const f32x2 xk01 = {xk[0], xk[1]}, xk23 = {xk[2], xk[3]}, xb01 = {xb[0], xb[1]}, xb23 = {xb[2], xb[3]};
        const f32x2 xw01 = {xw[0], xw[1]}, xw23 = {xw[2], xw[3]}, xr01 = {xr[0], xr[1]}, xr23 = {xr[2], xr[3]};
        S01 = __builtin_elementwise_fma(S01, xw01, __builtin_elementwise_fma(sa2, xb01, xv2 * xk01));
        S23 = __builtin_elementwise_fma(S23, xw23, __builtin_elementwise_fma(sa2, xb23, xv2 * xk23));
        f32x2 po = S01 * xr01; po = __builtin_elementwise_fma(S23, xr23, po);
        opend = po[0] + po[1];
        xa = na_; xw = nw_; xk = nk_; xb = nb_; xr = nr_; xv = nv;
      }
      { const float ro_ = sum16(opend); O[row * 33 + 31] = ro_; }
    }
    __syncthreads();
  }
  {
    const size_t mp = tok0 + (TSEQ - 32);
    const float o0 = O[(c8 * 2) * 33 + tl], o1 = O[(c8 * 2 + 1) * 33 + tl];
    *(unsigned*)(p.ubuf + (mp + tl) * DM + vc0 + c8 * 2) = cvtpk(o0, o1);
  }
  __syncthreads();
}

__device__ __forceinline__ void postscan_phase(const P& p, const int layer) {
  const int tid = threadIdx.x, head = tid >> 3, ch = tid * 8;
  const bf16_t* vsrc = p.vA + (size_t)layer * (64u << 20);
  float lg[8], lb[8];
  {
    const float* pg = p.a_ln_g + layer * DM + ch; const float* pb = p.a_ln_b + layer * DM + ch;
#pragma unroll
    for (int e = 0; e < 8; ++e) { lg[e] = pg[e]; lb[e] = pb[e]; }
  }
  for (int m0 = blockIdx.x; m0 < MTOK; m0 += 4 * gridDim.x) {
    bf16x8 ro[4], rv[4], rz[4]; float bn[4];
#pragma unroll
    for (int u = 0; u < 4; ++u) {
      const int m = m0 + u * gridDim.x;
      if (m < MTOK) {
        ro[u] = *(const bf16x8*)(p.ubuf + (size_t)m * DM + ch);
        rv[u] = *(const bf16x8*)(vsrc + (size_t)m * DM + ch);
        rz[u] = *(const bf16x8*)(p.z + (size_t)m * DM + ch);
        bn[u] = p.bon[(size_t)m * 32 + head];
      }
    }
#pragma unroll
    for (int u = 0; u < 4; ++u) {
      const int m = m0 + u * gridDim.x;
      if (m < MTOK) {
        float fo[8], fv[8], fz[8];
        unpack8(ro[u], fo); unpack8(rv[u], fv); unpack8(rz[u], fz);
        float sm = 0.f;
#pragma unroll
        for (int e = 0; e < 8; ++e) sm += fo[e];
        const float mean = sum8(sm) * (1.f / 64.f);
        float sv = 0.f;
#pragma unroll
        for (int e = 0; e < 8; ++e) { fo[e] -= mean; sv += fo[e] * fo[e]; }
        const float rstd = rsqrtf(sum8(sv) * (1.f / 64.f) + 64e-5f);
#pragma unroll
        for (int e = 0; e < 8; ++e) fo[e] = (fo[e] * rstd * lg[e] + lb[e] + bn[u] * fv[e]) * siluf_(fz[e]);
        *(bf16x8*)(p.ubuf + (size_t)m * DM + ch) = pack8f(fo);
      }
    }
  }
}

__device__ __forceinline__ void cmp_item(const P& p, const int item, char* lds) {
  const int qb = (item & 512) ? 63 - (item & 63) : (item & 63), g = (item >> 6) & 3, b = item >> 8;
  const int bg = b * 4 + g;
  const int tid = threadIdx.x, lane = tid & 63, w = tid >> 6;
  const int n = lane & 31, hi = lane >> 5;
  float* impM = (float*)lds;
  float* impS = impM + 64 * 68;
  for (int e = lane; e < 16 * 68; e += 64) { impM[w * 16 * 68 + e] = 0.f; impS[w * 16 * 68 + e] = 0.f; }
  const int ql = 16 * w + (n & 15);
  const int tq = qb * 64 + ql;
  const size_t m = (size_t)b * TSEQ + tq;
  const int cmaxq = (tq - 31) >> 4;
  const int nkt = (4 * qb + 3 + 31) >> 5;
  const bf16_t* Kc = p.kcmp + (size_t)bg * 256 * 128;
  const bf16_t* Vc = p.vcmpT + (size_t)bg * 128 * 256;
  const float NEG = -__builtin_inff();
#pragma unroll 1
  for (int ct = 0; ct < 2; ++ct) {
    const int head = g * 4 + 2 * ct + (n >> 4);
    bf16x8 qf[8];
#pragma unroll
    for (int d0 = 0; d0 < 8; ++d0) qf[d0] = *(const bf16x8*)(p.q + m * DM + head * 128 + d0 * 16 + hi * 8);
    float mx = -1e30f, l = 0.f;
#pragma unroll 1
    for (int kt = 0; kt < nkt; ++kt) {
      f32x16 sc; for (int r = 0; r < 16; ++r) sc[r] = 0.f;
#pragma unroll
      for (int d0 = 0; d0 < 8; ++d0) {
        bf16x8 kf = *(const bf16x8*)(Kc + (size_t)(kt * 32 + n) * 128 + d0 * 16 + hi * 8);
        sc = __builtin_amdgcn_mfma_f32_32x32x16_bf16(kf, qf[d0], sc, 0, 0, 0);
      }
      float tm = NEG;
#pragma unroll
      for (int r = 0; r < 16; ++r) { const int cc = kt * 32 + crow(r, hi); if (cc > cmaxq) sc[r] = NEG; tm = fmaxf(tm, sc[r]); }
      tm = swap32_max(tm);
      const float mn = fmaxf(mx, tm);
      float ps = 0.f;
#pragma unroll
      for (int r = 0; r < 16; ++r) ps += __builtin_amdgcn_exp2f(sc[r] - mn);
      ps = swap32_sum(ps);
      l = l * __builtin_amdgcn_exp2f(mx - mn) + ps; mx = mn;
    }
    const float inv_l = l > 0.f ? 1.f / l : 0.f;
    f32x16 o[4];
#pragma unroll
    for (int dt = 0; dt < 4; ++dt) for (int r = 0; r < 16; ++r) o[dt][r] = 0.f;
#pragma unroll 1
    for (int kt = 0; kt < nkt; ++kt) {
      f32x16 sc; for (int r = 0; r < 16; ++r) sc[r] = 0.f;
#pragma unroll
      for (int d0 = 0; d0 < 8; ++d0) {
        bf16x8 kf = *(const bf16x8*)(Kc + (size_t)(kt * 32 + n) * 128 + d0 * 16 + hi * 8);
        sc = __builtin_amdgcn_mfma_f32_32x32x16_bf16(kf, qf[d0], sc, 0, 0, 0);
      }
      float pr[16];
#pragma unroll
      for (int r = 0; r < 16; ++r) { const int cc = kt * 32 + crow(r, hi); pr[r] = (cc > cmaxq) ? 0.f : __builtin_amdgcn_exp2f(sc[r] - mx) * inv_l; }
#pragma unroll
      for (int a = 0; a < 4; ++a) {
        float mainv = pr[4 * a] + pr[4 * a + 1] + pr[4 * a + 2] + 0.5f * pr[4 * a + 3];
        float spill = 0.5f * pr[4 * a + 3];
        mainv += __shfl_xor(mainv, 16); spill += __shfl_xor(spill, 16);
        if ((n & 16) == 0) {
          const int jj = 8 * kt + 2 * a + hi;
          impM[ql * 68 + jj] += mainv; impS[ql * 68 + jj + 1] += spill;
        }
      }
      const float pf0[8] = {pr[0], pr[1], pr[2], pr[3], pr[4], pr[5], pr[6], pr[7]};
      const float pf1[8] = {pr[8], pr[9], pr[10], pr[11], pr[12], pr[13], pr[14], pr[15]};
      const bf16x8 pb0 = pack8f(pf0), pb1 = pack8f(pf1);
#pragma unroll
      for (int dt = 0; dt < 4; ++dt) {
        const bf16_t* vp = Vc + (size_t)(dt * 32 + n) * 256 + kt * 32 + hi * 8;
        bf16x8 v0 = *(const bf16x8*)vp, v1 = *(const bf16x8*)(vp + 16);
        o[dt] = __builtin_amdgcn_mfma_f32_32x32x16_bf16(v0, pb0, o[dt], 0, 0, 0);
        o[dt] = __builtin_amdgcn_mfma_f32_32x32x16_bf16(v1, pb1, o[dt], 0, 0, 0);
      }
    }
    const float gt = p.gates[m * 48 + head * 3 + 0];
#pragma unroll
    for (int dt = 0; dt < 4; ++dt)
#pragma unroll
      for (int a = 0; a < 4; ++a) {
        u32x2 wv = {cvtpk(o[dt][4 * a] * gt, o[dt][4 * a + 1] * gt), cvtpk(o[dt][4 * a + 2] * gt, o[dt][4 * a + 3] * gt)};
        *(u32x2*)(p.ocmp + m * DM + head * 128 + dt * 32 + 8 * a + 4 * hi) = wv;
      }
  }
  __syncthreads();
  {
    const int qq = 16 * w + (lane >> 2), part = lane & 3;
    const int cur = qb;
    unsigned lo, hi32;
    if (cur < 16) { lo = (2u << cur) - 1u; hi32 = 0u; }
    else {
      float* rowp = impM + qq * 68; const float* rows = impS + qq * 68;
      for (int e = 0; e < 16; ++e) { const int j = part * 16 + e; rowp[j] = rowp[j] + rows[j]; }
      __builtin_amdgcn_fence(__ATOMIC_RELEASE, "wavefront");
      __builtin_amdgcn_wave_barrier();
      float vj[16]; int rank[16];
#pragma unroll
      for (int e = 0; e < 16; ++e) { vj[e] = rowp[part * 16 + e]; rank[e] = 0; }
      for (int j2 = 1; j2 <= cur - 2; ++j2) {
        const float v2 = rowp[j2];
#pragma unroll
        for (int e = 0; e < 16; ++e) { const int j = part * 16 + e; rank[e] += (v2 > vj[e] || (v2 == vj[e] && j2 < j)) ? 1 : 0; }
      }
      unsigned bits = 0;
#pragma unroll
      for (int e = 0; e < 16; ++e) { const int j = part * 16 + e; if (j >= 1 && j <= cur - 2 && rank[e] < 13) bits |= 1u << e; }
      const int base = lane & ~3;
      const unsigned b0 = __shfl(bits, base), b1 = __shfl(bits, base + 1), b2 = __shfl(bits, base + 2), b3 = __shfl(bits, base + 3);
      lo = b0 | (b1 << 16); hi32 = b2 | (b3 << 16);
      lo |= 1u;
      { const int j = cur - 1; if (j < 32) lo |= 1u << j; else hi32 |= 1u << (j - 32); }
      { const int j = cur; if (j < 32) lo |= 1u << j; else hi32 |= 1u << (j - 32); }
    }
    if (part == 0) {
      unsigned* sp = p.selmask + ((size_t)bg * TSEQ + qb * 64 + qq) * 2;
      sp[0] = lo; sp[1] = hi32;
    }
  }
  __syncthreads();
}

template <int BR>
__device__ __forceinline__ void attn_pass(const P& p, const int b, const int g, const int qb, const int head, const int tq, const bf16x8* qf,
                                          unsigned long long tiles, const unsigned long long mysel, char* lds) {
  const int tid = threadIdx.x, lane = tid & 63;
  const int kl = lane & 31, hi = lane >> 5;
  const int bg = b * 4 + g;
  const bf16_t* Kg = (BR == 0 ? p.kw : p.ks) + (size_t)bg * TSEQ * 128;
  const bf16_t* Vg = (BR == 0 ? p.vwT : p.vsT) + (size_t)bg * 128 * TSEQ;
  const unsigned Wlim = BR == 0 ? 512u : 0x80000000u;
  const float NEG = -__builtin_inff();
  f32x16 o[4];
#pragma unroll
  for (int dt = 0; dt < 4; ++dt) for (int r = 0; r < 16; ++r) o[dt][r] = 0.f;
  float mx = -1e30f, l = 0.f;
  bf16x8 sk[4], sv[4];
  auto load_tile = [&](int j) {
#pragma unroll
    for (int i = 0; i < 4; ++i) {
      const int id = tid + 256 * i;
      sk[i] = *(const bf16x8*)(Kg + (size_t)(j * 64 + (id >> 4)) * 128 + (id & 15) * 8);
      sv[i] = *(const bf16x8*)(Vg + (size_t)(id >> 3) * TSEQ + j * 64 + (id & 7) * 8);
    }
  };
  auto store_tile = [&](int buf) {
    char* Kb = lds + buf * ATT_BUF; char* Vb = Kb + ATT_KSZ;
#pragma unroll
    for (int i = 0; i < 4; ++i) {
      const int id = tid + 256 * i;
      { const int row = id >> 4, c16 = id & 15; *(bf16x8*)(Kb + row * 272 + (c16 << 4)) = sk[i]; }
      { const int d = id >> 3, cx = id & 7; *(bf16x8*)(Vb + d * 144 + (cx << 4)) = sv[i]; }
    }
  };
  int j = __builtin_ctzll(tiles); tiles &= tiles - 1;
  load_tile(j);
  store_tile(0);
  __syncthreads();
  int buf = 0;
  while (true) {
    const bool more = tiles != 0ull;
    int jn = 0;
    if (more) { jn = __builtin_ctzll(tiles); tiles &= tiles - 1; load_tile(jn); }
    {
      const char* Kb = lds + buf * ATT_BUF + kl * 272 + hi * 16; const char* Vb = lds + buf * ATT_BUF + ATT_KSZ + kl * 144 + hi * 16;
      const bool lane_ok = BR == 0 ? true : ((mysel >> j) & 1ull) != 0ull;
      const bool wave_any = __any(lane_ok);
      const bool boundary = BR == 0 ? (j == qb || j + 8 == qb) : (j == qb);
      if (wave_any) {
#pragma unroll
        for (int hs = 0; hs < 2; ++hs) {
          f32x16 sc; for (int r = 0; r < 16; ++r) sc[r] = 0.f;
#pragma unroll
          for (int d0 = 0; d0 < 8; ++d0) {
            bf16x8 kf = *(const bf16x8*)(Kb + hs * 32 * 272 + d0 * 32);
            sc = __builtin_amdgcn_mfma_f32_32x32x16_bf16(kf, qf[d0], sc, 0, 0, 0);
          }
          if (boundary) {
            const int dq = tq - (j * 64 + hs * 32 + 4 * hi);
#pragma unroll
            for (int r = 0; r < 16; ++r) { const int cidx = (r & 3) + 8 * (r >> 2); if ((unsigned)(dq - cidx) >= Wlim) sc[r] = NEG; }
          }
          if (BR == 1) {
#pragma unroll
            for (int r = 0; r < 16; ++r) sc[r] = lane_ok ? sc[r] : NEG;
          }
          float tm = sc[0];
#pragma unroll
          for (int r = 1; r < 16; ++r) tm = fmaxf(tm, sc[r]);
          tm = swap32_max(tm);
          if (!__all(tm <= mx + 8.f)) {
            const float mn = fmaxf(mx, tm);
            const float alpha = __builtin_amdgcn_exp2f(mx - mn);
            l *= alpha; mx = mn;
#pragma unroll
            for (int dt = 0; dt < 4; ++dt)
#pragma unroll
              for (int r = 0; r < 16; ++r) o[dt][r] *= alpha;
          }
          float pr[16]; float ps = 0.f;
#pragma unroll
          for (int r = 0; r < 16; ++r) { pr[r] = __builtin_amdgcn_exp2f(sc[r] - mx); ps += pr[r]; }
          ps = swap32_sum(ps);
          l += ps;
          const float pf0[8] = {pr[0], pr[1], pr[2], pr[3], pr[4], pr[5], pr[6], pr[7]};
          const float pf1[8] = {pr[8], pr[9], pr[10], pr[11], pr[12], pr[13], pr[14], pr[15]};
          const bf16x8 pb0 = pack8f(pf0), pb1 = pack8f(pf1);
#pragma unroll
          for (int dt = 0; dt < 4; ++dt) {
            bf16x8 v0 = *(const bf16x8*)(Vb + dt * 32 * 144 + hs * 64);
            bf16x8 v1 = *(const bf16x8*)(Vb + dt * 32 * 144 + hs * 64 + 32);
            o[dt] = __builtin_amdgcn_mfma_f32_32x32x16_bf16(v0, pb0, o[dt], 0, 0, 0);
            o[dt] = __builtin_amdgcn_mfma_f32_32x32x16_bf16(v1, pb1, o[dt], 0, 0, 0);
          }
        }
      }
    }
    if (more) store_tile(buf ^ 1);
    __syncthreads();
    if (!more) break;
    j = jn; buf ^= 1;
  }
  const size_t m = (size_t)b * TSEQ + tq;
  const float gt = p.gates[m * 48 + head * 3 + (BR == 0 ? 2 : 1)];
  const float sc_ = gt / l;
  if (BR == 0) {
#pragma unroll
    for (int dt = 0; dt < 4; ++dt)
#pragma unroll
      for (int a = 0; a < 4; ++a) {
        const size_t idx = m * DM + head * 128 + dt * 32 + 8 * a + 4 * hi;
        *(u32x2*)(p.ubuf + idx) = u32x2{cvtpk(o[dt][4 * a] * sc_, o[dt][4 * a + 1] * sc_), cvtpk(o[dt][4 * a + 2] * sc_, o[dt][4 * a + 3] * sc_)};
      }
  } else {
#pragma unroll
    for (int dt = 0; dt < 4; ++dt)
#pragma unroll
      for (int a = 0; a < 4; ++a) {
        const size_t idx = m * DM + head * 128 + dt * 32 + 8 * a + 4 * hi;
        const u32x2 oc = *(const u32x2*)(p.ocmp + idx);
        const u32x2 zz = *(const u32x2*)(p.sz + idx);
        const u32x2 ww = *(const u32x2*)(p.ubuf + idx);
        const float y0 = (o[dt][4 * a] * sc_ + bflo(ww[0]) + bflo(oc[0])) * bflo(zz[0]);
        const float y1 = (o[dt][4 * a + 1] * sc_ + bfhi(ww[0]) + bfhi(oc[0])) * bfhi(zz[0]);
        const float y2 = (o[dt][4 * a + 2] * sc_ + bflo(ww[1]) + bflo(oc[1])) * bflo(zz[1]);
        const float y3 = (o[dt][4 * a + 3] * sc_ + bfhi(ww[1]) + bfhi(oc[1])) * bfhi(zz[1]);
        *(u32x2*)(p.ubuf + idx) = u32x2{cvtpk(y0, y1), cvtpk(y2, y3)};
      }
  }
}

__device__ __forceinline__ void attn_item(const P& p, const int item, char* lds, unsigned long long* uni) {
  const int half = item & 1, g = (item >> 1) & 3, b = (item >> 3) & 3, qb = 63 - (item >> 5);
  const int tid = threadIdx.x, lane = tid & 63, w = tid >> 6;
  const int kl = lane & 31, hi = lane >> 5;
  const int head = g * 4 + half * 2 + (w >> 1);
  const int tq = qb * 64 + (w & 1) * 32 + kl;
  const size_t m = (size_t)b * TSEQ + tq;
  bf16x8 qf[8];
#pragma unroll
  for (int d0 = 0; d0 < 8; ++d0) qf[d0] = *(const bf16x8*)(p.q + m * DM + head * 128 + d0 * 16 + hi * 8);
  const unsigned* sp = p.selmask + ((size_t)(b * 4 + g) * TSEQ + tq) * 2;
  const unsigned long long mysel = (unsigned long long)sp[0] | ((unsigned long long)sp[1] << 32);
  unsigned long long u = mysel;
#pragma unroll
  for (int o = 16; o >= 1; o >>= 1) { u |= (unsigned long long)__shfl_xor((unsigned)u, o) | ((unsigned long long)__shfl_xor((unsigned)(u >> 32), o) << 32); }
  if (lane == 0) uni[w] = u;
  __syncthreads();
  const unsigned long long U = (uni[0] | uni[1] | uni[2] | uni[3]) & (qb == 63 ? ~0ull : ((2ull << qb) - 1ull));
  const int jlo = qb >= 8 ? qb - 8 : 0;
  const unsigned long long wt = (qb == 63 ? ~0ull : ((2ull << qb) - 1ull)) & ~((1ull << jlo) - 1ull);
  attn_pass<0>(p, b, g, qb, head, tq, qf, wt, mysel, lds);
  attn_pass<1>(p, b, g, qb, head, tq, qf, U, mysel, lds);
}

typedef __attribute__((address_space(1))) unsigned gunsigned;
__device__ __forceinline__ unsigned gb_ld(unsigned* p) { return __hip_atomic_load((gunsigned*)p, __ATOMIC_RELAXED, __HIP_MEMORY_SCOPE_AGENT); }
__device__ __forceinline__ unsigned gb_add(unsigned* p, unsigned v) { return __hip_atomic_fetch_add((gunsigned*)p, v, __ATOMIC_RELAXED, __HIP_MEMORY_SCOPE_AGENT); }
__device__ __forceinline__ void grid_barrier(unsigned* bar, const unsigned e) {
  __builtin_amdgcn_fence(__ATOMIC_RELEASE, "workgroup");
  __builtin_amdgcn_s_waitcnt(0);
  __syncthreads();
  if (threadIdx.x == 0) {
    const unsigned G = gridDim.x, g = blockIdx.x & 7u;
    const unsigned ngrp = G < 8u ? G : 8u, nloc = (G + 7u - g) >> 3;
    __builtin_amdgcn_fence(__ATOMIC_RELEASE, "agent");
    __builtin_amdgcn_s_waitcnt(0);
    const unsigned old = gb_add(&bar[64u * (1u + g)], 1u);
    if (old + 1u == (e + 1u) * nloc) {
      const unsigned og = gb_add(&bar[0], 1u);
      if (og + 1u == (e + 1u) * ngrp) gb_add(&bar[64u * 20u], 1u);
      else { unsigned sp = 0; while (gb_ld(&bar[64u * 20u]) <= e && ++sp < (1u << 24)) __builtin_amdgcn_s_sleep(1); }
      gb_add(&bar[64u * (10u + g)], 1u);
    } else {
      unsigned sp = 0; while (gb_ld(&bar[64u * (10u + g)]) <= e && ++sp < (1u << 24)) __builtin_amdgcn_s_sleep(1);
    }
    __builtin_amdgcn_fence(__ATOMIC_ACQUIRE, "agent");
    __builtin_amdgcn_s_waitcnt(0);
  }
  __syncthreads();
}

#define NPHASE 23
#ifndef GRP
#define GRP 0xFFFF
#endif
#define EN(b) ((GRP >> (b)) & 1)
#ifndef DUPMASK
#define DUPMASK 0
#endif
#define PHASE(n, en, ...) if (ph_lo <= (n) && (n) < ph_hi) { if (EN(en)) { __VA_ARGS__ if ((DUPMASK >> (n)) & 1) { __syncthreads(); __VA_ARGS__ } } if ((n) + 1 < ph_hi) { if ((n) == 0) cg::this_grid().sync(); else grid_barrier(bar, (unsigned)((n) - 1)); } }

__device__ __forceinline__ bool deal_tile(int r, int NT, int& mt, int& nt) {
  const int G = gridDim.x, bid = blockIdx.x;
  if (G == 512) {
    const int x = bid & 7, lb = bid >> 3;
    const int NG = NT >> 3, rem = NT & 7;
    if (r < 2 * NG) { mt = 16 * x + (r & 1) * 8 + (lb >> 3); nt = (r >> 1) * 8 + (lb & 7); return true; }
    const int idx = (r - 2 * NG) * 64 + lb;
    if (idx < 16 * rem) { mt = 16 * x + idx / rem; nt = NG * 8 + idx % rem; return true; }
    return false;
  }
  const int t = bid + r * G;
  if (t < 128 * NT) { mt = t / NT; nt = t % NT; return true; }
  return false;
}
__device__ __forceinline__ int deal_rounds(int NT) {
  const int G = gridDim.x;
  if (G == 512) return 2 * (NT >> 3) + (16 * (NT & 7) + 63) / 64;
  return (128 * NT + G - 1) / G;
}
__device__ __forceinline__ void ph_proj(const P& p, int layer, char* lds) {
  {
    const int nr = deal_rounds(32);
    for (int r = 0; r < nr; ++r) {
      int mt, nt2;
      if (!deal_tile(r, 32, mt, nt2)) continue;
      GemmCtx cw; cw.A = p.ubuf; cw.lda = DM; cw.K = DM; cw.layer = layer; cw.j = 0; cw.Bt = p.Wp;
      cw.aux = p.a_mu + (size_t)(layer * 6 + (nt2 >> 3)) * DM;
      gemm_wide<AL_MIX, EP_PROJ>(p, cw, mt, nt2, lds);
    }
  }
  const int NL = layer == 0 ? 2 : 3;
  GemmCtx c; c.A = p.ubuf; c.lda = DM; c.K = DM; c.layer = layer; c.j = 0; c.Bt = p.Wp;
  const int nr = deal_rounds(NL);
  for (int r = 0; r < nr; ++r) {
    int mt, ntl;
    if (!deal_tile(r, NL, mt, ntl)) continue;
    const int nt = 64 + ntl;
    const int mui = nt == 64 ? 4 : nt == 65 ? 5 : 2;
    c.aux = p.a_mu + (size_t)(layer * 6 + mui) * DM;
    gemm_tile<AL_MIX, EP_PROJ>(p, c, mt, nt, lds);
  }
}
__device__ __forceinline__ void ph_wo(const P& p, int layer, const bf16_t* Wt, char* lds) {
  GemmCtx c; c.A = p.ubuf; c.lda = DM; c.Bt = Wt; c.K = DM; c.layer = layer; c.j = 0; c.aux = nullptr;
  const int nr = deal_rounds(8);
  for (int r = 0; r < nr; ++r) {
    int mt, nt2;
    if (!deal_tile(r, 8, mt, nt2)) continue;
    gemm_wide<AL_PLAIN, EP_RESID>(p, c, mt, nt2, lds);
  }
}
__device__ __forceinline__ void ph_kvwin(const P& p, int jl, int NTK, char* lds) {
  const int NK2 = NTK >> 1, NT2 = NK2 + 16;
  {
    const int nr = deal_rounds(NT2);
    for (int r = 0; r < nr; ++r) {
      int mt, nt2;
      if (!deal_tile(r, NT2, mt, nt2)) continue;
      GemmCtx c; c.lda = DM; c.K = DM; c.layer = 1; c.j = jl; c.aux = nullptr;
      if (nt2 < NK2) { c.A = p.hn; c.Bt = p.Wkv; gemm_wide<AL_PLAIN, EP_KV>(p, c, mt, nt2, lds); }
      else { c.A = p.ubuf; c.Bt = p.Win; gemm_wide<AL_PLAIN, EP_WIN>(p, c, mt, nt2 - NK2, lds); }
    }
  }
  if (jl != 0) {
    GemmCtx c; c.lda = DM; c.K = DM; c.layer = 1; c.j = jl; c.aux = nullptr; c.A = p.ubuf; c.Bt = p.Win;
    const int nr = deal_rounds(1);
    for (int r = 0; r < nr; ++r) {
      int mt, ntl;
      if (!deal_tile(r, 1, mt, ntl)) continue;
      gemm_tile<AL_PLAIN, EP_WIN>(p, c, mt, 32, lds);
    }
  }
}
__device__ __forceinline__ void ph_attn(const P& p, char* lds, unsigned long long* uni) {
  const int G = gridDim.x, bid = blockIdx.x;
  const bool xcd = G == 512;
  const int x = bid & 7, lb = bid >> 3, a = lb >> 1, half = lb & 1;
  int rnd = 0;
  for (int base = 0; base < 2048; base += G, ++rnd) {
    int idx;
    if (xcd) {
      const int bg = x * 2 + (rnd >> 1), b = bg >> 2, g = bg & 3;
      const int qb = (rnd & 1) ? a : 63 - a;
      idx = ((63 - qb) << 5) | (b << 3) | (g << 1) | half;
    } else idx = base + ((rnd & 1) ? (G - 1 - bid) : bid);
    if (idx < 2048) attn_item(p, idx, lds, uni);
    __syncthreads();
  }
}

__global__ void __launch_bounds__(NTHREADS, 2) fwd_kernel(const P p, const PJ pj, unsigned* bar, const int ph_lo, const int ph_hi) {
  __shared__ __attribute__((aligned(16))) char lds[LDS_BYTES];
  __shared__ unsigned long long uni[4];
  const int G = gridDim.x, bid = blockIdx.x;
  PHASE(0, 0, norm_phase<0, 0>(p, pj, false, p.a_norm_g, p.ubuf, nullptr, nullptr, nullptr, lds);)
  PHASE(1, 1, ph_proj(p, 0, lds);)
  PHASE(2, 2, for (int it = bid; it < 512; it += G) scan_item(p, 0, G == 512 ? ((((it & 7) * 16 + (it >> 5)) << 2) | ((it >> 3) & 3)) : it, lds);)
  PHASE(3, 3, postscan_phase(p, 0);)
  PHASE(4, 4, ph_wo(p, 0, p.Wo, lds);)
  PHASE(5, 0, norm_phase<0, 1>(p, pj, true, p.a_norm_g + DM, p.ubuf, nullptr, nullptr, nullptr, lds);)
  PHASE(6, 1, ph_proj(p, 1, lds);)
  PHASE(7, 2, for (int it = bid; it < 512; it += G) scan_item(p, 1, G == 512 ? ((((it & 7) * 16 + (it >> 5)) << 2) | ((it >> 3) & 3)) : it, lds);)
  PHASE(8, 3, postscan_phase(p, 1);)
  PHASE(9, 4, ph_wo(p, 1, p.Wo, lds);)
  PHASE(10, 0, norm_phase<1, 2>(p, pj, true, p.kv_norm_g, p.hn, p.b_norm_g, p.ubuf, nullptr, lds);)
  PHASE(11, 5, ph_kvwin(p, 0, 24, lds);)
  PHASE(12, 6,
    for (int t = bid; t < 256; t += G) {
      if (t >= 128) {
        GemmCtx cg; cg.lda = DM; cg.K = DM; cg.layer = 1; cg.j = 0; cg.aux = nullptr; cg.A = p.ubuf; cg.Bt = p.Win;
        gemm_tile<AL_PLAIN, EP_WIN>(p, cg, t - 128, 32, lds);
        continue;
      }
      const int j = t >> 6, r = t & 63, mt = r >> 1, nt = r & 1;
      GemmCtx c; c.A = p.kc + (size_t)j * (8u << 20); c.lda = 0; c.Bt = p.Wc1 + (size_t)j * 256 * 4096; c.K = 4096; c.layer = 0; c.j = j;
      c.aux = p.cmp_pe + (size_t)j * 32 * 128;
      gemm_tile<AL_CMP, EP_CMP1>(p, c, mt, nt, lds);
    })
  PHASE(13, 7,
    for (int t = bid; t < 64; t += G) {
      const int j = t >> 5, mt = t & 31;
      GemmCtx c; c.A = p.hc + (size_t)j * 4096 * 256; c.lda = 256; c.Bt = p.Wc2 + (size_t)j * 128 * 256; c.K = 256; c.layer = 0; c.j = j; c.aux = nullptr;
      gemm_tile<AL_PLAIN, EP_CMP2>(p, c, mt, 0, lds);
    })
  PHASE(14, 8, for (int t = bid; t < 1024; t += G) cmp_item(p, t, lds);)
  PHASE(15, 9, ph_attn(p, lds, uni);)
  PHASE(16, 4, ph_wo(p, 1, p.Wob, lds);)
  PHASE(17, 0, norm_phase<0, 3>(p, pj, true, p.b_norm_g + DM, p.ubuf, nullptr, nullptr, nullptr, lds);)
  PHASE(18, 5, ph_kvwin(p, 1, 0, lds);)
  PHASE(19, 8, for (int t = bid; t < 1024; t += G) cmp_item(p, t, lds);)
  PHASE(20, 9, ph_attn(p, lds, uni);)
  PHASE(21, 4, ph_wo(p, 1, p.Wob, lds);)
  PHASE(22, 0, norm_phase<2, -1>(p, pj, true, p.final_g, nullptr, nullptr, nullptr, p.out, lds);)
}

static inline size_t MiB(double x) { return (size_t)(x * 1048576.0); }

extern "C" void kernel_launch(void* const* d_in, const int* in_sizes, int n_in, void* d_out, int out_size, void* d_ws, size_t ws_size, hipStream_t stream) {
  (void)in_sizes; (void)n_in; (void)out_size;
  P p; memset(&p, 0, sizeof(P));
  PJ pj; memset(&pj, 0, sizeof(PJ));
  const float* const* in = (const float* const*)d_in;
  p.x = in[0]; p.a_norm_g = in[1]; p.a_mu = in[2];
  const float* a_w_rkvz = in[3];
  p.a_w0 = in[4]; const float* a_w1 = in[5]; const float* a_w2 = in[6];
  p.a_a0 = in[7]; const float* a_a1 = in[8]; const float* a_a2 = in[9];
  p.a_v0 = in[10]; const float* a_v1 = in[11]; const float* a_v2 = in[12];
  p.a_k_k = in[13]; p.a_k_a = in[14]; p.a_r_k = in[15]; p.a_ln_g = in[16]; p.a_ln_b = in[17];
  const float* a_w_o = in[18];
  p.kv_norm_g = in[19]; const float* kv_w = in[20]; p.cmp_pe = in[21]; const float* cmp_w1 = in[22]; const float* cmp_w2 = in[23];
  p.b_norm_g = in[24]; const float* b_w_in = in[25]; p.b_gate_b = in[26]; const float* b_w_o = in[27]; p.final_g = in[28];
  p.out = (float*)d_out;
  if (ws_size < MiB(512)) { fprintf(stderr, "workspace too small: %zu\n", ws_size); return; }
  char* ws = (char*)d_ws;
  p.ysum = (bf16_t*)(ws + MiB(0)); p.ubuf = (bf16_t*)(ws + MiB(64)); p.r = (bf16_t*)(ws + MiB(128)); p.k = (bf16_t*)(ws + MiB(192));
  p.vA = (bf16_t*)(ws + MiB(256)); p.z = (bf16_t*)(ws + MiB(320)); p.vB = (bf16_t*)(ws + MiB(384));
  p.hn = (bf16_t*)(ws + MiB(128)); p.ocmp = p.hn; p.q = (bf16_t*)(ws + MiB(192)); p.sz = (bf16_t*)(ws + MiB(256));
  p.kc = (bf16_t*)(ws + MiB(320)); p.vc = (bf16_t*)(ws + MiB(336)); p.ks = (bf16_t*)(ws + MiB(352)); p.vsT = (bf16_t*)(ws + MiB(368));
  p.kw = (bf16_t*)(ws + MiB(384)); p.vwT = (bf16_t*)(ws + MiB(400));
  p.hc = (bf16_t*)(ws + MiB(416)); p.kcmp = (bf16_t*)(ws + MiB(420)); p.vcmpT = (bf16_t*)(ws + MiB(421));
  p.gates = (float*)(ws + MiB(422)); p.selmask = (unsigned*)(ws + MiB(425));
  char* ar = ws + MiB(448);
  p.Wp = (bf16_t*)ar;
  p.W2w = (bf16_t*)(ar + MiB(33.5)); p.W2a = (bf16_t*)(ar + MiB(34)); p.W2v = (bf16_t*)(ar + MiB(34.5));
  p.Wo = (bf16_t*)(ar + MiB(35));
  p.Wkv = (bf16_t*)ar;
  p.Win = (bf16_t*)(ar + MiB(12));
  p.Wc1 = (bf16_t*)(ar + MiB(28.5));
  p.Wc2 = (bf16_t*)(ar + MiB(32.5));
  p.Wob = (bf16_t*)(ar + MiB(33));
  p.lw = (bf16_t*)(ws + MiB(492)); p.la = (bf16_t*)(ws + MiB(496)); p.lv = (bf16_t*)(ws + MiB(500));
  unsigned* bar = (unsigned*)(ws + MiB(508));
  p.bon = (float*)(ws + MiB(504)); p.ropec = (float*)(ws + MiB(506)); p.ropes = (float*)(ws + MiB(506.5));

  int nj = 0, tile = 0;
  auto add = [&](const float* src, bf16_t* dst, int K, int N, int ld, int Kpad, int Npad) {
    ConvJob& j = pj.jobs[nj++]; j.src = src; j.dst = dst; j.K = K; j.N = N; j.ld = ld; j.Kpad = Kpad; j.Npad = Npad; j.tile0 = tile;
    tile += (Kpad / 64) * (Npad / 64);
  };
  const size_t DD = (size_t)DM * DM;
  for (int L = 0; L < 2; ++L) {
    tile = 0;
    for (int n4 = 0; n4 < 4; ++n4) add(a_w_rkvz + (size_t)(L * 4 + n4) * DD, p.Wp + (size_t)n4 * DD, DM, DM, DM, DM, DM);
    add(a_w1 + (size_t)L * DM * 96, p.Wp + (size_t)8192 * DM, DM, 96, 96, DM, 128);
    add(a_a1 + (size_t)L * DM * 96, p.Wp + (size_t)8320 * DM, DM, 96, 96, DM, 128);
    if (L == 1) add(a_v1, p.Wp + (size_t)8448 * DM, DM, 64, 64, DM, 128);
    add(a_w2 + (size_t)L * 96 * DM, p.W2w, 96, DM, DM, 128, DM);
    add(a_a2 + (size_t)L * 96 * DM, p.W2a, 96, DM, DM, 128, DM);
    if (L == 1) add(a_v2, p.W2v, 64, DM, DM, 128, DM);
    add(a_w_o + (size_t)L * DD, p.Wo, DM, DM, DM, DM, DM);
    pj.stage_tiles[L] = tile;
  }
  tile = 0;
  add(kv_w, p.Wkv, DM, 3072, 3072, DM, 3072);
  for (int j = 0; j < 2; ++j) add(cmp_w1 + (size_t)j * 4096 * 256, p.Wc1 + (size_t)j * 256 * 4096, 4096, 256, 256, 4096, 256);
  for (int j = 0; j < 2; ++j) add(cmp_w2 + (size_t)j * 256 * 128, p.Wc2 + (size_t)j * 128 * 256, 256, 128, 128, 256, 128);
  for (int L = 0; L < 2; ++L) {
    if (L == 1) { pj.stage_tiles[2] = tile; tile = 0; }
    const float* wi = b_w_in + (size_t)L * DM * 4144;
    add(wi, p.Win, DM, 2048, 4144, DM, 2048);
    add(wi + 2096, p.Win + (size_t)2048 * DM, DM, 2048, 4144, DM, 2048);
    add(wi + 2048, p.Win + (size_t)4096 * DM, DM, 48, 4144, DM, 128);
    add(b_w_o + (size_t)L * DD, p.Wob, DM, DM, DM, DM, DM);
  }
  pj.stage_tiles[3] = tile;
  for (int i = 0; i < 16; ++i) pj.rope_inv[i] = (float)pow(500000.0, -(double)i / 16.0);

  static int grid_blocks = 0;
  if (!grid_blocks) {
    int dev = 0, cus = 0, per_cu = 0;
    hipGetDevice(&dev);
    hipDeviceGetAttribute(&cus, hipDeviceAttributeMultiprocessorCount, dev);
    hipOccupancyMaxActiveBlocksPerMultiprocessor(&per_cu, fwd_kernel, NTHREADS, 0);
    if (per_cu > 2) per_cu = 2;
    if (per_cu < 1) per_cu = 1;
    grid_blocks = cus * per_cu;
  }
#if ONE_LAUNCH
  hipMemsetAsync(bar, 0, 64 * 32 * 4, stream);
  int lo = 0, hi = NPHASE;
  void* args[] = {(void*)&p, (void*)&pj, (void*)&bar, (void*)&lo, (void*)&hi};
  hipError_t e = hipLaunchCooperativeKernel((void*)fwd_kernel, dim3(grid_blocks), dim3(NTHREADS), args, 0, stream);
  if (e != hipSuccess) fprintf(stderr, "cooperative launch failed: %s (grid %d)\n", hipGetErrorString(e), grid_blocks);
#else
  for (int ph = 0; ph < NPHASE; ++ph) {
    hipLaunchKernelGGL(fwd_kernel, dim3(grid_blocks), dim3(NTHREADS), 0, stream, p, pj, bar, ph, ph + 1);
  }

#endif
}
```

```cpp
#include <hip/hip_runtime.h>
#include <hip/hip_cooperative_groups.h>
#include <cstdio>
#include <cstdint>
#include <cstring>
#include <cmath>
namespace cg = cooperative_groups;

#ifndef ONE_LAUNCH
#define ONE_LAUNCH 1
#endif

typedef unsigned short bf16_t;
typedef short bf16x8 __attribute__((ext_vector_type(8)));
typedef float f32x4 __attribute__((ext_vector_type(4)));
typedef float f32x16 __attribute__((ext_vector_type(16)));
typedef unsigned u32x4 __attribute__((ext_vector_type(4)));
typedef unsigned u32x2 __attribute__((ext_vector_type(2)));

#define MTOK 16384
#define TSEQ 4096
#define DM 2048
#define NTHREADS 256
#define QSCALE 0.12751743f
#define ATT_KSZ 17408
#define ATT_BUF 35840
#define LDS_BYTES 71680

struct ConvJob { const float* src; bf16_t* dst; int K, N, ld, Kpad, Npad, tile0; };

struct P {
  const float *x, *a_norm_g, *a_mu, *a_w0, *a_a0, *a_v0, *a_k_k, *a_k_a, *a_r_k, *a_ln_g, *a_ln_b;
  const float *kv_norm_g, *cmp_pe, *b_norm_g, *b_gate_b, *final_g;
  float* out;
  bf16_t *ysum, *ubuf, *r, *k, *vA, *z, *vB;
  bf16_t *lw, *la, *lv; float *bon; float *ropec, *ropes;
  bf16_t *Wp, *W2w, *W2a, *W2v, *Wo;
  bf16_t *Wkv, *Win, *Wc1, *Wc2, *Wob;
  bf16_t *hn, *q, *sz, *ocmp;
  bf16_t *kc, *vc, *ks, *vsT, *kw, *vwT, *hc, *kcmp, *vcmpT;
  float *gates; unsigned *selmask;
};
struct PJ {
  ConvJob jobs[33];
  float rope_inv[16];
  int stage_tiles[4];
};

typedef __bf16 bf16x2_t __attribute__((ext_vector_type(2)));
typedef float f32x2 __attribute__((ext_vector_type(2)));
__device__ __forceinline__ unsigned cvtpk(float lo, float hi) {
  f32x2 v = {lo, hi};
  bf16x2_t b = __builtin_convertvector(v, bf16x2_t);
  return __builtin_bit_cast(unsigned, b);
}
__device__ __forceinline__ bf16_t f2bf(float x) { return (bf16_t)(cvtpk(x, x) & 0xffffu); }
__device__ __forceinline__ float bflo(unsigned w) { return __uint_as_float(w << 16); }
__device__ __forceinline__ float bfhi(unsigned w) { return __uint_as_float(w & 0xffff0000u); }
__device__ __forceinline__ float bf2f(bf16_t v) { return __uint_as_float(((unsigned)v) << 16); }
__device__ __forceinline__ void unpack8(bf16x8 v, float* f) {
  u32x4 w = *reinterpret_cast<u32x4*>(&v);
#pragma unroll
  for (int i = 0; i < 4; ++i) { f[2 * i] = bflo(w[i]); f[2 * i + 1] = bfhi(w[i]); }
}
__device__ __forceinline__ bf16x8 pack8f(const float* f) {
  u32x4 w = {cvtpk(f[0], f[1]), cvtpk(f[2], f[3]), cvtpk(f[4], f[5]), cvtpk(f[6], f[7])};
  return *reinterpret_cast<bf16x8*>(&w);
}
__device__ __forceinline__ float sigmoidf_(float x) { return __builtin_amdgcn_rcpf(1.f + __expf(-x)); }
__device__ __forceinline__ float siluf_(float x) { return x * __builtin_amdgcn_rcpf(1.f + __expf(-x)); }
#define DPP(x, ctrl) __int_as_float(__builtin_amdgcn_mov_dpp(__float_as_int(x), ctrl, 0xF, 0xF, true))
__device__ __forceinline__ float sum8(float x) {
  x += DPP(x, 0xB1); x += DPP(x, 0x4E); x += DPP(x, 0x141); return x;
}
__device__ __forceinline__ float wave_sum(float x) {
#pragma unroll
  for (int o = 32; o >= 1; o >>= 1) x += __shfl_xor(x, o);
  return x;
}
__device__ __forceinline__ float swap32_max(float x) {
  auto rr = __builtin_amdgcn_permlane32_swap(__float_as_uint(x), __float_as_uint(x), false, false);
  return fmaxf(__uint_as_float(rr[0]), __uint_as_float(rr[1]));
}
__device__ __forceinline__ float swap32_sum(float x) {
  auto rr = __builtin_amdgcn_permlane32_swap(__float_as_uint(x), __float_as_uint(x), false, false);
  return __uint_as_float(rr[0]) + __uint_as_float(rr[1]);
}
__device__ __forceinline__ int crow(int r, int hi) { return (r & 3) + 8 * (r >> 2) + 4 * hi; }

__device__ __forceinline__ void conv_tile(const ConvJob& jb, int tile, char* lds) {
  float* T = (float*)lds;
  const int nkt = jb.Kpad >> 6;
  const int n0 = (tile / nkt) * 64, k0 = (tile % nkt) * 64;
  const int tx = threadIdx.x & 63, ty = threadIdx.x >> 6;
#pragma unroll 4
  for (int rr = 0; rr < 16; ++rr) {
    int kl = ty * 16 + rr, kk = k0 + kl, n = n0 + tx;
    float v = (kk < jb.K && n < jb.N) ? jb.src[(size_t)kk * jb.ld + n] : 0.f;
    T[kl * 65 + tx] = v;
  }
  __syncthreads();
  const int nl = threadIdx.x >> 2, kc = (threadIdx.x & 3) * 16;
  unsigned w[8];
#pragma unroll
  for (int i = 0; i < 8; ++i) w[i] = cvtpk(T[(kc + 2 * i) * 65 + nl], T[(kc + 2 * i + 1) * 65 + nl]);
  bf16_t* d = jb.dst + (size_t)(n0 + nl) * jb.Kpad + k0 + kc;
  *(u32x4*)d = u32x4{w[0], w[1], w[2], w[3]};
  *(u32x4*)(d + 8) = u32x4{w[4], w[5], w[6], w[7]};
  __syncthreads();
}

template <int MODE>
__device__ __forceinline__ void rmsnorm_row(const P& p, int row, bool has_y, const float* g1, bf16_t* o1, const float* g2, bf16_t* o2, float* of) {
  const int lane = threadIdx.x & 63;
  const float* xr = p.x + (size_t)row * DM;
  const bf16_t* yr = p.ysum + (size_t)row * DM;
  f32x4 v[8]; float ss = 0.f;
#pragma unroll
  for (int i = 0; i < 8; ++i) {
    int c = (lane + 64 * i) * 4;
    v[i] = *(const f32x4*)(xr + c);
    if (has_y) { u32x2 w = *(const u32x2*)(yr + c); v[i][0] += bflo(w[0]); v[i][1] += bfhi(w[0]); v[i][2] += bflo(w[1]); v[i][3] += bfhi(w[1]); }
    ss += v[i][0] * v[i][0] + v[i][1] * v[i][1] + v[i][2] * v[i][2] + v[i][3] * v[i][3];
  }
  ss = wave_sum(ss);
  const float rs = rsqrtf(ss * (1.f / DM) + 1e-6f);
#pragma unroll
  for (int i = 0; i < 8; ++i) {
    int c = (lane + 64 * i) * 4;
    f32x4 g = *(const f32x4*)(g1 + c);
    if (MODE == 2) {
      f32x4 y = {v[i][0] * rs * g[0], v[i][1] * rs * g[1], v[i][2] * rs * g[2], v[i][3] * rs * g[3]};
      *(f32x4*)(of + (size_t)row * DM + c) = y;
    } else {
      u32x2 w = {cvtpk(v[i][0] * rs * g[0], v[i][1] * rs * g[1]), cvtpk(v[i][2] * rs * g[2], v[i][3] * rs * g[3])};
      *(u32x2*)(o1 + (size_t)row * DM + c) = w;
      if (MODE == 1) {
        f32x4 gg = *(const f32x4*)(g2 + c);
        u32x2 w2 = {cvtpk(v[i][0] * rs * gg[0], v[i][1] * rs * gg[1]), cvtpk(v[i][2] * rs * gg[2], v[i][3] * rs * gg[3])};
        *(u32x2*)(o2 + (size_t)row * DM + c) = w2;
      }
    }
  }
}

template <int MODE, int STAGE>
__device__ __forceinline__ void norm_phase(const P& p, const PJ& pj, bool has_y, const float* g1, bf16_t* o1, const float* g2, bf16_t* o2, float* of, char* lds) {
  if constexpr (STAGE >= 0) {
    constexpr int J0 = STAGE == 0 ? 0 : STAGE == 1 ? 9 : STAGE == 2 ? 20 : 29;
    constexpr int J1 = STAGE == 0 ? 9 : STAGE == 1 ? 20 : STAGE == 2 ? 29 : 33;
    const int nt = pj.stage_tiles[STAGE];
    for (int t = blockIdx.x; t < nt; t += gridDim.x) {
      const float* jsrc = pj.jobs[J0].src; bf16_t* jdst = pj.jobs[J0].dst;
      int jK = pj.jobs[J0].K, jN = pj.jobs[J0].N, jld = pj.jobs[J0].ld, jKp = pj.jobs[J0].Kpad, jNp = pj.jobs[J0].Npad, jt0 = pj.jobs[J0].tile0;
#pragma unroll
      for (int j = J0 + 1; j < J1; ++j) {
        const bool cnd = t >= pj.jobs[j].tile0;
        jsrc = cnd ? pj.jobs[j].src : jsrc; jdst = cnd ? pj.jobs[j].dst : jdst;
        jK = cnd ? pj.jobs[j].K : jK; jN = cnd ? pj.jobs[j].N : jN; jld = cnd ? pj.jobs[j].ld : jld;
        jKp = cnd ? pj.jobs[j].Kpad : jKp; jNp = cnd ? pj.jobs[j].Npad : jNp; jt0 = cnd ? pj.jobs[j].tile0 : jt0;
      }
      ConvJob jb; jb.src = jsrc; jb.dst = jdst; jb.K = jK; jb.N = jN; jb.ld = jld; jb.Kpad = jKp; jb.Npad = jNp; jb.tile0 = jt0;
      conv_tile(jb, t - jt0, lds);
    }
    if constexpr (STAGE == 0) {
      for (int pos = blockIdx.x * NTHREADS + threadIdx.x; pos < TSEQ; pos += gridDim.x * NTHREADS) {
#pragma unroll
        for (int i = 0; i < 16; ++i) {
          const float ang = (float)pos * pj.rope_inv[i];
          const double a = (double)ang * 0.15915494309189535;
          const float fr = (float)(a - rint(a));
          p.ropec[pos * 16 + i] = __builtin_amdgcn_cosf(fr); p.ropes[pos * 16 + i] = __builtin_amdgcn_sinf(fr);
        }
      }
    }
  }
  const int gw = blockIdx.x * 4 + (threadIdx.x >> 6), nw = gridDim.x * 4;
  for (int row = gw; row < MTOK; row += nw) rmsnorm_row<MODE>(p, row, has_y, g1, o1, g2, o2, of);
}

enum { AL_PLAIN = 0, AL_MIX = 1, AL_CMP = 2 };
enum { EP_PROJ = 0, EP_RESID = 1, EP_KV = 2, EP_CMP1 = 3, EP_CMP2 = 4, EP_WIN = 5 };

struct GemmCtx {
  const bf16_t* A; int lda;
  const bf16_t* Bt; int K;
  const float* aux;
  int layer, j;
};

template <int NI>
__device__ __forceinline__ void store_rows_lds(bf16_t* base, const size_t ld, const int row0, const int cbase, f32x4 (&acc)[4][NI], char* lds, const bool rmw) {
  constexpr int RB = NI * 32 + 16;
  constexpr int CPR = NI * 2;
  const int lane = threadIdx.x & 63, wid = threadIdx.x >> 6, lr = lane & 15, lq = lane >> 4;
  char* W = lds + wid * (64 * RB);
#pragma unroll
  for (int mi = 0; mi < 4; ++mi)
#pragma unroll
    for (int ni = 0; ni < NI; ++ni)
#pragma unroll
      for (int j = 0; j < 4; ++j) *(bf16_t*)(W + (mi * 16 + lq * 4 + j) * RB + (ni * 16 + lr) * 2) = f2bf(acc[mi][ni][j]);
  __builtin_amdgcn_fence(__ATOMIC_RELEASE, "wavefront");
  __builtin_amdgcn_wave_barrier();
#pragma unroll 4
  for (int i = 0; i < CPR; ++i) {
    const int id = lane + 64 * i, row = id / CPR, cc = id % CPR;
    bf16x8 v = *(const bf16x8*)(W + row * RB + cc * 16);
    bf16_t* g = base + (size_t)(row0 + row) * ld + cbase + cc * 8;
    if (rmw) {
      float fa[8], fb[8]; unpack8(v, fa); unpack8(*(const bf16x8*)g, fb);
#pragma unroll
      for (int e = 0; e < 8; ++e) fa[e] += fb[e];
      v = pack8f(fa);
    }
    *(bf16x8*)g = v;
  }
}

template <int EP, int NI>
__device__ __forceinline__ void gemm_epilogue(const P& p, const GemmCtx& c, const int nt, const int m0, const int wr, const int lq, const int lr, const int cbase, f32x4 (&acc)[4][NI], char* lds) {
  const int rbase = m0 + wr * 64 + lq * 4; const int n0 = nt * 128;
  const int cl = cbase + lr;
  if constexpr (EP == EP_PROJ) {
    if (nt < 64) {
      const int which = nt >> 4;
      const int slab = which < 2 ? which : which == 3 ? 3 : (c.layer == 0 ? 2 : 4);
      bf16_t* dst = p.r + (size_t)slab * (32u << 20);
      store_rows_lds<NI>(dst + (nt & 15) * 128, DM, m0 + wr * 64, cbase, acc, lds, false);
    } else {
      bf16_t* dst = p.lw + (size_t)(nt - 64) * (2u << 20);
#pragma unroll
      for (int mi = 0; mi < 4; ++mi)
#pragma unroll
        for (int ni = 0; ni < NI; ++ni)
#pragma unroll
          for (int j = 0; j < 4; ++j) {
            float v = acc[mi][ni][j];
            if (nt == 64) v = 1.f - 2.f * __builtin_amdgcn_rcpf(1.f + __expf(2.f * v));
            dst[(size_t)(rbase + mi * 16 + j) * 128 + cl + ni * 16] = f2bf(v);
          }
    }
  } else if constexpr (EP == EP_RESID) {
    const bool has_y = c.layer != 0;
    store_rows_lds<NI>(p.ysum + n0, DM, m0 + wr * 64, cbase, acc, lds, has_y);
  } else if constexpr (EP == EP_KV || EP == EP_WIN || EP == EP_CMP2) {
    int kind;
    bool rope = false; float qs = 1.f;
    bf16_t* dst = nullptr; int bgidx = 0;
    if constexpr (EP == EP_KV) {
      const int i = nt >> 2, g = nt & 3; bgidx = g;
      kind = (i == 3 || i == 5) ? 1 : 0; rope = (i == 2 || i == 4);
      dst = p.kc + (size_t)i * (8u << 20);
    } else if constexpr (EP == EP_WIN) {
      kind = nt < 16 ? 0 : nt < 32 ? 2 : 3; rope = nt < 16; qs = nt < 16 ? QSCALE : 1.f;
      dst = p.q + (nt < 16 ? (size_t)0 : (size_t)(32u << 20));
    } else {
      kind = c.j == 0 ? 0 : 1; rope = c.j == 0; dst = p.kcmp + (size_t)c.j * (512u << 10);
    }
    if (rope && cbase == 0) {
#pragma unroll
      for (int mi = 0; mi < 4; ++mi)
#pragma unroll
        for (int j = 0; j < 4; ++j) {
          const int row = rbase + mi * 16 + j;
          int pos;
          if constexpr (EP == EP_CMP2) { pos = 16 * (row & 255) + 31; if (pos > TSEQ - 1) pos = TSEQ - 1; } else pos = row & (TSEQ - 1);
          const float cs = p.ropec[pos * 16 + lr], sn = p.ropes[pos * 16 + lr];
          const float x1 = acc[mi][0][j], x2 = acc[mi][1][j];
          acc[mi][0][j] = x1 * cs - x2 * sn; acc[mi][1][j] = x2 * cs + x1 * sn;
        }
    }
    if (kind == 0 || kind == 2) {
      const bool sil = kind == 2;
#pragma unroll
      for (int mi = 0; mi < 4; ++mi)
#pragma unroll
        for (int ni = 0; ni < NI; ++ni)
#pragma unroll
          for (int j = 0; j < 4; ++j) { const float v = acc[mi][ni][j]; acc[mi][ni][j] = sil ? siluf_(v) : v * qs; }
      bf16_t* base; size_t ld;
      if constexpr (EP == EP_KV) {
        const int i = nt >> 2;
        if (i < 2) { base = dst + bgidx * 128; ld = 512; }
        else { const int b = m0 >> 12; base = dst + (size_t)(3 * b + bgidx) * TSEQ * 128; ld = 128; }
      } else if constexpr (EP == EP_WIN) { base = dst + (nt & 15) * 128; ld = DM; }
      else { base = dst; ld = 128; }
      store_rows_lds<NI>(base, ld, m0 + wr * 64, cbase, acc, lds, false);
    } else if (kind == 1) {
#pragma unroll
      for (int mi = 0; mi < 4; ++mi)
#pragma unroll
        for (int ni = 0; ni < NI; ++ni) {
          const int row0 = m0 + wr * 64 + mi * 16;
          const int d = cl + ni * 16;
          const int slot = (lq & 1) * 8 + (lq >> 1) * 4;
          u32x2 w = {cvtpk(acc[mi][ni][0], acc[mi][ni][1]), cvtpk(acc[mi][ni][2], acc[mi][ni][3])};
          size_t idx;
          if constexpr (EP == EP_KV) { const int b = row0 >> 12, t0 = row0 & (TSEQ - 1); idx = ((size_t)((b * 4 + bgidx) * 128 + d)) * TSEQ + t0 + slot; }
          else { const int bg = row0 >> 8, c0 = row0 & 255; idx = ((size_t)(bg * 128 + d)) * 256 + c0 + slot; }
          *(u32x2*)(dst + idx) = w;
        }
    } else {
      const float* gb = p.b_gate_b + c.j * 48;
#pragma unroll
      for (int mi = 0; mi < 4; ++mi)
#pragma unroll
        for (int ni = 0; ni < NI; ++ni) {
          const int n = cl + ni * 16;
          if (n < 48) {
#pragma unroll
            for (int j = 0; j < 4; ++j) p.gates[(size_t)(rbase + mi * 16 + j) * 48 + n] = sigmoidf_(acc[mi][ni][j] + gb[n]);
          }
        }
    }
  } else if constexpr (EP == EP_CMP1) {
    bf16_t* dst = p.hc + (size_t)c.j * 4096 * 256;
#pragma unroll
    for (int mi = 0; mi < 4; ++mi)
#pragma unroll
      for (int ni = 0; ni < NI; ++ni)
#pragma unroll
        for (int j = 0; j < 4; ++j) dst[(size_t)(rbase + mi * 16 + j) * 256 + n0 + cl + ni * 16] = f2bf(siluf_(acc[mi][ni][j]));
  }
  __syncthreads();
}

template <int AL, int EP>
__device__ __forceinline__ void gemm_tile(const P& p, const GemmCtx& c, const int mt, const int nt, char* lds) {
  const int tid = threadIdx.x, lane = tid & 63, wid = tid >> 6;
  const int wr = wid >> 1, wc = wid & 1, lr = lane & 15, lq = lane >> 4;
  const int m0 = mt * 128, n0 = nt * 128;
  const int K = c.K, nk = K >> 6;
  const int lc = tid & 7, lrow = tid >> 3;
  f32x4 acc[4][4];
#pragma unroll
  for (int i = 0; i < 4; ++i)
#pragma unroll
    for (int j = 0; j < 4; ++j) acc[i][j] = f32x4{0.f, 0.f, 0.f, 0.f};
  bf16x8 ra[4], rp[4], rb[4]; f32x4 ax0, ax1;

  auto load_tile = [&](int kt) {
#pragma unroll
    for (int i = 0; i < 4; ++i) {
      const int row = lrow + 32 * i;
      rb[i] = *(const bf16x8*)(c.Bt + (size_t)(n0 + row) * K + kt * 64 + lc * 8);
      if constexpr (AL == AL_PLAIN) {
        ra[i] = *(const bf16x8*)(c.A + (size_t)(m0 + row) * c.lda + kt * 64 + lc * 8);
      } else if constexpr (AL == AL_MIX) {
        const int m = m0 + row;
        const bf16_t* src = c.A + (size_t)m * DM + kt * 64 + lc * 8;
        ra[i] = *(const bf16x8*)src;
        if ((m & (TSEQ - 1)) != 0) rp[i] = *(const bf16x8*)(src - DM); else rp[i] = bf16x8{0, 0, 0, 0, 0, 0, 0, 0};
      } else {
        const int R = m0 + row, bg = R >> 8, cc = R & 255, b = bg >> 2, g = bg & 3;
        const int l = kt >> 1, d = (kt & 1) * 64 + lc * 8;
        int t = 16 * cc + l; if (t > TSEQ - 1) t = TSEQ - 1;
        ra[i] = *(const bf16x8*)(c.A + ((size_t)(b * TSEQ + t)) * 512 + g * 128 + d);
      }
    }
    if constexpr (AL == AL_MIX) { const float* mu = c.aux + kt * 64 + lc * 8; ax0 = *(const f32x4*)mu; ax1 = *(const f32x4*)(mu + 4); }
    if constexpr (AL == AL_CMP) { const float* pe = c.aux + (kt >> 1) * 128 + (kt & 1) * 64 + lc * 8; ax0 = *(const f32x4*)pe; ax1 = *(const f32x4*)(pe + 4); }
  };
  auto store_tile = [&](int buf) {
    char* Ab = lds + buf * 32768; char* Bb = Ab + 16384;
#pragma unroll
    for (int i = 0; i < 4; ++i) {
      const int row = lrow + 32 * i;
      const int off = row * 128 + ((lc ^ (row & 7)) << 4);
      *(bf16x8*)(Bb + off) = rb[i];
      if constexpr (AL == AL_PLAIN) { *(bf16x8*)(Ab + off) = ra[i]; }
      else {
        float f[8]; unpack8(ra[i], f);
        const float mu[8] = {ax0[0], ax0[1], ax0[2], ax0[3], ax1[0], ax1[1], ax1[2], ax1[3]};
        if constexpr (AL == AL_MIX) {
          float fp[8]; unpack8(rp[i], fp);
#pragma unroll
          for (int e = 0; e < 8; ++e) f[e] = f[e] + (fp[e] - f[e]) * mu[e];
        } else {
#pragma unroll
          for (int e = 0; e < 8; ++e) f[e] = f[e] + mu[e];
        }
        *(bf16x8*)(Ab + off) = pack8f(f);
      }
    }
  };
  auto compute = [&](int buf) {
    const char* Ab = lds + buf * 32768; const char* Bb = Ab + 16384;
#pragma unroll
    for (int ks = 0; ks < 2; ++ks) {
      bf16x8 af[4], bfr[4];
#pragma unroll
      for (int mi = 0; mi < 4; ++mi) { const int row = wr * 64 + mi * 16 + lr; af[mi] = *(const bf16x8*)(Ab + row * 128 + (((ks * 4 + lq) ^ (row & 7)) << 4)); }
#pragma unroll
      for (int ni = 0; ni < 4; ++ni) { const int row = wc * 64 + ni * 16 + lr; bfr[ni] = *(const bf16x8*)(Bb + row * 128 + (((ks * 4 + lq) ^ (row & 7)) << 4)); }
#pragma unroll
      for (int mi = 0; mi < 4; ++mi)
#pragma unroll
        for (int ni = 0; ni < 4; ++ni) acc[mi][ni] = __builtin_amdgcn_mfma_f32_16x16x32_bf16(af[mi], bfr[ni], acc[mi][ni], 0, 0, 0);
    }
  };

  load_tile(0);
  store_tile(0);
  __syncthreads();
  for (int kt = 0; kt < nk; ++kt) {
    if (kt + 1 < nk) load_tile(kt + 1);
    __builtin_amdgcn_sched_barrier(0);
    compute(kt & 1);
    __builtin_amdgcn_sched_barrier(0);
    if (kt + 1 < nk) store_tile((kt + 1) & 1);
    __syncthreads();
  }

  gemm_epilogue<EP, 4>(p, c, nt, m0, wr, lq, lr, wc * 64, acc, lds);
}


template <int AL, int EP>
__device__ __forceinline__ void gemm_wide(const P& p, const GemmCtx& c, const int mt, const int nt2, char* lds) {
  const int tid = threadIdx.x, lane = tid & 63, wid = tid >> 6;
  const int wr = wid >> 1, wc = wid & 1, lr = lane & 15, lq = lane >> 4;
  const int m0 = mt * 128, n0 = nt2 * 256;
  const int K = c.K, nk = K >> 5;
  const bf16_t* A = c.A;
  const bf16_t* Bt = c.Bt;
  const float* mu = c.aux;
  const int lc = tid & 3, lrow = tid >> 2;
  f32x4 acc[4][8];
#pragma unroll
  for (int i = 0; i < 4; ++i)
#pragma unroll
    for (int j = 0; j < 8; ++j) acc[i][j] = f32x4{0.f, 0.f, 0.f, 0.f};
  bf16x8 ra[2], rp[2], rb[4]; f32x4 ax0, ax1;
  auto load_tile = [&](int kt) {
#pragma unroll
    for (int i = 0; i < 4; ++i) rb[i] = *(const bf16x8*)(Bt + (size_t)(n0 + lrow + 64 * i) * K + kt * 32 + lc * 8);
#pragma unroll
    for (int i = 0; i < 2; ++i) {
      const int m = m0 + lrow + 64 * i;
      const bf16_t* src = A + (size_t)m * c.lda + kt * 32 + lc * 8;
      ra[i] = *(const bf16x8*)src;
      if constexpr (AL == AL_MIX) { if ((m & (TSEQ - 1)) != 0) rp[i] = *(const bf16x8*)(src - DM); else rp[i] = bf16x8{0, 0, 0, 0, 0, 0, 0, 0}; }
    }
    if constexpr (AL == AL_MIX) { ax0 = *(const f32x4*)(mu + kt * 32 + lc * 8); ax1 = *(const f32x4*)(mu + kt * 32 + lc * 8 + 4); }
  };
  auto store_tile = [&](int buf) {
    char* Ab = lds + buf * 24576; char* Bb = Ab + 8192;
#pragma unroll
    for (int i = 0; i < 4; ++i) { const int row = lrow + 64 * i; *(bf16x8*)(Bb + row * 64 + ((lc ^ ((-(row >> 2)) & 3)) << 4)) = rb[i]; }
#pragma unroll
    for (int i = 0; i < 2; ++i) {
      const int row = lrow + 64 * i;
      if constexpr (AL == AL_MIX) {
        const float muv[8] = {ax0[0], ax0[1], ax0[2], ax0[3], ax1[0], ax1[1], ax1[2], ax1[3]};
        float f[8], fp[8]; unpack8(ra[i], f); unpack8(rp[i], fp);
#pragma unroll
        for (int e = 0; e < 8; ++e) f[e] = f[e] + (fp[e] - f[e]) * muv[e];
        *(bf16x8*)(Ab + row * 64 + ((lc ^ ((-(row >> 2)) & 3)) << 4)) = pack8f(f);
      } else {
        *(bf16x8*)(Ab + row * 64 + ((lc ^ ((-(row >> 2)) & 3)) << 4)) = ra[i];
      }
    }
  };
  auto compute = [&](int buf) {
    const char* Ab = lds + buf * 24576; const char* Bb = Ab + 8192;
    const int sw = (lq ^ ((-(lr >> 2)) & 3)) << 4;
    bf16x8 af[4];
#pragma unroll
    for (int mi = 0; mi < 4; ++mi) af[mi] = *(const bf16x8*)(Ab + (wr * 64 + mi * 16 + lr) * 64 + sw);
#pragma unroll
    for (int nh = 0; nh < 2; ++nh) {
      bf16x8 bfr[4];
#pragma unroll
      for (int ni = 0; ni < 4; ++ni) bfr[ni] = *(const bf16x8*)(Bb + (wc * 128 + (nh * 4 + ni) * 16 + lr) * 64 + sw);
#pragma unroll
      for (int mi = 0; mi < 4; ++mi)
#pragma unroll
        for (int ni = 0; ni < 4; ++ni) acc[mi][nh * 4 + ni] = __builtin_amdgcn_mfma_f32_16x16x32_bf16(af[mi], bfr[ni], acc[mi][nh * 4 + ni], 0, 0, 0);
    }
  };
  load_tile(0);
  store_tile(0);
  __syncthreads();
  for (int kt = 0; kt < nk; ++kt) {
    if (kt + 1 < nk) load_tile(kt + 1);
    __builtin_amdgcn_sched_barrier(0);
    compute(kt & 1);
    __builtin_amdgcn_sched_barrier(0);
    if (kt + 1 < nk) store_tile((kt + 1) & 1);
    __syncthreads();
  }
  gemm_epilogue<EP, 8>(p, c, 2 * nt2 + wc, m0, wr, lq, lr, 0, acc, lds);
}

__device__ __forceinline__ float sum16(float x) {
  x += DPP(x, 0xB1); x += DPP(x, 0x4E); x += DPP(x, 0x141); x += DPP(x, 0x140); return x;
}
__device__ __forceinline__ void scan_item(const P& p, const int layer, const int item, char* lds) {
  const int quarter = item & 3, h = (item >> 2) & 31, b = item >> 7;
  const int tid = threadIdx.x, lane = tid & 63, wid = tid >> 6;
  float* R = (float*)lds;
  float* W = R + 2048; float* Kk = W + 2048; float* Aa = Kk + 2048; float* Bv = Aa + 2048;
  float* V = Bv + 2048;
  float* Vg = V + 512;
  float* O = Vg + 512;
  float* KKp = O + 528; float* KAp = KKp + 64; float* RKp = KAp + 64;
  float* LBp = RKp + 64;
  const bf16_t* vsrc = p.vA + (size_t)layer * (64u << 20);
  bf16_t* vdst = p.vB;
  const int tl = tid >> 3, c8 = tid & 7;
  const int ch0 = h * 64 + c8 * 8;
  const int vc0 = h * 64 + quarter * 16;
  const int lr = lane & 15, lq = lane >> 4;
  const int ten = wid >> 1, lmi = wid & 1;
  const bf16_t* lA = p.lw + (size_t)ten * (2u << 20);
  const bf16_t* lB = p.W2w + (size_t)ten * (256u << 10);
  if (tid < 64) {
    KKp[tid] = p.a_k_k[layer * DM + h * 64 + tid]; KAp[tid] = p.a_k_a[layer * DM + h * 64 + tid]; RKp[tid] = p.a_r_k[layer * DM + h * 64 + tid];
  }
  if (tid < 128) { const float b0_ = p.a_w0[layer * DM + h * 64 + (tid & 63)], b1_ = p.a_a0[layer * DM + h * 64 + (tid & 63)]; LBp[tid] = tid < 64 ? b0_ : b1_; }
  if (tid >= 128 && tid < 144) LBp[tid] = layer == 1 ? p.a_v0[vc0 + (tid - 128)] : 0.f;
  const int row = tid >> 4, kq = tid & 15;
  f32x2 S01 = {0.f, 0.f}, S23 = {0.f, 0.f};

  const size_t tok0 = (size_t)b * TSEQ;
  bf16x8 rr, rk, rv, rvf;
  bf16x8 wB[3][4], wBv[2], fA[3], fAv[2];
#pragma unroll
  for (int ks = 0; ks < 3; ++ks)
#pragma unroll
    for (int ni = 0; ni < 4; ++ni) wB[ks][ni] = *(const bf16x8*)(lB + (size_t)(h * 64 + ni * 16 + lr) * 128 + ks * 32 + lq * 8);
  if (layer == 1) {
#pragma unroll
    for (int ks = 0; ks < 2; ++ks) wBv[ks] = *(const bf16x8*)(p.W2v + (size_t)(vc0 + lr) * 128 + ks * 32 + lq * 8);
  }
  auto load_raw = [&](int c) {
    const size_t m = tok0 + c * 32 + tl;
    {
      const size_t ml = tok0 + c * 32 + lmi * 16 + lr;
#pragma unroll
      for (int ks = 0; ks < 3; ++ks) fA[ks] = *(const bf16x8*)(lA + ml * 128 + ks * 32 + lq * 8);
      if (layer == 1) {
#pragma unroll
        for (int ks = 0; ks < 2; ++ks) fAv[ks] = *(const bf16x8*)(p.lv + ml * 128 + ks * 32 + lq * 8);
      }
    }
    rr = *(const bf16x8*)(p.r + m * DM + ch0);
    rk = *(const bf16x8*)(p.k + m * DM + ch0);
    if (c8 < 2) {
      rv = *(const bf16x8*)(vsrc + m * DM + vc0 + c8 * 8);
      if (layer == 1) rvf = *(const bf16x8*)(p.vA + m * DM + vc0 + c8 * 8);
    }
  };
  load_raw(0);
  __syncthreads();
  for (int c = 0; c < TSEQ / 32; ++c) {
    const size_t mc = tok0 + c * 32;
    {
      f32x4 acc[4];
#pragma unroll
      for (int ni = 0; ni < 4; ++ni) acc[ni] = f32x4{0.f, 0.f, 0.f, 0.f};
#pragma unroll
      for (int ks = 0; ks < 3; ++ks) {
#pragma unroll
        for (int ni = 0; ni < 4; ++ni) acc[ni] = __builtin_amdgcn_mfma_f32_16x16x32_bf16(fA[ks], wB[ks][ni], acc[ni], 0, 0, 0);
      }
      float* dstL = ten == 0 ? W : Bv;
#pragma unroll
      for (int ni = 0; ni < 4; ++ni)
#pragma unroll
        for (int j = 0; j < 4; ++j) {
          float sg = sigmoidf_(acc[ni][j] + LBp[ten * 64 + ni * 16 + lr]);
          float val = ten == 0 ? __expf(-0.6065306597126334f * sg) : sg;
          dstL[(lmi * 16 + lq * 4 + j) * 64 + ni * 16 + lr] = val;
        }
      if (layer == 1 && wid < 2) {
        f32x4 av = f32x4{0.f, 0.f, 0.f, 0.f};
#pragma unroll
        for (int ks = 0; ks < 2; ++ks) av = __builtin_amdgcn_mfma_f32_16x16x32_bf16(fAv[ks], wBv[ks], av, 0, 0, 0);
#pragma unroll
        for (int j = 0; j < 4; ++j) Vg[(wid * 16 + lq * 4 + j) * 16 + lr] = sigmoidf_(av[j] + LBp[128 + lr]);
      }
    }
    if (c > 0) {
      const float o0 = O[(c8 * 2) * 33 + tl], o1 = O[(c8 * 2 + 1) * 33 + tl];
      *(unsigned*)(p.ubuf + (mc - 32 + tl) * DM + vc0 + c8 * 2) = cvtpk(o0, o1);
    }
    __syncthreads();
    {
      float fr[8], fk[8], fa[8];
      unpack8(rr, fr); unpack8(rk, fk);
      { f32x4 a0 = *(const f32x4*)(Bv + tl * 64 + c8 * 8), a1 = *(const f32x4*)(Bv + tl * 64 + c8 * 8 + 4);
        fa[0] = a0[0]; fa[1] = a0[1]; fa[2] = a0[2]; fa[3] = a0[3]; fa[4] = a1[0]; fa[5] = a1[1]; fa[6] = a1[2]; fa[7] = a1[3]; }
      float kk[8], ss = 0.f, bsum = 0.f;
      float kkv[8], kav[8], rkv[8];
      { f32x4 t0 = *(const f32x4*)(KKp + c8 * 8), t1 = *(const f32x4*)(KKp + c8 * 8 + 4);
        kkv[0] = t0[0]; kkv[1] = t0[1]; kkv[2] = t0[2]; kkv[3] = t0[3]; kkv[4] = t1[0]; kkv[5] = t1[1]; kkv[6] = t1[2]; kkv[7] = t1[3];
        t0 = *(const f32x4*)(KAp + c8 * 8); t1 = *(const f32x4*)(KAp + c8 * 8 + 4);
        kav[0] = t0[0]; kav[1] = t0[1]; kav[2] = t0[2]; kav[3] = t0[3]; kav[4] = t1[0]; kav[5] = t1[1]; kav[6] = t1[2]; kav[7] = t1[3];
        t0 = *(const f32x4*)(RKp + c8 * 8); t1 = *(const f32x4*)(RKp + c8 * 8 + 4);
        rkv[0] = t0[0]; rkv[1] = t0[1]; rkv[2] = t0[2]; rkv[3] = t0[3]; rkv[4] = t1[0]; rkv[5] = t1[1]; rkv[6] = t1[2]; rkv[7] = t1[3]; }
#pragma unroll
      for (int e = 0; e < 8; ++e) { kk[e] = fk[e] * kkv[e]; ss += kk[e] * kk[e]; }
      ss = sum8(ss);
      const float inv = __builtin_amdgcn_rsqf(fmaxf(ss, 1e-24f));
      float kp[8], na[8], bb[8];
#pragma unroll
      for (int e = 0; e < 8; ++e) {
        kk[e] *= inv;
        kp[e] = fk[e] * (1.f + (fa[e] - 1.f) * kav[e]);
        na[e] = -kk[e]; bb[e] = kk[e] * fa[e];
        bsum += fr[e] * kp[e] * rkv[e];
      }
      bsum = sum8(bsum);
      float* d;
      d = R + tl * 64 + c8 * 8;  *(f32x4*)d = f32x4{fr[0], fr[1], fr[2], fr[3]}; *(f32x4*)(d + 4) = f32x4{fr[4], fr[5], fr[6], fr[7]};
      d = Kk + tl * 64 + c8 * 8; *(f32x4*)d = f32x4{kp[0], kp[1], kp[2], kp[3]}; *(f32x4*)(d + 4) = f32x4{kp[4], kp[5], kp[6], kp[7]};
      d = Aa + tl * 64 + c8 * 8; *(f32x4*)d = f32x4{na[0], na[1], na[2], na[3]}; *(f32x4*)(d + 4) = f32x4{na[4], na[5], na[6], na[7]};
      d = Bv + tl * 64 + c8 * 8; *(f32x4*)d = f32x4{bb[0], bb[1], bb[2], bb[3]}; *(f32x4*)(d + 4) = f32x4{bb[4], bb[5], bb[6], bb[7]};
      if (quarter == 0 && c8 == 0) p.bon[(mc + tl) * 32 + h] = bsum;
      if (c8 < 2) {
        float fv[8]; unpack8(rv, fv);
        if (layer == 1) {
          float ff[8]; unpack8(rvf, ff);
          f32x4 g0 = *(const f32x4*)(Vg + tl * 16 + c8 * 8), g1 = *(const f32x4*)(Vg + tl * 16 + c8 * 8 + 4);
          const float gg[8] = {g0[0], g0[1], g0[2], g0[3], g1[0], g1[1], g1[2], g1[3]};
#pragma unroll
          for (int e = 0; e < 8; ++e) fv[e] = fv[e] + (ff[e] - fv[e]) * gg[e];
          *(bf16x8*)(vdst + (mc + tl) * DM + vc0 + c8 * 8) = pack8f(fv);
        }
        d = V + tl * 16 + c8 * 8; *(f32x4*)d = f32x4{fv[0], fv[1], fv[2], fv[3]}; *(f32x4*)(d + 4) = f32x4{fv[4], fv[5], fv[6], fv[7]};
      }
    }
    __syncthreads();
    if (c + 1 < TSEQ / 32) load_raw(c + 1);
    {
      f32x4 xa, xw, xk, xb, xr, na_, nw_, nk_, nb_, nr_; float xv, nv;
      const float* bA = Aa + kq * 4; const float* bW = W + kq * 4; const float* bK = Kk + kq * 4; const float* bB = Bv + kq * 4; const float* bR = R + kq * 4;
      xa = *(const f32x4*)bA; xw = *(const f32x4*)bW; xk = *(const f32x4*)bK; xb = *(const f32x4*)bB; xr = *(const f32x4*)bR; xv = V[row];
      float opend = 0.f;
#pragma unroll 8
      for (int t = 0; t < 32; ++t) {
        const f32x2 xa01 = {xa[0], xa[1]}, xa23 = {xa[2], xa[3]};
        f32x2 pa = S01 * xa01; pa = __builtin_elementwise_fma(S23, xa23, pa);
        float ra_ = pa[0] + pa[1];
        __builtin_amdgcn_sched_barrier(0);
        {
          const int o_ = ((t + 1) & 31) * 64;
          na_ = *(const f32x4*)(bA + o_); nw_ = *(const f32x4*)(bW + o_); nk_ = *(const f32x4*)(bK + o_); nb_ = *(const f32x4*)(bB + o_); nr_ = *(const f32x4*)(bR + o_);
          nv = V[((t + 1) & 31) * 16 + row];
        }
        float ro_ = opend;
        ra_ += DPP(ra_, 0xB1); ro_ += DPP(ro_, 0xB1);
        ra_ += DPP(ra_, 0x4E); ro_ += DPP(ro_, 0x4E);
        ra_ += DPP(ra_, 0x141); ro_ += DPP(ro_, 0x141);
        ra_ += DPP(ra_, 0x140); ro_ += DPP(ro_, 0x140);
        O[row * 33 + ((t - 1) & 31)] = ro_;
        const f32x2 sa2 = {ra_, ra_}, xv2 = {xv, xv};
        const f32x2 xk01 = {xk[0], xk[1]}, xk23 = {xk[2], xk[3]}, xb01 = {xb[0], xb[1]}, xb23 = {xb[2], xb[3]};
        const f32x2 xw01 = {xw[0], xw[1]}, xw23 = {xw[2], xw[3]}, xr01 = {xr[0], xr[1]}, xr23 = {xr[2], xr[3]};
        S01 = __builtin_elementwise_fma(S01, xw01, __builtin_elementwise_fma(sa2, xb01, xv2 * xk01));
        S23 = __builtin_elementwise_fma(S23, xw23, __builtin_elementwise_fma(sa2, xb23, xv2 * xk23));
        f32x2 po = S01 * xr01; po = __builtin_elementwise_fma(S23, xr23, po);
        opend = po[0] + po[1];
        xa = na_; xw = nw_; xk = nk_; xb = nb_; xr = nr_; xv = nv;
      }
      { const float ro_ = sum16(opend); O[row * 33 + 31] = ro_; }
    }
    __syncthreads();
  }
  {
    const size_t mp = tok0 + (TSEQ - 32);
    const float o0 = O[(c8 * 2) * 33 + tl], o1 = O[(c8 * 2 + 1) * 33 + tl];
    *(unsigned*)(p.ubuf + (mp + tl) * DM + vc0 + c8 * 2) = cvtpk(o0, o1);
  }
  __syncthreads();
}

__device__ __forceinline__ void postscan_phase(const P& p, const int layer) {
  const int tid = threadIdx.x, head = tid >> 3, ch = tid * 8;
  const bf16_t* vsrc = p.vA + (size_t)layer * (64u << 20);
  float lg[8], lb[8];
  {
    const float* pg = p.a_ln_g + layer * DM + ch; const float* pb = p.a_ln_b + layer * DM + ch;
#pragma unroll
    for (int e = 0; e < 8; ++e) { lg[e] = pg[e]; lb[e] = pb[e]; }
  }
  for (int m0 = blockIdx.x; m0 < MTOK; m0 += 4 * gridDim.x) {
    bf16x8 ro[4], rv[4], rz[4]; float bn[4];
#pragma unroll
    for (int u = 0; u < 4; ++u) {
      const int m = m0 + u * gridDim.x;
      if (m < MTOK) {
        ro[u] = *(const bf16x8*)(p.ubuf + (size_t)m * DM + ch);
        rv[u] = *(const bf16x8*)(vsrc + (size_t)m * DM + ch);
        rz[u] = *(const bf16x8*)(p.z + (size_t)m * DM + ch);
        bn[u] = p.bon[(size_t)m * 32 + head];
      }
    }
#pragma unroll
    for (int u = 0; u < 4; ++u) {
      const int m = m0 + u * gridDim.x;
      if (m < MTOK) {
        float fo[8], fv[8], fz[8];
        unpack8(ro[u], fo); unpack8(rv[u], fv); unpack8(rz[u], fz);
        float sm = 0.f;
#pragma unroll
        for (int e = 0; e < 8; ++e) sm += fo[e];
        const float mean = sum8(sm) * (1.f / 64.f);
        float sv = 0.f;
#pragma unroll
        for (int e = 0; e < 8; ++e) { fo[e] -= mean; sv += fo[e] * fo[e]; }
        const float rstd = rsqrtf(sum8(sv) * (1.f / 64.f) + 64e-5f);
#pragma unroll
        for (int e = 0; e < 8; ++e) fo[e] = (fo[e] * rstd * lg[e] + lb[e] + bn[u] * fv[e]) * siluf_(fz[e]);
        *(bf16x8*)(p.ubuf + (size_t)m * DM + ch) = pack8f(fo);
      }
    }
  }
}

__device__ __forceinline__ void cmp_item(const P& p, const int item, char* lds) {
  const int qb = (item & 512) ? 63 - (item & 63) : (item & 63), g = (item >> 6) & 3, b = item >> 8;
  const int bg = b * 4 + g;
  const int tid = threadIdx.x, lane = tid & 63, w = tid >> 6;
  const int n = lane & 31, hi = lane >> 5;
  float* impM = (float*)lds;
  float* impS = impM + 64 * 68;
  for (int e = lane; e < 16 * 68; e += 64) { impM[w * 16 * 68 + e] = 0.f; impS[w * 16 * 68 + e] = 0.f; }
  const int ql = 16 * w + (n & 15);
  const int tq = qb * 64 + ql;
  const size_t m = (size_t)b * TSEQ + tq;
  const int cmaxq = (tq - 31) >> 4;
  const int nkt = (4 * qb + 3 + 31) >> 5;
  const bf16_t* Kc = p.kcmp + (size_t)bg * 256 * 128;
  const bf16_t* Vc = p.vcmpT + (size_t)bg * 128 * 256;
  const float NEG = -__builtin_inff();
#pragma unroll 1
  for (int ct = 0; ct < 2; ++ct) {
    const int head = g * 4 + 2 * ct + (n >> 4);
    bf16x8 qf[8];
#pragma unroll
    for (int d0 = 0; d0 < 8; ++d0) qf[d0] = *(const bf16x8*)(p.q + m * DM + head * 128 + d0 * 16 + hi * 8);
    float mx = -1e30f, l = 0.f;
#pragma unroll 1
    for (int kt = 0; kt < nkt; ++kt) {
      f32x16 sc; for (int r = 0; r < 16; ++r) sc[r] = 0.f;
#pragma unroll
      for (int d0 = 0; d0 < 8; ++d0) {
        bf16x8 kf = *(const bf16x8*)(Kc + (size_t)(kt * 32 + n) * 128 + d0 * 16 + hi * 8);
        sc = __builtin_amdgcn_mfma_f32_32x32x16_bf16(kf, qf[d0], sc, 0, 0, 0);
      }
      float tm = NEG;
#pragma unroll
      for (int r = 0; r < 16; ++r) { const int cc = kt * 32 + crow(r, hi); if (cc > cmaxq) sc[r] = NEG; tm = fmaxf(tm, sc[r]); }
      tm = swap32_max(tm);
      const float mn = fmaxf(mx, tm);
      float ps = 0.f;
#pragma unroll
      for (int r = 0; r < 16; ++r) ps += __builtin_amdgcn_exp2f(sc[r] - mn);
      ps = swap32_sum(ps);
      l = l * __builtin_amdgcn_exp2f(mx - mn) + ps; mx = mn;
    }
    const float inv_l = l > 0.f ? 1.f / l : 0.f;
    f32x16 o[4];
#pragma unroll
    for (int dt = 0; dt < 4; ++dt) for (int r = 0; r < 16; ++r) o[dt][r] = 0.f;
#pragma unroll 1
    for (int kt = 0; kt < nkt; ++kt) {
      f32x16 sc; for (int r = 0; r < 16; ++r) sc[r] = 0.f;
#pragma unroll
      for (int d0 = 0; d0 < 8; ++d0) {
        bf16x8 kf = *(const bf16x8*)(Kc + (size_t)(kt * 32 + n) * 128 + d0 * 16 + hi * 8);
        sc = __builtin_amdgcn_mfma_f32_32x32x16_bf16(kf, qf[d0], sc, 0, 0, 0);
      }
      float pr[16];
#pragma unroll
      for (int r = 0; r < 16; ++r) { const int cc = kt * 32 + crow(r, hi); pr[r] = (cc > cmaxq) ? 0.f : __builtin_amdgcn_exp2f(sc[r] - mx) * inv_l; }
#pragma unroll
      for (int a = 0; a < 4; ++a) {
        float mainv = pr[4 * a] + pr[4 * a + 1] + pr[4 * a + 2] + 0.5f * pr[4 * a + 3];
        float spill = 0.5f * pr[4 * a + 3];
        mainv += __shfl_xor(mainv, 16); spill += __shfl_xor(spill, 16);
        if ((n & 16) == 0) {
          const int jj = 8 * kt + 2 * a + hi;
          impM[ql * 68 + jj] += mainv; impS[ql * 68 + jj + 1] += spill;
        }
      }
      const float pf0[8] = {pr[0], pr[1], pr[2], pr[3], pr[4], pr[5], pr[6], pr[7]};
      const float pf1[8] = {pr[8], pr[9], pr[10], pr[11], pr[12], pr[13], pr[14], pr[15]};
      const bf16x8 pb0 = pack8f(pf0), pb1 = pack8f(pf1);
#pragma unroll
      for (int dt = 0; dt < 4; ++dt) {
        const bf16_t* vp = Vc + (size_t)(dt * 32 + n) * 256 + kt * 32 + hi * 8;
        bf16x8 v0 = *(const bf16x8*)vp, v1 = *(const bf16x8*)(vp + 16);
        o[dt] = __builtin_amdgcn_mfma_f32_32x32x16_bf16(v0, pb0, o[dt], 0, 0, 0);
        o[dt] = __builtin_amdgcn_mfma_f32_32x32x16_bf16(v1, pb1, o[dt], 0, 0, 0);
      }
    }
    const float gt = p.gates[m * 48 + head * 3 + 0];
#pragma unroll
    for (int dt = 0; dt < 4; ++dt)
#pragma unroll
      for (int a = 0; a < 4; ++a) {
        u32x2 wv = {cvtpk(o[dt][4 * a] * gt, o[dt][4 * a + 1] * gt), cvtpk(o[dt][4 * a + 2] * gt, o[dt][4 * a + 3] * gt)};
        *(u32x2*)(p.ocmp + m * DM + head * 128 + dt * 32 + 8 * a + 4 * hi) = wv;
      }
  }
  __syncthreads();
  {
    const int qq = 16 * w + (lane >> 2), part = lane & 3;
    const int cur = qb;
    unsigned lo, hi32;
    if (cur < 16) { lo = (2u << cur) - 1u; hi32 = 0u; }
    else {
      float* rowp = impM + qq * 68; const float* rows = impS + qq * 68;
      for (int e = 0; e < 16; ++e) { const int j = part * 16 + e; rowp[j] = rowp[j] + rows[j]; }
      __builtin_amdgcn_fence(__ATOMIC_RELEASE, "wavefront");
      __builtin_amdgcn_wave_barrier();
      float vj[16]; int rank[16];
#pragma unroll
      for (int e = 0; e < 16; ++e) { vj[e] = rowp[part * 16 + e]; rank[e] = 0; }
      for (int j2 = 1; j2 <= cur - 2; ++j2) {
        const float v2 = rowp[j2];
#pragma unroll
        for (int e = 0; e < 16; ++e) { const int j = part * 16 + e; rank[e] += (v2 > vj[e] || (v2 == vj[e] && j2 < j)) ? 1 : 0; }
      }
      unsigned bits = 0;
#pragma unroll
      for (int e = 0; e < 16; ++e) { const int j = part * 16 + e; if (j >= 1 && j <= cur - 2 && rank[e] < 13) bits |= 1u << e; }
      const int base = lane & ~3;
      const unsigned b0 = __shfl(bits, base), b1 = __shfl(bits, base + 1), b2 = __shfl(bits, base + 2), b3 = __shfl(bits, base + 3);
      lo = b0 | (b1 << 16); hi32 = b2 | (b3 << 16);
      lo |= 1u;
      { const int j = cur - 1; if (j < 32) lo |= 1u << j; else hi32 |= 1u << (j - 32); }
      { const int j = cur; if (j < 32) lo |= 1u << j; else hi32 |= 1u << (j - 32); }
    }
    if (part == 0) {
      unsigned* sp = p.selmask + ((size_t)bg * TSEQ + qb * 64 + qq) * 2;
      sp[0] = lo; sp[1] = hi32;
    }
  }
  __syncthreads();
}

template <int BR>
__device__ __forceinline__ void attn_pass(const P& p, const int b, const int g, const int qb, const int head, const int tq, const bf16x8* qf,
                                          unsigned long long tiles, const unsigned long long mysel, char* lds) {
  const int tid = threadIdx.x, lane = tid & 63;
  const int kl = lane & 31, hi = lane >> 5;
  const int bg = b * 4 + g;
  const bf16_t* Kg = (BR == 0 ? p.kw : p.ks) + (size_t)bg * TSEQ * 128;
  const bf16_t* Vg = (BR == 0 ? p.vwT : p.vsT) + (size_t)bg * 128 * TSEQ;
  const unsigned Wlim = BR == 0 ? 512u : 0x80000000u;
  const float NEG = -__builtin_inff();
  f32x16 o[4];
#pragma unroll
  for (int dt = 0; dt < 4; ++dt) for (int r = 0; r < 16; ++r) o[dt][r] = 0.f;
  float mx = -1e30f, l = 0.f;
  bf16x8 sk[4], sv[4];
  auto load_tile = [&](int j) {
#pragma unroll
    for (int i = 0; i < 4; ++i) {
      const int id = tid + 256 * i;
      sk[i] = *(const bf16x8*)(Kg + (size_t)(j * 64 + (id >> 4)) * 128 + (id & 15) * 8);
      sv[i] = *(const bf16x8*)(Vg + (size_t)(id >> 3) * TSEQ + j * 64 + (id & 7) * 8);
    }
  };
  auto store_tile = [&](int buf) {
    char* Kb = lds + buf * ATT_BUF; char* Vb = Kb + ATT_KSZ;
#pragma unroll
    for (int i = 0; i < 4; ++i) {
      const int id = tid + 256 * i;
      { const int row = id >> 4, c16 = id & 15; *(bf16x8*)(Kb + row * 272 + (c16 << 4)) = sk[i]; }
      { const int d = id >> 3, cx = id & 7; *(bf16x8*)(Vb + d * 144 + (cx << 4)) = sv[i]; }
    }
  };
  int j = __builtin_ctzll(tiles); tiles &= tiles - 1;
  load_tile(j);
  store_tile(0);
  __syncthreads();
  int buf = 0;
  while (true) {
    const bool more = tiles != 0ull;
    int jn = 0;
    if (more) { jn = __builtin_ctzll(tiles); tiles &= tiles - 1; load_tile(jn); }
    {
      const char* Kb = lds + buf * ATT_BUF + kl * 272 + hi * 16; const char* Vb = lds + buf * ATT_BUF + ATT_KSZ + kl * 144 + hi * 16;
      const bool lane_ok = BR == 0 ? true : ((mysel >> j) & 1ull) != 0ull;
      const bool wave_any = __any(lane_ok);
      const bool boundary = BR == 0 ? (j == qb || j + 8 == qb) : (j == qb);
      if (wave_any) {
#pragma unroll
        for (int hs = 0; hs < 2; ++hs) {
          f32x16 sc; for (int r = 0; r < 16; ++r) sc[r] = 0.f;
#pragma unroll
          for (int d0 = 0; d0 < 8; ++d0) {
            bf16x8 kf = *(const bf16x8*)(Kb + hs * 32 * 272 + d0 * 32);
            sc = __builtin_amdgcn_mfma_f32_32x32x16_bf16(kf, qf[d0], sc, 0, 0, 0);
          }
          if (boundary) {
            const int dq = tq - (j * 64 + hs * 32 + 4 * hi);
#pragma unroll
            for (int r = 0; r < 16; ++r) { const int cidx = (r & 3) + 8 * (r >> 2); if ((unsigned)(dq - cidx) >= Wlim) sc[r] = NEG; }
          }
          if (BR == 1) {
#pragma unroll
            for (int r = 0; r < 16; ++r) sc[r] = lane_ok ? sc[r] : NEG;
          }
          float tm = sc[0];
#pragma unroll
          for (int r = 1; r < 16; ++r) tm = fmaxf(tm, sc[r]);
          tm = swap32_max(tm);
          if (!__all(tm <= mx + 8.f)) {
            const float mn = fmaxf(mx, tm);
            const float alpha = __builtin_amdgcn_exp2f(mx - mn);
            l *= alpha; mx = mn;
#pragma unroll
            for (int dt = 0; dt < 4; ++dt)
#pragma unroll
              for (int r = 0; r < 16; ++r) o[dt][r] *= alpha;
          }
          float pr[16]; float ps = 0.f;
#pragma unroll
          for (int r = 0; r < 16; ++r) { pr[r] = __builtin_amdgcn_exp2f(sc[r] - mx); ps += pr[r]; }
          ps = swap32_sum(ps);
          l += ps;
          const float pf0[8] = {pr[0], pr[1], pr[2], pr[3], pr[4], pr[5], pr[6], pr[7]};
          const float pf1[8] = {pr[8], pr[9], pr[10], pr[11], pr[12], pr[13], pr[14], pr[15]};
          const bf16x8 pb0 = pack8f(pf0), pb1 = pack8f(pf1);
#pragma unroll
          for (int dt = 0; dt < 4; ++dt) {
            bf16x8 v0 = *(const bf16x8*)(Vb + dt * 32 * 144 + hs * 64);
            bf16x8 v1 = *(const bf16x8*)(Vb + dt * 32 * 144 + hs * 64 + 32);
            o[dt] = __builtin_amdgcn_mfma_f32_32x32x16_bf16(v0, pb0, o[dt], 0, 0, 0);
            o[dt] = __builtin_amdgcn_mfma_f32_32x32x16_bf16(v1, pb1, o[dt], 0, 0, 0);
          }
        }
      }
    }
    if (more) store_tile(buf ^ 1);
    __syncthreads();
    if (!more) break;
    j = jn; buf ^= 1;
  }
  const size_t m = (size_t)b * TSEQ + tq;
  const float gt = p.gates[m * 48 + head * 3 + (BR == 0 ? 2 : 1)];
  const float sc_ = gt / l;
  if (BR == 0) {
#pragma unroll
    for (int dt = 0; dt < 4; ++dt)
#pragma unroll
      for (int a = 0; a < 4; ++a) {
        const size_t idx = m * DM + head * 128 + dt * 32 + 8 * a + 4 * hi;
        *(u32x2*)(p.ubuf + idx) = u32x2{cvtpk(o[dt][4 * a] * sc_, o[dt][4 * a + 1] * sc_), cvtpk(o[dt][4 * a + 2] * sc_, o[dt][4 * a + 3] * sc_)};
      }
  } else {
#pragma unroll
    for (int dt = 0; dt < 4; ++dt)
#pragma unroll
      for (int a = 0; a < 4; ++a) {
        const size_t idx = m * DM + head * 128 + dt * 32 + 8 * a + 4 * hi;
        const u32x2 oc = *(const u32x2*)(p.ocmp + idx);
        const u32x2 zz = *(const u32x2*)(p.sz + idx);
        const u32x2 ww = *(const u32x2*)(p.ubuf + idx);
        const float y0 = (o[dt][4 * a] * sc_ + bflo(ww[0]) + bflo(oc[0])) * bflo(zz[0]);
        const float y1 = (o[dt][4 * a + 1] * sc_ + bfhi(ww[0]) + bfhi(oc[0])) * bfhi(zz[0]);
        const float y2 = (o[dt][4 * a + 2] * sc_ + bflo(ww[1]) + bflo(oc[1])) * bflo(zz[1]);
        const float y3 = (o[dt][4 * a + 3] * sc_ + bfhi(ww[1]) + bfhi(oc[1])) * bfhi(zz[1]);
        *(u32x2*)(p.ubuf + idx) = u32x2{cvtpk(y0, y1), cvtpk(y2, y3)};
      }
  }
}

__device__ __forceinline__ void attn_item(const P& p, const int item, char* lds, unsigned long long* uni) {
  const int half = item & 1, g = (item >> 1) & 3, b = (item >> 3) & 3, qb = 63 - (item >> 5);
  const int tid = threadIdx.x, lane = tid & 63, w = tid >> 6;
  const int kl = lane & 31, hi = lane >> 5;
  const int head = g * 4 + half * 2 + (w >> 1);
  const int tq = qb * 64 + (w & 1) * 32 + kl;
  const size_t m = (size_t)b * TSEQ + tq;
  bf16x8 qf[8];
#pragma unroll
  for (int d0 = 0; d0 < 8; ++d0) qf[d0] = *(const bf16x8*)(p.q + m * DM + head * 128 + d0 * 16 + hi * 8);
  const unsigned* sp = p.selmask + ((size_t)(b * 4 + g) * TSEQ + tq) * 2;
  const unsigned long long mysel = (unsigned long long)sp[0] | ((unsigned long long)sp[1] << 32);
  unsigned long long u = mysel;
#pragma unroll
  for (int o = 16; o >= 1; o >>= 1) { u |= (unsigned long long)__shfl_xor((unsigned)u, o) | ((unsigned long long)__shfl_xor((unsigned)(u >> 32), o) << 32); }
  if (lane == 0) uni[w] = u;
  __syncthreads();
  const unsigned long long U = (uni[0] | uni[1] | uni[2] | uni[3]) & (qb == 63 ? ~0ull : ((2ull << qb) - 1ull));
  const int jlo = qb >= 8 ? qb - 8 : 0;
  const unsigned long long wt = (qb == 63 ? ~0ull : ((2ull << qb) - 1ull)) & ~((1ull << jlo) - 1ull);
  attn_pass<0>(p, b, g, qb, head, tq, qf, wt, mysel, lds);
  attn_pass<1>(p, b, g, qb, head, tq, qf, U, mysel, lds);
}

typedef __attribute__((address_space(1))) unsigned gunsigned;
__device__ __forceinline__ unsigned gb_ld(unsigned* p) { return __hip_atomic_load((gunsigned*)p, __ATOMIC_RELAXED, __HIP_MEMORY_SCOPE_AGENT); }
__device__ __forceinline__ unsigned gb_add(unsigned* p, unsigned v) { return __hip_atomic_fetch_add((gunsigned*)p, v, __ATOMIC_RELAXED, __HIP_MEMORY_SCOPE_AGENT); }
__device__ __forceinline__ void grid_barrier(unsigned* bar, const unsigned e) {
  __builtin_amdgcn_fence(__ATOMIC_RELEASE, "workgroup");
  __builtin_amdgcn_s_waitcnt(0);
  __syncthreads();
  if (threadIdx.x == 0) {
    const unsigned G = gridDim.x, g = blockIdx.x & 7u;
    const unsigned ngrp = G < 8u ? G : 8u, nloc = (G + 7u - g) >> 3;
    __builtin_amdgcn_fence(__ATOMIC_RELEASE, "agent");
    __builtin_amdgcn_s_waitcnt(0);
    const unsigned old = gb_add(&bar[64u * (1u + g)], 1u);
    if (old + 1u == (e + 1u) * nloc) {
      const unsigned og = gb_add(&bar[0], 1u);
      if (og + 1u == (e + 1u) * ngrp) gb_add(&bar[64u * 20u], 1u);
      else { unsigned sp = 0; while (gb_ld(&bar[64u * 20u]) <= e && ++sp < (1u << 24)) __builtin_amdgcn_s_sleep(1); }
      gb_add(&bar[64u * (10u + g)], 1u);
    } else {
      unsigned sp = 0; while (gb_ld(&bar[64u * (10u + g)]) <= e && ++sp < (1u << 24)) __builtin_amdgcn_s_sleep(1);
    }
    __builtin_amdgcn_fence(__ATOMIC_ACQUIRE, "agent");
    __builtin_amdgcn_s_waitcnt(0);
  }
  __syncthreads();
}

#define NPHASE 23
#ifndef GRP
#define GRP 0xFFFF
#endif
#define EN(b) ((GRP >> (b)) & 1)
#ifndef DUPMASK
#define DUPMASK 0
#endif
#define PHASE(n, en, ...) if (ph_lo <= (n) && (n) < ph_hi) { if (EN(en)) { __VA_ARGS__ if ((DUPMASK >> (n)) & 1) { __syncthreads(); __VA_ARGS__ } } if ((n) + 1 < ph_hi) { if ((n) == 0) cg::this_grid().sync(); else grid_barrier(bar, (unsigned)((n) - 1)); } }

__device__ __forceinline__ bool deal_tile(int r, int NT, int& mt, int& nt) {
  const int G = gridDim.x, bid = blockIdx.x;
  if (G == 512) {
    const int x = bid & 7, lb = bid >> 3;
    const int NG = NT >> 3, rem = NT & 7;
    if (r < 2 * NG) { mt = 16 * x + (r & 1) * 8 + (lb >> 3); nt = (r >> 1) * 8 + (lb & 7); return true; }
    const int idx = (r - 2 * NG) * 64 + lb;
    if (idx < 16 * rem) { mt = 16 * x + idx / rem; nt = NG * 8 + idx % rem; return true; }
    return false;
  }
  const int t = bid + r * G;
  if (t < 128 * NT) { mt = t / NT; nt = t % NT; return true; }
  return false;
}
__device__ __forceinline__ int deal_rounds(int NT) {
  const int G = gridDim.x;
  if (G == 512) return 2 * (NT >> 3) + (16 * (NT & 7) + 63) / 64;
  return (128 * NT + G - 1) / G;
}
__device__ __forceinline__ void ph_proj(const P& p, int layer, char* lds) {
  {
    const int nr = deal_rounds(32);
    for (int r = 0; r < nr; ++r) {
      int mt, nt2;
      if (!deal_tile(r, 32, mt, nt2)) continue;
      GemmCtx cw; cw.A = p.ubuf; cw.lda = DM; cw.K = DM; cw.layer = layer; cw.j = 0; cw.Bt = p.Wp;
      cw.aux = p.a_mu + (size_t)(layer * 6 + (nt2 >> 3)) * DM;
      gemm_wide<AL_MIX, EP_PROJ>(p, cw, mt, nt2, lds);
    }
  }
  const int NL = layer == 0 ? 2 : 3;
  GemmCtx c; c.A = p.ubuf; c.lda = DM; c.K = DM; c.layer = layer; c.j = 0; c.Bt = p.Wp;
  const int nr = deal_rounds(NL);
  for (int r = 0; r < nr; ++r) {
    int mt, ntl;
    if (!deal_tile(r, NL, mt, ntl)) continue;
    const int nt = 64 + ntl;
    const int mui = nt == 64 ? 4 : nt == 65 ? 5 : 2;
    c.aux = p.a_mu + (size_t)(layer * 6 + mui) * DM;
    gemm_tile<AL_MIX, EP_PROJ>(p, c, mt, nt, lds);
  }
}
__device__ __forceinline__ void ph_wo(const P& p, int layer, const bf16_t* Wt, char* lds) {
  GemmCtx c; c.A = p.ubuf; c.lda = DM; c.Bt = Wt; c.K = DM; c.layer = layer; c.j = 0; c.aux = nullptr;
  const int nr = deal_rounds(8);
  for (int r = 0; r < nr; ++r) {
    int mt, nt2;
    if (!deal_tile(r, 8, mt, nt2)) continue;
    gemm_wide<AL_PLAIN, EP_RESID>(p, c, mt, nt2, lds);
  }
}
__device__ __forceinline__ void ph_kvwin(const P& p, int jl, int NTK, char* lds) {
  const int NK2 = NTK >> 1, NT2 = NK2 + 16;
  {
    const int nr = deal_rounds(NT2);
    for (int r = 0; r < nr; ++r) {
      int mt, nt2;
      if (!deal_tile(r, NT2, mt, nt2)) continue;
      GemmCtx c; c.lda = DM; c.K = DM; c.layer = 1; c.j = jl; c.aux = nullptr;
      if (nt2 < NK2) { c.A = p.hn; c.Bt = p.Wkv; gemm_wide<AL_PLAIN, EP_KV>(p, c, mt, nt2, lds); }
      else { c.A = p.ubuf; c.Bt = p.Win; gemm_wide<AL_PLAIN, EP_WIN>(p, c, mt, nt2 - NK2, lds); }
    }
  }
  if (jl != 0) {
    GemmCtx c; c.lda = DM; c.K = DM; c.layer = 1; c.j = jl; c.aux = nullptr; c.A = p.ubuf; c.Bt = p.Win;
    const int nr = deal_rounds(1);
    for (int r = 0; r < nr; ++r) {
      int mt, ntl;
      if (!deal_tile(r, 1, mt, ntl)) continue;
      gemm_tile<AL_PLAIN, EP_WIN>(p, c, mt, 32, lds);
    }
  }
}
__device__ __forceinline__ void ph_attn(const P& p, char* lds, unsigned long long* uni) {
  const int G = gridDim.x, bid = blockIdx.x;
  const bool xcd = G == 512;
  const int x = bid & 7, lb = bid >> 3, a = lb >> 1, half = lb & 1;
  int rnd = 0;
  for (int base = 0; base < 2048; base += G, ++rnd) {
    int idx;
    if (xcd) {
      const int bg = x * 2 + (rnd >> 1), b = bg >> 2, g = bg & 3;
      const int qb = (rnd & 1) ? a : 63 - a;
      idx = ((63 - qb) << 5) | (b << 3) | (g << 1) | half;
    } else idx = base + ((rnd & 1) ? (G - 1 - bid) : bid);
    if (idx < 2048) attn_item(p, idx, lds, uni);
    __syncthreads();
  }
}

__global__ void __launch_bounds__(NTHREADS, 2) fwd_kernel(const P p, const PJ pj, unsigned* bar, const int ph_lo, const int ph_hi) {
  __shared__ __attribute__((aligned(16))) char lds[LDS_BYTES];
  __shared__ unsigned long long uni[4];
  const int G = gridDim.x, bid = blockIdx.x;
  if (bid == 0 && ph_lo == 0) { for (int i = threadIdx.x; i < 64 * 32; i += NTHREADS) bar[i] = 0u; }
  PHASE(0, 0, norm_phase<0, 0>(p, pj, false, p.a_norm_g, p.ubuf, nullptr, nullptr, nullptr, lds);)
  PHASE(1, 1, ph_proj(p, 0, lds);)
  PHASE(2, 2, for (int it = bid; it < 512; it += G) scan_item(p, 0, G == 512 ? ((((it & 7) * 16 + (it >> 5)) << 2) | ((it >> 3) & 3)) : it, lds);)
  PHASE(3, 3, postscan_phase(p, 0);)
  PHASE(4, 4, ph_wo(p, 0, p.Wo, lds);)
  PHASE(5, 0, norm_phase<0, 1>(p, pj, true, p.a_norm_g + DM, p.ubuf, nullptr, nullptr, nullptr, lds);)
  PHASE(6, 1, ph_proj(p, 1, lds);)
  PHASE(7, 2, for (int it = bid; it < 512; it += G) scan_item(p, 1, G == 512 ? ((((it & 7) * 16 + (it >> 5)) << 2) | ((it >> 3) & 3)) : it, lds);)
  PHASE(8, 3, postscan_phase(p, 1);)
  PHASE(9, 4, ph_wo(p, 1, p.Wo, lds);)
  PHASE(10, 0, norm_phase<1, 2>(p, pj, true, p.kv_norm_g, p.hn, p.b_norm_g, p.ubuf, nullptr, lds);)
  PHASE(11, 5, ph_kvwin(p, 0, 24, lds);)
  PHASE(12, 6,
    for (int t = bid; t < 256; t += G) {
      if (t >= 128) {
        GemmCtx cg; cg.lda = DM; cg.K = DM; cg.layer = 1; cg.j = 0; cg.aux = nullptr; cg.A = p.ubuf; cg.Bt = p.Win;
        gemm_tile<AL_PLAIN, EP_WIN>(p, cg, t - 128, 32, lds);
        continue;
      }
      const int j = t >> 6, r = t & 63, mt = r >> 1, nt = r & 1;
      GemmCtx c; c.A = p.kc + (size_t)j * (8u << 20); c.lda = 0; c.Bt = p.Wc1 + (size_t)j * 256 * 4096; c.K = 4096; c.layer = 0; c.j = j;
      c.aux = p.cmp_pe + (size_t)j * 32 * 128;
      gemm_tile<AL_CMP, EP_CMP1>(p, c, mt, nt, lds);
    })
  PHASE(13, 7,
    for (int t = bid; t < 64; t += G) {
      const int j = t >> 5, mt = t & 31;
      GemmCtx c; c.A = p.hc + (size_t)j * 4096 * 256; c.lda = 256; c.Bt = p.Wc2 + (size_t)j * 128 * 256; c.K = 256; c.layer = 0; c.j = j; c.aux = nullptr;
      gemm_tile<AL_PLAIN, EP_CMP2>(p, c, mt, 0, lds);
    })
  PHASE(14, 8, for (int t = bid; t < 1024; t += G) cmp_item(p, t, lds);)
  PHASE(15, 9, ph_attn(p, lds, uni);)
  PHASE(16, 4, ph_wo(p, 1, p.Wob, lds);)
  PHASE(17, 0, norm_phase<0, 3>(p, pj, true, p.b_norm_g + DM, p.ubuf, nullptr, nullptr, nullptr, lds);)
  PHASE(18, 5, ph_kvwin(p, 1, 0, lds);)
  PHASE(19, 8, for (int t = bid; t < 1024; t += G) cmp_item(p, t, lds);)
  PHASE(20, 9, ph_attn(p, lds, uni);)
  PHASE(21, 4, ph_wo(p, 1, p.Wob, lds);)
  PHASE(22, 0, norm_phase<2, -1>(p, pj, true, p.final_g, nullptr, nullptr, nullptr, p.out, lds);)
}

static inline size_t MiB(double x) { return (size_t)(x * 1048576.0); }

extern "C" void kernel_launch(void* const* d_in, const int* in_sizes, int n_in, void* d_out, int out_size, void* d_ws, size_t ws_size, hipStream_t stream) {
  (void)in_sizes; (void)n_in; (void)out_size;
  P p; memset(&p, 0, sizeof(P));
  PJ pj; memset(&pj, 0, sizeof(PJ));
  const float* const* in = (const float* const*)d_in;
  p.x = in[0]; p.a_norm_g = in[1]; p.a_mu = in[2];
  const float* a_w_rkvz = in[3];
  p.a_w0 = in[4]; const float* a_w1 = in[5]; const float* a_w2 = in[6];
  p.a_a0 = in[7]; const float* a_a1 = in[8]; const float* a_a2 = in[9];
  p.a_v0 = in[10]; const float* a_v1 = in[11]; const float* a_v2 = in[12];
  p.a_k_k = in[13]; p.a_k_a = in[14]; p.a_r_k = in[15]; p.a_ln_g = in[16]; p.a_ln_b = in[17];
  const float* a_w_o = in[18];
  p.kv_norm_g = in[19]; const float* kv_w = in[20]; p.cmp_pe = in[21]; const float* cmp_w1 = in[22]; const float* cmp_w2 = in[23];
  p.b_norm_g = in[24]; const float* b_w_in = in[25]; p.b_gate_b = in[26]; const float* b_w_o = in[27]; p.final_g = in[28];
  p.out = (float*)d_out;
  if (ws_size < MiB(512)) { fprintf(stderr, "workspace too small: %zu\n", ws_size); return; }
  char* ws = (char*)d_ws;
  p.ysum = (bf16_t*)(ws + MiB(0)); p.ubuf = (bf16_t*)(ws + MiB(64)); p.r = (bf16_t*)(ws + MiB(128)); p.k = (bf16_t*)(ws + MiB(192));
  p.vA = (bf16_t*)(ws + MiB(256)); p.z = (bf16_t*)(ws + MiB(320)); p.vB = (bf16_t*)(ws + MiB(384));
  p.hn = (bf16_t*)(ws + MiB(128)); p.ocmp = p.hn; p.q = (bf16_t*)(ws + MiB(192)); p.sz = (bf16_t*)(ws + MiB(256));
  p.kc = (bf16_t*)(ws + MiB(320)); p.vc = (bf16_t*)(ws + MiB(336)); p.ks = (bf16_t*)(ws + MiB(352)); p.vsT = (bf16_t*)(ws + MiB(368));
  p.kw = (bf16_t*)(ws + MiB(384)); p.vwT = (bf16_t*)(ws + MiB(400));
  p.hc = (bf16_t*)(ws + MiB(416)); p.kcmp = (bf16_t*)(ws + MiB(420)); p.vcmpT = (bf16_t*)(ws + MiB(421));
  p.gates = (float*)(ws + MiB(422)); p.selmask = (unsigned*)(ws + MiB(425));
  char* ar = ws + MiB(448);
  p.Wp = (bf16_t*)ar;
  p.W2w = (bf16_t*)(ar + MiB(33.5)); p.W2a = (bf16_t*)(ar + MiB(34)); p.W2v = (bf16_t*)(ar + MiB(34.5));
  p.Wo = (bf16_t*)(ar + MiB(35));
  p.Wkv = (bf16_t*)ar;
  p.Win = (bf16_t*)(ar + MiB(12));
  p.Wc1 = (bf16_t*)(ar + MiB(28.5));
  p.Wc2 = (bf16_t*)(ar + MiB(32.5));
  p.Wob = (bf16_t*)(ar + MiB(33));
  p.lw = (bf16_t*)(ws + MiB(492)); p.la = (bf16_t*)(ws + MiB(496)); p.lv = (bf16_t*)(ws + MiB(500));
  unsigned* bar = (unsigned*)(ws + MiB(508));
  p.bon = (float*)(ws + MiB(504)); p.ropec = (float*)(ws + MiB(506)); p.ropes = (float*)(ws + MiB(506.5));

  int nj = 0, tile = 0;
  auto add = [&](const float* src, bf16_t* dst, int K, int N, int ld, int Kpad, int Npad) {
    ConvJob& j = pj.jobs[nj++]; j.src = src; j.dst = dst; j.K = K; j.N = N; j.ld = ld; j.Kpad = Kpad; j.Npad = Npad; j.tile0 = tile;
    tile += (Kpad / 64) * (Npad / 64);
  };
  const size_t DD = (size_t)DM * DM;
  for (int L = 0; L < 2; ++L) {
    tile = 0;
    for (int n4 = 0; n4 < 4; ++n4) add(a_w_rkvz + (size_t)(L * 4 + n4) * DD, p.Wp + (size_t)n4 * DD, DM, DM, DM, DM, DM);
    add(a_w1 + (size_t)L * DM * 96, p.Wp + (size_t)8192 * DM, DM, 96, 96, DM, 128);
    add(a_a1 + (size_t)L * DM * 96, p.Wp + (size_t)8320 * DM, DM, 96, 96, DM, 128);
    if (L == 1) add(a_v1, p.Wp + (size_t)8448 * DM, DM, 64, 64, DM, 128);
    add(a_w2 + (size_t)L * 96 * DM, p.W2w, 96, DM, DM, 128, DM);
    add(a_a2 + (size_t)L * 96 * DM, p.W2a, 96, DM, DM, 128, DM);
    if (L == 1) add(a_v2, p.W2v, 64, DM, DM, 128, DM);
    add(a_w_o + (size_t)L * DD, p.Wo, DM, DM, DM, DM, DM);
    pj.stage_tiles[L] = tile;
  }
  tile = 0;
  add(kv_w, p.Wkv, DM, 3072, 3072, DM, 3072);
  for (int j = 0; j < 2; ++j) add(cmp_w1 + (size_t)j * 4096 * 256, p.Wc1 + (size_t)j * 256 * 4096, 4096, 256, 256, 4096, 256);
  for (int j = 0; j < 2; ++j) add(cmp_w2 + (size_t)j * 256 * 128, p.Wc2 + (size_t)j * 128 * 256, 256, 128, 128, 256, 128);
  for (int L = 0; L < 2; ++L) {
    if (L == 1) { pj.stage_tiles[2] = tile; tile = 0; }
    const float* wi = b_w_in + (size_t)L * DM * 4144;
    add(wi, p.Win, DM, 2048, 4144, DM, 2048);
    add(wi + 2096, p.Win + (size_t)2048 * DM, DM, 2048, 4144, DM, 2048);
    add(wi + 2048, p.Win + (size_t)4096 * DM, DM, 48, 4144, DM, 128);
    add(b_w_o + (size_t)L * DD, p.Wob, DM, DM, DM, DM, DM);
  }
  pj.stage_tiles[3] = tile;
  for (int i = 0; i < 16; ++i) pj.rope_inv[i] = (float)pow(500000.0, -(double)i / 16.0);

  static int grid_blocks = 0;
  if (!grid_blocks) {
    int dev = 0, cus = 0, per_cu = 0;
    hipGetDevice(&dev);
    hipDeviceGetAttribute(&cus, hipDeviceAttributeMultiprocessorCount, dev);
    hipOccupancyMaxActiveBlocksPerMultiprocessor(&per_cu, fwd_kernel, NTHREADS, 0);
    if (per_cu > 2) per_cu = 2;
    if (per_cu < 1) per_cu = 1;
    grid_blocks = cus * per_cu;
  }
#if ONE_LAUNCH
  int lo = 0, hi = NPHASE;
  void* args[] = {(void*)&p, (void*)&pj, (void*)&bar, (void*)&lo, (void*)&hi};
  hipError_t e = hipLaunchCooperativeKernel((void*)fwd_kernel, dim3(grid_blocks), dim3(NTHREADS), args, 0, stream);
  if (e != hipSuccess) fprintf(stderr, "cooperative launch failed: %s (grid %d)\n", hipGetErrorString(e), grid_blocks);
#else
  for (int ph = 0; ph < NPHASE; ++ph) {
    hipLaunchKernelGGL(fwd_kernel, dim3(grid_blocks), dim3(NTHREADS), 0, stream, p, pj, bar, ph, ph + 1);
  }

#endif
}
```

```cpp
#include <hip/hip_runtime.h>
#include <hip/hip_cooperative_groups.h>
#include <cstdio>
#include <cstdint>
#include <cstring>
#include <cmath>
namespace cg = cooperative_groups;

#ifndef ONE_LAUNCH
#define ONE_LAUNCH 1
#endif

typedef unsigned short bf16_t;
typedef short bf16x8 __attribute__((ext_vector_type(8)));
typedef float f32x4 __attribute__((ext_vector_type(4)));
typedef float f32x16 __attribute__((ext_vector_type(16)));
typedef unsigned u32x4 __attribute__((ext_vector_type(4)));
typedef unsigned u32x2 __attribute__((ext_vector_type(2)));

#define MTOK 16384
#define TSEQ 4096
#define DM 2048
#define NTHREADS 256
#define QSCALE 0.12751743f
#define ATT_KSZ 17408
#define ATT_BUF 35840
#define LDS_BYTES 71680

struct ConvJob { const float* src; bf16_t* dst; int K, N, ld, Kpad, Npad, tile0; };

struct P {
  const float *x, *a_norm_g, *a_mu, *a_w0, *a_a0, *a_v0, *a_k_k, *a_k_a, *a_r_k, *a_ln_g, *a_ln_b;
  const float *kv_norm_g, *cmp_pe, *b_norm_g, *b_gate_b, *final_g;
  float* out;
  bf16_t *ysum, *ubuf, *r, *k, *vA, *z, *vB;
  bf16_t *lw, *la, *lv; float *bon; float *ropec, *ropes;
  bf16_t *Wp, *W2w, *W2a, *W2v, *Wo;
  bf16_t *Wkv, *Win, *Wc1, *Wc2, *Wob;
  bf16_t *hn, *q, *sz, *ocmp;
  bf16_t *kc, *vc, *ks, *vsT, *kw, *vwT, *hc, *kcmp, *vcmpT;
  float *gates; unsigned *selmask;
};
struct PJ {
  ConvJob jobs[33];
  float rope_inv[16];
  int stage_tiles[4];
};

typedef __bf16 bf16x2_t __attribute__((ext_vector_type(2)));
typedef float f32x2 __attribute__((ext_vector_type(2)));
__device__ __forceinline__ unsigned cvtpk(float lo, float hi) {
  f32x2 v = {lo, hi};
  bf16x2_t b = __builtin_convertvector(v, bf16x2_t);
  return __builtin_bit_cast(unsigned, b);
}
__device__ __forceinline__ bf16_t f2bf(float x) { return (bf16_t)(cvtpk(x, x) & 0xffffu); }
__device__ __forceinline__ float bflo(unsigned w) { return __uint_as_float(w << 16); }
__device__ __forceinline__ float bfhi(unsigned w) { return __uint_as_float(w & 0xffff0000u); }
__device__ __forceinline__ float bf2f(bf16_t v) { return __uint_as_float(((unsigned)v) << 16); }
__device__ __forceinline__ void unpack8(bf16x8 v, float* f) {
  u32x4 w = *reinterpret_cast<u32x4*>(&v);
#pragma unroll
  for (int i = 0; i < 4; ++i) { f[2 * i] = bflo(w[i]); f[2 * i + 1] = bfhi(w[i]); }
}
__device__ __forceinline__ bf16x8 pack8f(const float* f) {
  u32x4 w = {cvtpk(f[0], f[1]), cvtpk(f[2], f[3]), cvtpk(f[4], f[5]), cvtpk(f[6], f[7])};
  return *reinterpret_cast<bf16x8*>(&w);
}
__device__ __forceinline__ float sigmoidf_(float x) { return __builtin_amdgcn_rcpf(1.f + __expf(-x)); }
__device__ __forceinline__ float siluf_(float x) { return x * __builtin_amdgcn_rcpf(1.f + __expf(-x)); }
#define DPP(x, ctrl) __int_as_float(__builtin_amdgcn_mov_dpp(__float_as_int(x), ctrl, 0xF, 0xF, true))
__device__ __forceinline__ float sum8(float x) {
  x += DPP(x, 0xB1); x += DPP(x, 0x4E); x += DPP(x, 0x141); return x;
}
__device__ __forceinline__ float wave_sum(float x) {
#pragma unroll
  for (int o = 32; o >= 1; o >>= 1) x += __shfl_xor(x, o);
  return x;
}
__device__ __forceinline__ float swap32_max(float x) {
  auto rr = __builtin_amdgcn_permlane32_swap(__float_as_uint(x), __float_as_uint(x), false, false);
  return fmaxf(__uint_as_float(rr[0]), __uint_as_float(rr[1]));
}
__device__ __forceinline__ float swap32_sum(float x) {
  auto rr = __builtin_amdgcn_permlane32_swap(__float_as_uint(x), __float_as_uint(x), false, false);
  return __uint_as_float(rr[0]) + __uint_as_float(rr[1]);
}
__device__ __forceinline__ int crow(int r, int hi) { return (r & 3) + 8 * (r >> 2) + 4 * hi; }

__device__ __forceinline__ void conv_tile(const ConvJob& jb, int tile, char* lds) {
  float* T = (float*)lds;
  const int nkt = jb.Kpad >> 6;
  const int n0 = (tile / nkt) * 64, k0 = (tile % nkt) * 64;
  const int tx = threadIdx.x & 63, ty = threadIdx.x >> 6;
#pragma unroll 4
  for (int rr = 0; rr < 16; ++rr) {
    int kl = ty * 16 + rr, kk = k0 + kl, n = n0 + tx;
    float v = (kk < jb.K && n < jb.N) ? jb.src[(size_t)kk * jb.ld + n] : 0.f;
    T[kl * 65 + tx] = v;
  }
  __syncthreads();
  const int nl = threadIdx.x >> 2, kc = (threadIdx.x & 3) * 16;
  unsigned w[8];
#pragma unroll
  for (int i = 0; i < 8; ++i) w[i] = cvtpk(T[(kc + 2 * i) * 65 + nl], T[(kc + 2 * i + 1) * 65 + nl]);
  bf16_t* d = jb.dst + (size_t)(n0 + nl) * jb.Kpad + k0 + kc;
  *(u32x4*)d = u32x4{w[0], w[1], w[2], w[3]};
  *(u32x4*)(d + 8) = u32x4{w[4], w[5], w[6], w[7]};
  __syncthreads();
}

template <int MODE>
__device__ __forceinline__ void rmsnorm_row(const P& p, int row, bool has_y, const float* g1, bf16_t* o1, const float* g2, bf16_t* o2, float* of) {
  const int lane = threadIdx.x & 63;
  const float* xr = p.x + (size_t)row * DM;
  const bf16_t* yr = p.ysum + (size_t)row * DM;
  f32x4 v[8]; float ss = 0.f;
#pragma unroll
  for (int i = 0; i < 8; ++i) {
    int c = (lane + 64 * i) * 4;
    v[i] = *(const f32x4*)(xr + c);
    if (has_y) { u32x2 w = *(const u32x2*)(yr + c); v[i][0] += bflo(w[0]); v[i][1] += bfhi(w[0]); v[i][2] += bflo(w[1]); v[i][3] += bfhi(w[1]); }
    ss += v[i][0] * v[i][0] + v[i][1] * v[i][1] + v[i][2] * v[i][2] + v[i][3] * v[i][3];
  }
  ss = wave_sum(ss);
  const float rs = rsqrtf(ss * (1.f / DM) + 1e-6f);
#pragma unroll
  for (int i = 0; i < 8; ++i) {
    int c = (lane + 64 * i) * 4;
    f32x4 g = *(const f32x4*)(g1 + c);
    if (MODE == 2) {
      f32x4 y = {v[i][0] * rs * g[0], v[i][1] * rs * g[1], v[i][2] * rs * g[2], v[i][3] * rs * g[3]};
      *(f32x4*)(of + (size_t)row * DM + c) = y;
    } else {
      u32x2 w = {cvtpk(v[i][0] * rs * g[0], v[i][1] * rs * g[1]), cvtpk(v[i][2] * rs * g[2], v[i][3] * rs * g[3])};
      *(u32x2*)(o1 + (size_t)row * DM + c) = w;
      if (MODE == 1) {
        f32x4 gg = *(const f32x4*)(g2 + c);
        u32x2 w2 = {cvtpk(v[i][0] * rs * gg[0], v[i][1] * rs * gg[1]), cvtpk(v[i][2] * rs * gg[2], v[i][3] * rs * gg[3])};
        *(u32x2*)(o2 + (size_t)row * DM + c) = w2;
      }
    }
  }
}

template <int MODE, int STAGE>
__device__ __forceinline__ void norm_phase(const P& p, const PJ& pj, bool has_y, const float* g1, bf16_t* o1, const float* g2, bf16_t* o2, float* of, char* lds) {
  if constexpr (STAGE >= 0) {
    constexpr int J0 = STAGE == 0 ? 0 : STAGE == 1 ? 9 : STAGE == 2 ? 20 : 29;
    constexpr int J1 = STAGE == 0 ? 9 : STAGE == 1 ? 20 : STAGE == 2 ? 29 : 33;
    const int nt = pj.stage_tiles[STAGE];
    for (int t = blockIdx.x; t < nt; t += gridDim.x) {
      const float* jsrc = pj.jobs[J0].src; bf16_t* jdst = pj.jobs[J0].dst;
      int jK = pj.jobs[J0].K, jN = pj.jobs[J0].N, jld = pj.jobs[J0].ld, jKp = pj.jobs[J0].Kpad, jNp = pj.jobs[J0].Npad, jt0 = pj.jobs[J0].tile0;
#pragma unroll
      for (int j = J0 + 1; j < J1; ++j) {
        const bool cnd = t >= pj.jobs[j].tile0;
        jsrc = cnd ? pj.jobs[j].src : jsrc; jdst = cnd ? pj.jobs[j].dst : jdst;
        jK = cnd ? pj.jobs[j].K : jK; jN = cnd ? pj.jobs[j].N : jN; jld = cnd ? pj.jobs[j].ld : jld;
        jKp = cnd ? pj.jobs[j].Kpad : jKp; jNp = cnd ? pj.jobs[j].Npad : jNp; jt0 = cnd ? pj.jobs[j].tile0 : jt0;
      }
      ConvJob jb; jb.src = jsrc; jb.dst = jdst; jb.K = jK; jb.N = jN; jb.ld = jld; jb.Kpad = jKp; jb.Npad = jNp; jb.tile0 = jt0;
      conv_tile(jb, t - jt0, lds);
    }
    if constexpr (STAGE == 0) {
      for (int pos = blockIdx.x * NTHREADS + threadIdx.x; pos < TSEQ; pos += gridDim.x * NTHREADS) {
#pragma unroll
        for (int i = 0; i < 16; ++i) {
          const float ang = (float)pos * pj.rope_inv[i];
          const double a = (double)ang * 0.15915494309189535;
          const float fr = (float)(a - rint(a));
          p.ropec[pos * 16 + i] = __builtin_amdgcn_cosf(fr); p.ropes[pos * 16 + i] = __builtin_amdgcn_sinf(fr);
        }
      }
    }
  }
  const bool aff = gridDim.x == 512;
  const int gw = aff ? (((int)blockIdx.x >> 3) * 4 + (int)(threadIdx.x >> 6)) : (int)(blockIdx.x * 4 + (threadIdx.x >> 6));
  const int nw = aff ? 256 : (int)gridDim.x * 4;
  const int rbeg = aff ? ((int)blockIdx.x & 7) * 2048 : 0, rend = aff ? rbeg + 2048 : MTOK;
  for (int row = rbeg + gw; row < rend; row += nw) rmsnorm_row<MODE>(p, row, has_y, g1, o1, g2, o2, of);
}

enum { AL_PLAIN = 0, AL_MIX = 1, AL_CMP = 2 };
enum { EP_PROJ = 0, EP_RESID = 1, EP_KV = 2, EP_CMP1 = 3, EP_CMP2 = 4, EP_WIN = 5 };

struct GemmCtx {
  const bf16_t* A; int lda;
  const bf16_t* Bt; int K;
  const float* aux;
  int layer, j;
};

template <int NI>
__device__ __forceinline__ void store_rows_lds(bf16_t* base, const size_t ld, const int row0, const int cbase, f32x4 (&acc)[4][NI], char* lds, const bool rmw) {
  constexpr int RB = NI * 32 + 16;
  constexpr int CPR = NI * 2;
  const int lane = threadIdx.x & 63, wid = threadIdx.x >> 6, lr = lane & 15, lq = lane >> 4;
  char* W = lds + wid * (64 * RB);
#pragma unroll
  for (int mi = 0; mi < 4; ++mi)
#pragma unroll
    for (int ni = 0; ni < NI; ++ni)
#pragma unroll
      for (int j = 0; j < 4; ++j) *(bf16_t*)(W + (mi * 16 + lq * 4 + j) * RB + (ni * 16 + lr) * 2) = f2bf(acc[mi][ni][j]);
  __builtin_amdgcn_fence(__ATOMIC_RELEASE, "wavefront");
  __builtin_amdgcn_wave_barrier();
#pragma unroll 4
  for (int i = 0; i < CPR; ++i) {
    const int id = lane + 64 * i, row = id / CPR, cc = id % CPR;
    bf16x8 v = *(const bf16x8*)(W + row * RB + cc * 16);
    bf16_t* g = base + (size_t)(row0 + row) * ld + cbase + cc * 8;
    if (rmw) {
      float fa[8], fb[8]; unpack8(v, fa); unpack8(*(const bf16x8*)g, fb);
#pragma unroll
      for (int e = 0; e < 8; ++e) fa[e] += fb[e];
      v = pack8f(fa);
    }
    *(bf16x8*)g = v;
  }
}

template <int EP, int NI>
__device__ __forceinline__ void gemm_epilogue(const P& p, const GemmCtx& c, const int nt, const int m0, const int wr, const int lq, const int lr, const int cbase, f32x4 (&acc)[4][NI], char* lds) {
  const int rbase = m0 + wr * 64 + lq * 4; const int n0 = nt * 128;
  const int cl = cbase + lr;
  if constexpr (EP == EP_PROJ) {
    if (nt < 64) {
      const int which = nt >> 4;
      const int slab = which < 2 ? which : which == 3 ? 3 : (c.layer == 0 ? 2 : 4);
      bf16_t* dst = p.r + (size_t)slab * (32u << 20);
      store_rows_lds<NI>(dst + (nt & 15) * 128, DM, m0 + wr * 64, cbase, acc, lds, false);
    } else {
      bf16_t* dst = p.lw + (size_t)(nt - 64) * (2u << 20);
#pragma unroll
      for (int mi = 0; mi < 4; ++mi)
#pragma unroll
        for (int ni = 0; ni < NI; ++ni)
#pragma unroll
          for (int j = 0; j < 4; ++j) {
            float v = acc[mi][ni][j];
            if (nt == 64) v = 1.f - 2.f * __builtin_amdgcn_rcpf(1.f + __expf(2.f * v));
            dst[(size_t)(rbase + mi * 16 + j) * 128 + cl + ni * 16] = f2bf(v);
          }
    }
  } else if constexpr (EP == EP_RESID) {
    const bool has_y = c.layer != 0;
    store_rows_lds<NI>(p.ysum + n0, DM, m0 + wr * 64, cbase, acc, lds, has_y);
  } else if constexpr (EP == EP_KV || EP == EP_WIN || EP == EP_CMP2) {
    int kind;
    bool rope = false; float qs = 1.f;
    bf16_t* dst = nullptr; int bgidx = 0;
    if constexpr (EP == EP_KV) {
      const int i = nt >> 2, g = nt & 3; bgidx = g;
      kind = (i == 3 || i == 5) ? 1 : 0; rope = (i == 2 || i == 4);
      dst = p.kc + (size_t)i * (8u << 20);
    } else if constexpr (EP == EP_WIN) {
      kind = nt < 16 ? 0 : nt < 32 ? 2 : 3; rope = nt < 16; qs = nt < 16 ? QSCALE : 1.f;
      dst = p.q + (nt < 16 ? (size_t)0 : (size_t)(32u << 20));
    } else {
      kind = c.j == 0 ? 0 : 1; rope = c.j == 0; dst = p.kcmp + (size_t)c.j * (512u << 10);
    }
    if (rope && cbase == 0) {
#pragma unroll
      for (int mi = 0; mi < 4; ++mi)
#pragma unroll
        for (int j = 0; j < 4; ++j) {
          const int row = rbase + mi * 16 + j;
          int pos;
          if constexpr (EP == EP_CMP2) { pos = 16 * (row & 255) + 31; if (pos > TSEQ - 1) pos = TSEQ - 1; } else pos = row & (TSEQ - 1);
          const float cs = p.ropec[pos * 16 + lr], sn = p.ropes[pos * 16 + lr];
          const float x1 = acc[mi][0][j], x2 = acc[mi][1][j];
          acc[mi][0][j] = x1 * cs - x2 * sn; acc[mi][1][j] = x2 * cs + x1 * sn;
        }
    }
    if (kind == 0 || kind == 2) {
      const bool sil = kind == 2;
#pragma unroll
      for (int mi = 0; mi < 4; ++mi)
#pragma unroll
        for (int ni = 0; ni < NI; ++ni)
#pragma unroll
          for (int j = 0; j < 4; ++j) { const float v = acc[mi][ni][j]; acc[mi][ni][j] = sil ? siluf_(v) : v * qs; }
      bf16_t* base; size_t ld;
      if constexpr (EP == EP_KV) {
        const int i = nt >> 2;
        if (i < 2) { base = dst + bgidx * 128; ld = 512; }
        else { const int b = m0 >> 12; base = dst + (size_t)(3 * b + bgidx) * TSEQ * 128; ld = 128; }
      } else if constexpr (EP == EP_WIN) { base = dst + (nt & 15) * 128; ld = DM; }
      else { base = dst; ld = 128; }
      store_rows_lds<NI>(base, ld, m0 + wr * 64, cbase, acc, lds, false);
    } else if (kind == 1) {
#pragma unroll
      for (int mi = 0; mi < 4; ++mi)
#pragma unroll
        for (int ni = 0; ni < NI; ++ni) {
          const int row0 = m0 + wr * 64 + mi * 16;
          const int d = cl + ni * 16;
          const int slot = (lq & 1) * 8 + (lq >> 1) * 4;
          u32x2 w = {cvtpk(acc[mi][ni][0], acc[mi][ni][1]), cvtpk(acc[mi][ni][2], acc[mi][ni][3])};
          size_t idx;
          if constexpr (EP == EP_KV) { const int b = row0 >> 12, t0 = row0 & (TSEQ - 1); idx = ((size_t)((b * 4 + bgidx) * 128 + d)) * TSEQ + t0 + slot; }
          else { const int bg = row0 >> 8, c0 = row0 & 255; idx = ((size_t)(bg * 128 + d)) * 256 + c0 + slot; }
          *(u32x2*)(dst + idx) = w;
        }
    } else {
      const float* gb = p.b_gate_b + c.j * 48;
#pragma unroll
      for (int mi = 0; mi < 4; ++mi)
#pragma unroll
        for (int ni = 0; ni < NI; ++ni) {
          const int n = cl + ni * 16;
          if (n < 48) {
#pragma unroll
            for (int j = 0; j < 4; ++j) p.gates[(size_t)(rbase + mi * 16 + j) * 48 + n] = sigmoidf_(acc[mi][ni][j] + gb[n]);
          }
        }
    }
  } else if constexpr (EP == EP_CMP1) {
    bf16_t* dst = p.hc + (size_t)c.j * 4096 * 256;
#pragma unroll
    for (int mi = 0; mi < 4; ++mi)
#pragma unroll
      for (int ni = 0; ni < NI; ++ni)
#pragma unroll
        for (int j = 0; j < 4; ++j) dst[(size_t)(rbase + mi * 16 + j) * 256 + n0 + cl + ni * 16] = f2bf(siluf_(acc[mi][ni][j]));
  }
  __syncthreads();
}

template <int AL, int EP>
__device__ __forceinline__ void gemm_tile(const P& p, const GemmCtx& c, const int mt, const int nt, char* lds) {
  const int tid = threadIdx.x, lane = tid & 63, wid = tid >> 6;
  const int wr = wid >> 1, wc = wid & 1, lr = lane & 15, lq = lane >> 4;
  const int m0 = mt * 128, n0 = nt * 128;
  const int K = c.K, nk = K >> 6;
  const int lc = tid & 7, lrow = tid >> 3;
  f32x4 acc[4][4];
#pragma unroll
  for (int i = 0; i < 4; ++i)
#pragma unroll
    for (int j = 0; j < 4; ++j) acc[i][j] = f32x4{0.f, 0.f, 0.f, 0.f};
  bf16x8 ra[4], rp[4], rb[4]; f32x4 ax0, ax1;

  auto load_tile = [&](int kt) {
#pragma unroll
    for (int i = 0; i < 4; ++i) {
      const int row = lrow + 32 * i;
      rb[i] = *(const bf16x8*)(c.Bt + (size_t)(n0 + row) * K + kt * 64 + lc * 8);
      if constexpr (AL == AL_PLAIN) {
        ra[i] = *(const bf16x8*)(c.A + (size_t)(m0 + row) * c.lda + kt * 64 + lc * 8);
      } else if constexpr (AL == AL_MIX) {
        const int m = m0 + row;
        const bf16_t* src = c.A + (size_t)m * DM + kt * 64 + lc * 8;
        ra[i] = *(const bf16x8*)src;
        if ((m & (TSEQ - 1)) != 0) rp[i] = *(const bf16x8*)(src - DM); else rp[i] = bf16x8{0, 0, 0, 0, 0, 0, 0, 0};
      } else {
        const int R = m0 + row, bg = R >> 8, cc = R & 255, b = bg >> 2, g = bg & 3;
        const int l = kt >> 1, d = (kt & 1) * 64 + lc * 8;
        int t = 16 * cc + l; if (t > TSEQ - 1) t = TSEQ - 1;
        ra[i] = *(const bf16x8*)(c.A + ((size_t)(b * TSEQ + t)) * 512 + g * 128 + d);
      }
    }
    if constexpr (AL == AL_MIX) { const float* mu = c.aux + kt * 64 + lc * 8; ax0 = *(const f32x4*)mu; ax1 = *(const f32x4*)(mu + 4); }
    if constexpr (AL == AL_CMP) { const float* pe = c.aux + (kt >> 1) * 128 + (kt & 1) * 64 + lc * 8; ax0 = *(const f32x4*)pe; ax1 = *(const f32x4*)(pe + 4); }
  };
  auto store_tile = [&](int buf) {
    char* Ab = lds + buf * 32768; char* Bb = Ab + 16384;
#pragma unroll
    for (int i = 0; i < 4; ++i) {
      const int row = lrow + 32 * i;
      const int off = row * 128 + ((lc ^ (row & 7)) << 4);
      *(bf16x8*)(Bb + off) = rb[i];
      if constexpr (AL == AL_PLAIN) { *(bf16x8*)(Ab + off) = ra[i]; }
      else {
        float f[8]; unpack8(ra[i], f);
        const float mu[8] = {ax0[0], ax0[1], ax0[2], ax0[3], ax1[0], ax1[1], ax1[2], ax1[3]};
        if constexpr (AL == AL_MIX) {
          float fp[8]; unpack8(rp[i], fp);
#pragma unroll
          for (int e = 0; e < 8; ++e) f[e] = f[e] + (fp[e] - f[e]) * mu[e];
        } else {
#pragma unroll
          for (int e = 0; e < 8; ++e) f[e] = f[e] + mu[e];
        }
        *(bf16x8*)(Ab + off) = pack8f(f);
      }
    }
  };
  auto compute = [&](int buf) {
    const char* Ab = lds + buf * 32768; const char* Bb = Ab + 16384;
#pragma unroll
    for (int ks = 0; ks < 2; ++ks) {
      bf16x8 af[4], bfr[4];
#pragma unroll
      for (int mi = 0; mi < 4; ++mi) { const int row = wr * 64 + mi * 16 + lr; af[mi] = *(const bf16x8*)(Ab + row * 128 + (((ks * 4 + lq) ^ (row & 7)) << 4)); }
#pragma unroll
      for (int ni = 0; ni < 4; ++ni) { const int row = wc * 64 + ni * 16 + lr; bfr[ni] = *(const bf16x8*)(Bb + row * 128 + (((ks * 4 + lq) ^ (row & 7)) << 4)); }
#pragma unroll
      for (int mi = 0; mi < 4; ++mi)
#pragma unroll
        for (int ni = 0; ni < 4; ++ni) acc[mi][ni] = __builtin_amdgcn_mfma_f32_16x16x32_bf16(af[mi], bfr[ni], acc[mi][ni], 0, 0, 0);
    }
  };

  load_tile(0);
  store_tile(0);
  __syncthreads();
  for (int kt = 0; kt < nk; ++kt) {
    if (kt + 1 < nk) load_tile(kt + 1);
    __builtin_amdgcn_sched_barrier(0);
    compute(kt & 1);
    __builtin_amdgcn_sched_barrier(0);
    if (kt + 1 < nk) store_tile((kt + 1) & 1);
    __syncthreads();
  }

  gemm_epilogue<EP, 4>(p, c, nt, m0, wr, lq, lr, wc * 64, acc, lds);
}


template <int AL, int EP>
__device__ __forceinline__ void gemm_wide(const P& p, const GemmCtx& c, const int mt, const int nt2, char* lds) {
  const int tid = threadIdx.x, lane = tid & 63, wid = tid >> 6;
  const int wr = wid >> 1, wc = wid & 1, lr = lane & 15, lq = lane >> 4;
  const int m0 = mt * 128, n0 = nt2 * 256;
  const int K = c.K, nk = K >> 5;
  const bf16_t* A = c.A;
  const bf16_t* Bt = c.Bt;
  const float* mu = c.aux;
  const int lc = tid & 3, lrow = tid >> 2;
  f32x4 acc[4][8];
#pragma unroll
  for (int i = 0; i < 4; ++i)
#pragma unroll
    for (int j = 0; j < 8; ++j) acc[i][j] = f32x4{0.f, 0.f, 0.f, 0.f};
  bf16x8 ra[2], rp[2], rb[4]; f32x4 ax0, ax1;
  auto load_tile = [&](int kt) {
#pragma unroll
    for (int i = 0; i < 4; ++i) rb[i] = *(const bf16x8*)(Bt + (size_t)(n0 + lrow + 64 * i) * K + kt * 32 + lc * 8);
#pragma unroll
    for (int i = 0; i < 2; ++i) {
      const int m = m0 + lrow + 64 * i;
      const bf16_t* src = A + (size_t)m * c.lda + kt * 32 + lc * 8;
      ra[i] = *(const bf16x8*)src;
      if constexpr (AL == AL_MIX) { if ((m & (TSEQ - 1)) != 0) rp[i] = *(const bf16x8*)(src - DM); else rp[i] = bf16x8{0, 0, 0, 0, 0, 0, 0, 0}; }
    }
    if constexpr (AL == AL_MIX) { ax0 = *(const f32x4*)(mu + kt * 32 + lc * 8); ax1 = *(const f32x4*)(mu + kt * 32 + lc * 8 + 4); }
  };
  auto store_tile = [&](int buf) {
    char* Ab = lds + buf * 24576; char* Bb = Ab + 8192;
#pragma unroll
    for (int i = 0; i < 4; ++i) { const int row = lrow + 64 * i; *(bf16x8*)(Bb + row * 64 + ((lc ^ ((-(row >> 2)) & 3)) << 4)) = rb[i]; }
#pragma unroll
    for (int i = 0; i < 2; ++i) {
      const int row = lrow + 64 * i;
      if constexpr (AL == AL_MIX) {
        const float muv[8] = {ax0[0], ax0[1], ax0[2], ax0[3], ax1[0], ax1[1], ax1[2], ax1[3]};
        float f[8], fp[8]; unpack8(ra[i], f); unpack8(rp[i], fp);
#pragma unroll
        for (int e = 0; e < 8; ++e) f[e] = f[e] + (fp[e] - f[e]) * muv[e];
        *(bf16x8*)(Ab + row * 64 + ((lc ^ ((-(row >> 2)) & 3)) << 4)) = pack8f(f);
      } else {
        *(bf16x8*)(Ab + row * 64 + ((lc ^ ((-(row >> 2)) & 3)) << 4)) = ra[i];
      }
    }
  };
  auto compute = [&](int buf) {
    const char* Ab = lds + buf * 24576; const char* Bb = Ab + 8192;
    const int sw = (lq ^ ((-(lr >> 2)) & 3)) << 4;
    bf16x8 af[4];
#pragma unroll
    for (int mi = 0; mi < 4; ++mi) af[mi] = *(const bf16x8*)(Ab + (wr * 64 + mi * 16 + lr) * 64 + sw);
#pragma unroll
    for (int nh = 0; nh < 2; ++nh) {
      bf16x8 bfr[4];
#pragma unroll
      for (int ni = 0; ni < 4; ++ni) bfr[ni] = *(const bf16x8*)(Bb + (wc * 128 + (nh * 4 + ni) * 16 + lr) * 64 + sw);
#pragma unroll
      for (int mi = 0; mi < 4; ++mi)
#pragma unroll
        for (int ni = 0; ni < 4; ++ni) acc[mi][nh * 4 + ni] = __builtin_amdgcn_mfma_f32_16x16x32_bf16(af[mi], bfr[ni], acc[mi][nh * 4 + ni], 0, 0, 0);
    }
  };
  load_tile(0);
  store_tile(0);
  __syncthreads();
  for (int kt = 0; kt < nk; ++kt) {
    if (kt + 1 < nk) load_tile(kt + 1);
    __builtin_amdgcn_sched_barrier(0);
    compute(kt & 1);
    __builtin_amdgcn_sched_barrier(0);
    if (kt + 1 < nk) store_tile((kt + 1) & 1);
    __syncthreads();
  }
  gemm_epilogue<EP, 8>(p, c, 2 * nt2 + wc, m0, wr, lq, lr, 0, acc, lds);
}

__device__ __forceinline__ float sum16(float x) {
  x += DPP(x, 0xB1); x += DPP(x, 0x4E); x += DPP(x, 0x141); x += DPP(x, 0x140); return x;
}
__device__ __forceinline__ void scan_item(const P& p, const int layer, const int item, char* lds) {
  const int quarter = item & 3, h = (item >> 2) & 31, b = item >> 7;
  const int tid = threadIdx.x, lane = tid & 63, wid = tid >> 6;
  float* R = (float*)lds;
  float* W = R + 2048; float* Kk = W + 2048; float* Aa = Kk + 2048; float* Bv = Aa + 2048;
  float* V = Bv + 2048;
  float* Vg = V + 512;
  float* O = Vg + 512;
  float* KKp = O + 528; float* KAp = KKp + 64; float* RKp = KAp + 64;
  float* LBp = RKp + 64;
  const bf16_t* vsrc = p.vA + (size_t)layer * (64u << 20);
  bf16_t* vdst = p.vB;
  const int tl = tid >> 3, c8 = tid & 7;
  const int ch0 = h * 64 + c8 * 8;
  const int vc0 = h * 64 + quarter * 16;
  const int lr = lane & 15, lq = lane >> 4;
  const int ten = wid >> 1, lmi = wid & 1;
  const bf16_t* lA = p.lw + (size_t)ten * (2u << 20);
  const bf16_t* lB = p.W2w + (size_t)ten * (256u << 10);
  if (tid < 64) {
    KKp[tid] = p.a_k_k[layer * DM + h * 64 + tid]; KAp[tid] = p.a_k_a[layer * DM + h * 64 + tid]; RKp[tid] = p.a_r_k[layer * DM + h * 64 + tid];
  }
  if (tid < 128) { const float b0_ = p.a_w0[layer * DM + h * 64 + (tid & 63)], b1_ = p.a_a0[layer * DM + h * 64 + (tid & 63)]; LBp[tid] = tid < 64 ? b0_ : b1_; }
  if (tid >= 128 && tid < 144) LBp[tid] = layer == 1 ? p.a_v0[vc0 + (tid - 128)] : 0.f;
  const int row = tid >> 4, kq = tid & 15;
  f32x2 S01 = {0.f, 0.f}, S23 = {0.f, 0.f};

  const size_t tok0 = (size_t)b * TSEQ;
  bf16x8 rr, rk, rv, rvf;
  bf16x8 wB[3][4], wBv[2], fA[3], fAv[2];
#pragma unroll
  for (int ks = 0; ks < 3; ++ks)
#pragma unroll
    for (int ni = 0; ni < 4; ++ni) wB[ks][ni] = *(const bf16x8*)(lB + (size_t)(h * 64 + ni * 16 + lr) * 128 + ks * 32 + lq * 8);
  if (layer == 1) {
#pragma unroll
    for (int ks = 0; ks < 2; ++ks) wBv[ks] = *(const bf16x8*)(p.W2v + (size_t)(vc0 + lr) * 128 + ks * 32 + lq * 8);
  }
  auto load_raw = [&](int c) {
    const size_t m = tok0 + c * 32 + tl;
    {
      const size_t ml = tok0 + c * 32 + lmi * 16 + lr;
#pragma unroll
      for (int ks = 0; ks < 3; ++ks) fA[ks] = *(const bf16x8*)(lA + ml * 128 + ks * 32 + lq * 8);
      if (layer == 1) {
#pragma unroll
        for (int ks = 0; ks < 2; ++ks) fAv[ks] = *(const bf16x8*)(p.lv + ml * 128 + ks * 32 + lq * 8);
      }
    }
    rr = *(const bf16x8*)(p.r + m * DM + ch0);
    rk = *(const bf16x8*)(p.k + m * DM + ch0);
    if (c8 < 2) {
      rv = *(const bf16x8*)(vsrc + m * DM + vc0 + c8 * 8);
      if (layer == 1) rvf = *(const bf16x8*)(p.vA + m * DM + vc0 + c8 * 8);
    }
  };
  load_raw(0);
  __syncthreads();
  for (int c = 0; c < TSEQ / 32; ++c) {
    const size_t mc = tok0 + c * 32;
    {
      f32x4 acc[4];
#pragma unroll
      for (int ni = 0; ni < 4; ++ni) acc[ni] = f32x4{0.f, 0.f, 0.f, 0.f};
#pragma unroll
      for (int ks = 0; ks < 3; ++ks) {
#pragma unroll
        for (int ni = 0; ni < 4; ++ni) acc[ni] = __builtin_amdgcn_mfma_f32_16x16x32_bf16(fA[ks], wB[ks][ni], acc[ni], 0, 0, 0);
      }
      float* dstL = ten == 0 ? W : Bv;
#pragma unroll
      for (int ni = 0; ni < 4; ++ni)
#pragma unroll
        for (int j = 0; j < 4; ++j) {
          float sg = sigmoidf_(acc[ni][j] + LBp[ten * 64 + ni * 16 + lr]);
          float val = ten == 0 ? __expf(-0.6065306597126334f * sg) : sg;
          dstL[(lmi * 16 + lq * 4 + j) * 64 + ni * 16 + lr] = val;
        }
      if (layer == 1 && wid < 2) {
        f32x4 av = f32x4{0.f, 0.f, 0.f, 0.f};
#pragma unroll
        for (int ks = 0; ks < 2; ++ks) av = __builtin_amdgcn_mfma_f32_16x16x32_bf16(fAv[ks], wBv[ks], av, 0, 0, 0);
#pragma unroll
        for (int j = 0; j < 4; ++j) Vg[(wid * 16 + lq * 4 + j) * 16 + lr] = sigmoidf_(av[j] + LBp[128 + lr]);
      }
    }
    if (c > 0) {
      const float o0 = O[(c8 * 2) * 33 + tl], o1 = O[(c8 * 2 + 1) * 33 + tl];
      *(unsigned*)(p.ubuf + (mc - 32 + tl) * DM + vc0 + c8 * 2) = cvtpk(o0, o1);
    }
    __syncthreads();
    {
      float fr[8], fk[8], fa[8];
      unpack8(rr, fr); unpack8(rk, fk);
      { f32x4 a0 = *(const f32x4*)(Bv + tl * 64 + c8 * 8), a1 = *(const f32x4*)(Bv + tl * 64 + c8 * 8 + 4);
        fa[0] = a0[0]; fa[1] = a0[1]; fa[2] = a0[2]; fa[3] = a0[3]; fa[4] = a1[0]; fa[5] = a1[1]; fa[6] = a1[2]; fa[7] = a1[3]; }
      float kk[8], ss = 0.f, bsum = 0.f;
      float kkv[8], kav[8], rkv[8];
      { f32x4 t0 = *(const f32x4*)(KKp + c8 * 8), t1 = *(const f32x4*)(KKp + c8 * 8 + 4);
        kkv[0] = t0[0]; kkv[1] = t0[1]; kkv[2] = t0[2]; kkv[3] = t0[3]; kkv[4] = t1[0]; kkv[5] = t1[1]; kkv[6] = t1[2]; kkv[7] = t1[3];
        t0 = *(const f32x4*)(KAp + c8 * 8); t1 = *(const f32x4*)(KAp + c8 * 8 + 4);
        kav[0] = t0[0]; kav[1] = t0[1]; kav[2] = t0[2]; kav[3] = t0[3]; kav[4] = t1[0]; kav[5] = t1[1]; kav[6] = t1[2]; kav[7] = t1[3];
        t0 = *(const f32x4*)(RKp + c8 * 8); t1 = *(const f32x4*)(RKp + c8 * 8 + 4);
        rkv[0] = t0[0]; rkv[1] = t0[1]; rkv[2] = t0[2]; rkv[3] = t0[3]; rkv[4] = t1[0]; rkv[5] = t1[1]; rkv[6] = t1[2]; rkv[7] = t1[3]; }
#pragma unroll
      for (int e = 0; e < 8; ++e) { kk[e] = fk[e] * kkv[e]; ss += kk[e] * kk[e]; }
      ss = sum8(ss);
      const float inv = __builtin_amdgcn_rsqf(fmaxf(ss, 1e-24f));
      float kp[8], na[8], bb[8];
#pragma unroll
      for (int e = 0; e < 8; ++e) {
        kk[e] *= inv;
        kp[e] = fk[e] * (1.f + (fa[e] - 1.f) * kav[e]);
        na[e] = -kk[e]; bb[e] = kk[e] * fa[e];
        bsum += fr[e] * kp[e] * rkv[e];
      }
      bsum = sum8(bsum);
      float* d;
      d = R + tl * 64 + c8 * 8;  *(f32x4*)d = f32x4{fr[0], fr[1], fr[2], fr[3]}; *(f32x4*)(d + 4) = f32x4{fr[4], fr[5], fr[6], fr[7]};
      d = Kk + tl * 64 + c8 * 8; *(f32x4*)d = f32x4{kp[0], kp[1], kp[2], kp[3]}; *(f32x4*)(d + 4) = f32x4{kp[4], kp[5], kp[6], kp[7]};
      d = Aa + tl * 64 + c8 * 8; *(f32x4*)d = f32x4{na[0], na[1], na[2], na[3]}; *(f32x4*)(d + 4) = f32x4{na[4], na[5], na[6], na[7]};
      d = Bv + tl * 64 + c8 * 8; *(f32x4*)d = f32x4{bb[0], bb[1], bb[2], bb[3]}; *(f32x4*)(d + 4) = f32x4{bb[4], bb[5], bb[6], bb[7]};
      if (quarter == 0 && c8 == 0) p.bon[(mc + tl) * 32 + h] = bsum;
      if (c8 < 2) {
        float fv[8]; unpack8(rv, fv);
        if (layer == 1) {
          float ff[8]; unpack8(rvf, ff);
          f32x4 g0 = *(const f32x4*)(Vg + tl * 16 + c8 * 8), g1 = *(const f32x4*)(Vg + tl * 16 + c8 * 8 + 4);
          const float gg[8] = {g0[0], g0[1], g0[2], g0[3], g1[0], g1[1], g1[2], g1[3]};
#pragma unroll
          for (int e = 0; e < 8; ++e) fv[e] = fv[e] + (ff[e] - fv[e]) * gg[e];
          *(bf16x8*)(vdst + (mc + tl) * DM + vc0 + c8 * 8) = pack8f(fv);
        }
        d = V + tl * 16 + c8 * 8; *(f32x4*)d = f32x4{fv[0], fv[1], fv[2], fv[3]}; *(f32x4*)(d + 4) = f32x4{fv[4], fv[5], fv[6], fv[7]};
      }
    }
    __syncthreads();
    if (c + 1 < TSEQ / 32) load_raw(c + 1);
    {
      f32x4 xa, xw, xk, xb, xr, na_, nw_, nk_, nb_, nr_; float xv, nv;
      const float* bA = Aa + kq * 4; const float* bW = W + kq * 4; const float* bK = Kk + kq * 4; const float* bB = Bv + kq * 4; const float* bR = R + kq * 4;
      xa = *(const f32x4*)bA; xw = *(const f32x4*)bW; xk = *(const f32x4*)bK; xb = *(const f32x4*)bB; xr = *(const f32x4*)bR; xv = V[row];
      float opend = 0.f;
#pragma unroll 8
      for (int t = 0; t < 32; ++t) {
        const f32x2 xa01 = {xa[0], xa[1]}, xa23 = {xa[2], xa[3]};
        f32x2 pa = S01 * xa01; pa = __builtin_elementwise_fma(S23, xa23, pa);
        float ra_ = pa[0] + pa[1];
        __builtin_amdgcn_sched_barrier(0);
        {
          const int o_ = ((t + 1) & 31) * 64;
          na_ = *(const f32x4*)(bA + o_); nw_ = *(const f32x4*)(bW + o_); nk_ = *(const f32x4*)(bK + o_); nb_ = *(const f32x4*)(bB + o_); nr_ = *(const f32x4*)(bR + o_);
          nv = V[((t + 1) & 31) * 16 + row];
        }
        float ro_ = opend;
        ra_ += DPP(ra_, 0xB1); ro_ += DPP(ro_, 0xB1);
        ra_ += DPP(ra_, 0x4E); ro_ += DPP(ro_, 0x4E);
        ra_ += DPP(ra_, 0x141); ro_ += DPP(ro_, 0x141);
        ra_ += DPP(ra_, 0x140); ro_ += DPP(ro_, 0x140);
        O[row * 33 + ((t - 1) & 31)] = ro_;
        const f32x2 sa2 = {ra_, ra_}, xv2 = {xv, xv};
        const f32x2 xk01 = {xk[0], xk[1]}, xk23 = {xk[2], xk[3]}, xb01 = {xb[0], xb[1]}, xb23 = {xb[2], xb[3]};
        const f32x2 xw01 = {xw[0], xw[1]}, xw23 = {xw[2], xw[3]}, xr01 = {xr[0], xr[1]}, xr23 = {xr[2], xr[3]};
        S01 = __builtin_elementwise_fma(S01, xw01, __builtin_elementwise_fma(sa2, xb01, xv2 * xk01));
        S23 = __builtin_elementwise_fma(S23, xw23, __builtin_elementwise_fma(sa2, xb23, xv2 * xk23));
        f32x2 po = S01 * xr01; po = __builtin_elementwise_fma(S23, xr23, po);
        opend = po[0] + po[1];
        xa = na_; xw = nw_; xk = nk_; xb = nb_; xr = nr_; xv = nv;
      }
      { const float ro_ = sum16(opend); O[row * 33 + 31] = ro_; }
    }
    __syncthreads();
  }
  {
    const size_t mp = tok0 + (TSEQ - 32);
    const float o0 = O[(c8 * 2) * 33 + tl], o1 = O[(c8 * 2 + 1) * 33 + tl];
    *(unsigned*)(p.ubuf + (mp + tl) * DM + vc0 + c8 * 2) = cvtpk(o0, o1);
  }
  __syncthreads();
}

__device__ __forceinline__ void postscan_phase(const P& p, const int layer) {
  const int tid = threadIdx.x, head = tid >> 3, ch = tid * 8;
  const bf16_t* vsrc = p.vA + (size_t)layer * (64u << 20);
  float lg[8], lb[8];
  {
    const float* pg = p.a_ln_g + layer * DM + ch; const float* pb = p.a_ln_b + layer * DM + ch;
#pragma unroll
    for (int e = 0; e < 8; ++e) { lg[e] = pg[e]; lb[e] = pb[e]; }
  }
  const bool aff = gridDim.x == 512;
  const int mstride = aff ? 64 : (int)gridDim.x;
  const int mbeg = aff ? ((int)blockIdx.x & 7) * 2048 + ((int)blockIdx.x >> 3) : (int)blockIdx.x;
  const int mend = aff ? ((int)blockIdx.x & 7) * 2048 + 2048 : MTOK;
  for (int m0 = mbeg; m0 < mend; m0 += 4 * mstride) {
    bf16x8 ro[4], rv[4], rz[4]; float bn[4];
#pragma unroll
    for (int u = 0; u < 4; ++u) {
      const int m = m0 + u * mstride;
      if (m < mend) {
        ro[u] = *(const bf16x8*)(p.ubuf + (size_t)m * DM + ch);
        rv[u] = *(const bf16x8*)(vsrc + (size_t)m * DM + ch);
        rz[u] = *(const bf16x8*)(p.z + (size_t)m * DM + ch);
        bn[u] = p.bon[(size_t)m * 32 + head];
      }
    }
#pragma unroll
    for (int u = 0; u < 4; ++u) {
      const int m = m0 + u * mstride;
      if (m < MTOK) {
        float fo[8], fv[8], fz[8];
        unpack8(ro[u], fo); unpack8(rv[u], fv); unpack8(rz[u], fz);
        float sm = 0.f;
#pragma unroll
        for (int e = 0; e < 8; ++e) sm += fo[e];
        const float mean = sum8(sm) * (1.f / 64.f);
        float sv = 0.f;
#pragma unroll
        for (int e = 0; e < 8; ++e) { fo[e] -= mean; sv += fo[e] * fo[e]; }
        const float rstd = rsqrtf(sum8(sv) * (1.f / 64.f) + 64e-5f);
#pragma unroll
        for (int e = 0; e < 8; ++e) fo[e] = (fo[e] * rstd * lg[e] + lb[e] + bn[u] * fv[e]) * siluf_(fz[e]);
        *(bf16x8*)(p.ubuf + (size_t)m * DM + ch) = pack8f(fo);
      }
    }
  }
}

__device__ __forceinline__ void cmp_item(const P& p, const int item, char* lds) {
  const int qb = (item & 512) ? 63 - (item & 63) : (item & 63), g = (item >> 6) & 3, b = item >> 8;
  const int bg = b * 4 + g;
  const int tid = threadIdx.x, lane = tid & 63, w = tid >> 6;
  const int n = lane & 31, hi = lane >> 5;
  float* impM = (float*)lds;
  float* impS = impM + 64 * 68;
  for (int e = lane; e < 16 * 68; e += 64) { impM[w * 16 * 68 + e] = 0.f; impS[w * 16 * 68 + e] = 0.f; }
  const int ql = 16 * w + (n & 15);
  const int tq = qb * 64 + ql;
  const size_t m = (size_t)b * TSEQ + tq;
  const int cmaxq = (tq - 31) >> 4;
  const int nkt = (4 * qb + 3 + 31) >> 5;
  const bf16_t* Kc = p.kcmp + (size_t)bg * 256 * 128;
  const bf16_t* Vc = p.vcmpT + (size_t)bg * 128 * 256;
  const float NEG = -__builtin_inff();
#pragma unroll 1
  for (int ct = 0; ct < 2; ++ct) {
    const int head = g * 4 + 2 * ct + (n >> 4);
    bf16x8 qf[8];
#pragma unroll
    for (int d0 = 0; d0 < 8; ++d0) qf[d0] = *(const bf16x8*)(p.q + m * DM + head * 128 + d0 * 16 + hi * 8);
    float mx = -1e30f, l = 0.f;
#pragma unroll 1
    for (int kt = 0; kt < nkt; ++kt) {
      f32x16 sc; for (int r = 0; r < 16; ++r) sc[r] = 0.f;
#pragma unroll
      for (int d0 = 0; d0 < 8; ++d0) {
        bf16x8 kf = *(const bf16x8*)(Kc + (size_t)(kt * 32 + n) * 128 + d0 * 16 + hi * 8);
        sc = __builtin_amdgcn_mfma_f32_32x32x16_bf16(kf, qf[d0], sc, 0, 0, 0);
      }
      float tm = NEG;
#pragma unroll
      for (int r = 0; r < 16; ++r) { const int cc = kt * 32 + crow(r, hi); if (cc > cmaxq) sc[r] = NEG; tm = fmaxf(tm, sc[r]); }
      tm = swap32_max(tm);
      const float mn = fmaxf(mx, tm);
      float ps = 0.f;
#pragma unroll
      for (int r = 0; r < 16; ++r) ps += __builtin_amdgcn_exp2f(sc[r] - mn);
      ps = swap32_sum(ps);
      l = l * __builtin_amdgcn_exp2f(mx - mn) + ps; mx = mn;
    }
    const float inv_l = l > 0.f ? 1.f / l : 0.f;
    f32x16 o[4];
#pragma unroll
    for (int dt = 0; dt < 4; ++dt) for (int r = 0; r < 16; ++r) o[dt][r] = 0.f;
#pragma unroll 1
    for (int kt = 0; kt < nkt; ++kt) {
      f32x16 sc; for (int r = 0; r < 16; ++r) sc[r] = 0.f;
#pragma unroll
      for (int d0 = 0; d0 < 8; ++d0) {
        bf16x8 kf = *(const bf16x8*)(Kc + (size_t)(kt * 32 + n) * 128 + d0 * 16 + hi * 8);
        sc = __builtin_amdgcn_mfma_f32_32x32x16_bf16(kf, qf[d0], sc, 0, 0, 0);
      }
      float pr[16];
#pragma unroll
      for (int r = 0; r < 16; ++r) { const int cc = kt * 32 + crow(r, hi); pr[r] = (cc > cmaxq) ? 0.f : __builtin_amdgcn_exp2f(sc[r] - mx) * inv_l; }
#pragma unroll
      for (int a = 0; a < 4; ++a) {
        float mainv = pr[4 * a] + pr[4 * a + 1] + pr[4 * a + 2] + 0.5f * pr[4 * a + 3];
        float spill = 0.5f * pr[4 * a + 3];
        mainv += __shfl_xor(mainv, 16); spill += __shfl_xor(spill, 16);
        if ((n & 16) == 0) {
          const int jj = 8 * kt + 2 * a + hi;
          impM[ql * 68 + jj] += mainv; impS[ql * 68 + jj + 1] += spill;
        }
      }
      const float pf0[8] = {pr[0], pr[1], pr[2], pr[3], pr[4], pr[5], pr[6], pr[7]};
      const float pf1[8] = {pr[8], pr[9], pr[10], pr[11], pr[12], pr[13], pr[14], pr[15]};
      const bf16x8 pb0 = pack8f(pf0), pb1 = pack8f(pf1);
#pragma unroll
      for (int dt = 0; dt < 4; ++dt) {
        const bf16_t* vp = Vc + (size_t)(dt * 32 + n) * 256 + kt * 32 + hi * 8;
        bf16x8 v0 = *(const bf16x8*)vp, v1 = *(const bf16x8*)(vp + 16);
        o[dt] = __builtin_amdgcn_mfma_f32_32x32x16_bf16(v0, pb0, o[dt], 0, 0, 0);
        o[dt] = __builtin_amdgcn_mfma_f32_32x32x16_bf16(v1, pb1, o[dt], 0, 0, 0);
      }
    }
    const float gt = p.gates[m * 48 + head * 3 + 0];
#pragma unroll
    for (int dt = 0; dt < 4; ++dt)
#pragma unroll
      for (int a = 0; a < 4; ++a) {
        u32x2 wv = {cvtpk(o[dt][4 * a] * gt, o[dt][4 * a + 1] * gt), cvtpk(o[dt][4 * a + 2] * gt, o[dt][4 * a + 3] * gt)};
        *(u32x2*)(p.ocmp + m * DM + head * 128 + dt * 32 + 8 * a + 4 * hi) = wv;
      }
  }
  __syncthreads();
  {
    const int qq = 16 * w + (lane >> 2), part = lane & 3;
    const int cur = qb;
    unsigned lo, hi32;
    if (cur < 16) { lo = (2u << cur) - 1u; hi32 = 0u; }
    else {
      float* rowp = impM + qq * 68; const float* rows = impS + qq * 68;
      for (int e = 0; e < 16; ++e) { const int j = part * 16 + e; rowp[j] = rowp[j] + rows[j]; }
      __builtin_amdgcn_fence(__ATOMIC_RELEASE, "wavefront");
      __builtin_amdgcn_wave_barrier();
      float vj[16]; int rank[16];
#pragma unroll
      for (int e = 0; e < 16; ++e) { vj[e] = rowp[part * 16 + e]; rank[e] = 0; }
      for (int j2 = 1; j2 <= cur - 2; ++j2) {
        const float v2 = rowp[j2];
#pragma unroll
        for (int e = 0; e < 16; ++e) { const int j = part * 16 + e; rank[e] += (v2 > vj[e] || (v2 == vj[e] && j2 < j)) ? 1 : 0; }
      }
      unsigned bits = 0;
#pragma unroll
      for (int e = 0; e < 16; ++e) { const int j = part * 16 + e; if (j >= 1 && j <= cur - 2 && rank[e] < 13) bits |= 1u << e; }
      const int base = lane & ~3;
      const unsigned b0 = __shfl(bits, base), b1 = __shfl(bits, base + 1), b2 = __shfl(bits, base + 2), b3 = __shfl(bits, base + 3);
      lo = b0 | (b1 << 16); hi32 = b2 | (b3 << 16);
      lo |= 1u;
      { const int j = cur - 1; if (j < 32) lo |= 1u << j; else hi32 |= 1u << (j - 32); }
      { const int j = cur; if (j < 32) lo |= 1u << j; else hi32 |= 1u << (j - 32); }
    }
    if (part == 0) {
      unsigned* sp = p.selmask + ((size_t)bg * TSEQ + qb * 64 + qq) * 2;
      sp[0] = lo; sp[1] = hi32;
    }
  }
  __syncthreads();
}

template <int BR>
__device__ __forceinline__ void attn_pass(const P& p, const int b, const int g, const int qb, const int head, const int tq, const bf16x8* qf,
                                          unsigned long long tiles, const unsigned long long mysel, char* lds) {
  const int tid = threadIdx.x, lane = tid & 63;
  const int kl = lane & 31, hi = lane >> 5;
  const int bg = b * 4 + g;
  const bf16_t* Kg = (BR == 0 ? p.kw : p.ks) + (size_t)bg * TSEQ * 128;
  const bf16_t* Vg = (BR == 0 ? p.vwT : p.vsT) + (size_t)bg * 128 * TSEQ;
  const unsigned Wlim = BR == 0 ? 512u : 0x80000000u;
  const float NEG = -__builtin_inff();
  f32x16 o[4];
#pragma unroll
  for (int dt = 0; dt < 4; ++dt) for (int r = 0; r < 16; ++r) o[dt][r] = 0.f;
  float mx = -1e30f, l = 0.f;
  bf16x8 sk[4], sv[4];
  auto load_tile = [&](int j) {
#pragma unroll
    for (int i = 0; i < 4; ++i) {
      const int id = tid + 256 * i;
      sk[i] = *(const bf16x8*)(Kg + (size_t)(j * 64 + (id >> 4)) * 128 + (id & 15) * 8);
      sv[i] = *(const bf16x8*)(Vg + (size_t)(id >> 3) * TSEQ + j * 64 + (id & 7) * 8);
    }
  };
  auto store_tile = [&](int buf) {
    char* Kb = lds + buf * ATT_BUF; char* Vb = Kb + ATT_KSZ;
#pragma unroll
    for (int i = 0; i < 4; ++i) {
      const int id = tid + 256 * i;
      { const int row = id >> 4, c16 = id & 15; *(bf16x8*)(Kb + row * 272 + (c16 << 4)) = sk[i]; }
      { const int d = id >> 3, cx = id & 7; *(bf16x8*)(Vb + d * 144 + (cx << 4)) = sv[i]; }
    }
  };
  int j = __builtin_ctzll(tiles); tiles &= tiles - 1;
  load_tile(j);
  store_tile(0);
  __syncthreads();
  int buf = 0;
  while (true) {
    const bool more = tiles != 0ull;
    int jn = 0;
    if (more) { jn = __builtin_ctzll(tiles); tiles &= tiles - 1; load_tile(jn); }
    {
      const char* Kb = lds + buf * ATT_BUF + kl * 272 + hi * 16; const char* Vb = lds + buf * ATT_BUF + ATT_KSZ + kl * 144 + hi * 16;
      const bool lane_ok = BR == 0 ? true : ((mysel >> j) & 1ull) != 0ull;
      const bool wave_any = __any(lane_ok);
      const bool boundary = BR == 0 ? (j == qb || j + 8 == qb) : (j == qb);
      if (wave_any) {
#pragma unroll
        for (int hs = 0; hs < 2; ++hs) {
          f32x16 sc; for (int r = 0; r < 16; ++r) sc[r] = 0.f;
#pragma unroll
          for (int d0 = 0; d0 < 8; ++d0) {
            bf16x8 kf = *(const bf16x8*)(Kb + hs * 32 * 272 + d0 * 32);
            sc = __builtin_amdgcn_mfma_f32_32x32x16_bf16(kf, qf[d0], sc, 0, 0, 0);
          }
          if (boundary) {
            const int dq = tq - (j * 64 + hs * 32 + 4 * hi);
#pragma unroll
            for (int r = 0; r < 16; ++r) { const int cidx = (r & 3) + 8 * (r >> 2); if ((unsigned)(dq - cidx) >= Wlim) sc[r] = NEG; }
          }
          if (BR == 1) {
#pragma unroll
            for (int r = 0; r < 16; ++r) sc[r] = lane_ok ? sc[r] : NEG;
          }
          float tm = sc[0];
#pragma unroll
          for (int r = 1; r < 16; ++r) tm = fmaxf(tm, sc[r]);
          tm = swap32_max(tm);
          if (!__all(tm <= mx + 8.f)) {
            const float mn = fmaxf(mx, tm);
            const float alpha = __builtin_amdgcn_exp2f(mx - mn);
            l *= alpha; mx = mn;
#pragma unroll
            for (int dt = 0; dt < 4; ++dt)
#pragma unroll
              for (int r = 0; r < 16; ++r) o[dt][r] *= alpha;
          }
          float pr[16]; float ps = 0.f;
#pragma unroll
          for (int r = 0; r < 16; ++r) { pr[r] = __builtin_amdgcn_exp2f(sc[r] - mx); ps += pr[r]; }
          ps = swap32_sum(ps);
          l += ps;
          const float pf0[8] = {pr[0], pr[1], pr[2], pr[3], pr[4], pr[5], pr[6], pr[7]};
          const float pf1[8] = {pr[8], pr[9], pr[10], pr[11], pr[12], pr[13], pr[14], pr[15]};
          const bf16x8 pb0 = pack8f(pf0), pb1 = pack8f(pf1);
#pragma unroll
          for (int dt = 0; dt < 4; ++dt) {
            bf16x8 v0 = *(const bf16x8*)(Vb + dt * 32 * 144 + hs * 64);
            bf16x8 v1 = *(const bf16x8*)(Vb + dt * 32 * 144 + hs * 64 + 32);
            o[dt] = __builtin_amdgcn_mfma_f32_32x32x16_bf16(v0, pb0, o[dt], 0, 0, 0);
            o[dt] = __builtin_amdgcn_mfma_f32_32x32x16_bf16(v1, pb1, o[dt], 0, 0, 0);
          }
        }
      }
    }
    if (more) store_tile(buf ^ 1);
    __syncthreads();
    if (!more) break;
    j = jn; buf ^= 1;
  }
  const size_t m = (size_t)b * TSEQ + tq;
  const float gt = p.gates[m * 48 + head * 3 + (BR == 0 ? 2 : 1)];
  const float sc_ = gt / l;
  if (BR == 0) {
#pragma unroll
    for (int dt = 0; dt < 4; ++dt)
#pragma unroll
      for (int a = 0; a < 4; ++a) {
        const size_t idx = m * DM + head * 128 + dt * 32 + 8 * a + 4 * hi;
        *(u32x2*)(p.ubuf + idx) = u32x2{cvtpk(o[dt][4 * a] * sc_, o[dt][4 * a + 1] * sc_), cvtpk(o[dt][4 * a + 2] * sc_, o[dt][4 * a + 3] * sc_)};
      }
  } else {
#pragma unroll
    for (int dt = 0; dt < 4; ++dt)
#pragma unroll
      for (int a = 0; a < 4; ++a) {
        const size_t idx = m * DM + head * 128 + dt * 32 + 8 * a + 4 * hi;
        const u32x2 oc = *(const u32x2*)(p.ocmp + idx);
        const u32x2 zz = *(const u32x2*)(p.sz + idx);
        const u32x2 ww = *(const u32x2*)(p.ubuf + idx);
        const float y0 = (o[dt][4 * a] * sc_ + bflo(ww[0]) + bflo(oc[0])) * bflo(zz[0]);
        const float y1 = (o[dt][4 * a + 1] * sc_ + bfhi(ww[0]) + bfhi(oc[0])) * bfhi(zz[0]);
        const float y2 = (o[dt][4 * a + 2] * sc_ + bflo(ww[1]) + bflo(oc[1])) * bflo(zz[1]);
        const float y3 = (o[dt][4 * a + 3] * sc_ + bfhi(ww[1]) + bfhi(oc[1])) * bfhi(zz[1]);
        *(u32x2*)(p.ubuf + idx) = u32x2{cvtpk(y0, y1), cvtpk(y2, y3)};
      }
  }
}

__device__ __forceinline__ void attn_item(const P& p, const int item, char* lds, unsigned long long* uni) {
  const int half = item & 1, g = (item >> 1) & 3, b = (item >> 3) & 3, qb = 63 - (item >> 5);
  const int tid = threadIdx.x, lane = tid & 63, w = tid >> 6;
  const int kl = lane & 31, hi = lane >> 5;
  const int head = g * 4 + half * 2 + (w >> 1);
  const int tq = qb * 64 + (w & 1) * 32 + kl;
  const size_t m = (size_t)b * TSEQ + tq;
  bf16x8 qf[8];
#pragma unroll
  for (int d0 = 0; d0 < 8; ++d0) qf[d0] = *(const bf16x8*)(p.q + m * DM + head * 128 + d0 * 16 + hi * 8);
  const unsigned* sp = p.selmask + ((size_t)(b * 4 + g) * TSEQ + tq) * 2;
  const unsigned long long mysel = (unsigned long long)sp[0] | ((unsigned long long)sp[1] << 32);
  unsigned long long u = mysel;
#pragma unroll
  for (int o = 16; o >= 1; o >>= 1) { u |= (unsigned long long)__shfl_xor((unsigned)u, o) | ((unsigned long long)__shfl_xor((unsigned)(u >> 32), o) << 32); }
  if (lane == 0) uni[w] = u;
  __syncthreads();
  const unsigned long long U = (uni[0] | uni[1] | uni[2] | uni[3]) & (qb == 63 ? ~0ull : ((2ull << qb) - 1ull));
  const int jlo = qb >= 8 ? qb - 8 : 0;
  const unsigned long long wt = (qb == 63 ? ~0ull : ((2ull << qb) - 1ull)) & ~((1ull << jlo) - 1ull);
  attn_pass<0>(p, b, g, qb, head, tq, qf, wt, mysel, lds);
  attn_pass<1>(p, b, g, qb, head, tq, qf, U, mysel, lds);
}

typedef __attribute__((address_space(1))) unsigned gunsigned;
__device__ __forceinline__ unsigned gb_ld(unsigned* p) { return __hip_atomic_load((gunsigned*)p, __ATOMIC_RELAXED, __HIP_MEMORY_SCOPE_AGENT); }
__device__ __forceinline__ unsigned gb_add(unsigned* p, unsigned v) { return __hip_atomic_fetch_add((gunsigned*)p, v, __ATOMIC_RELAXED, __HIP_MEMORY_SCOPE_AGENT); }
__device__ __forceinline__ void grid_barrier(unsigned* bar, const unsigned e) {
  __builtin_amdgcn_fence(__ATOMIC_RELEASE, "workgroup");
  __builtin_amdgcn_s_waitcnt(0);
  __syncthreads();
  if (threadIdx.x == 0) {
    const unsigned G = gridDim.x, g = blockIdx.x & 7u;
    const unsigned ngrp = G < 8u ? G : 8u, nloc = (G + 7u - g) >> 3;
    __builtin_amdgcn_fence(__ATOMIC_RELEASE, "agent");
    __builtin_amdgcn_s_waitcnt(0);
    const unsigned old = gb_add(&bar[64u * (1u + g)], 1u);
    if (old + 1u == (e + 1u) * nloc) {
      const unsigned og = gb_add(&bar[0], 1u);
      if (og + 1u == (e + 1u) * ngrp) gb_add(&bar[64u * 20u], 1u);
      else { unsigned sp = 0; while (gb_ld(&bar[64u * 20u]) <= e && ++sp < (1u << 24)) __builtin_amdgcn_s_sleep(1); }
      gb_add(&bar[64u * (10u + g)], 1u);
    } else {
      unsigned sp = 0; while (gb_ld(&bar[64u * (10u + g)]) <= e && ++sp < (1u << 24)) __builtin_amdgcn_s_sleep(1);
    }
    __builtin_amdgcn_fence(__ATOMIC_ACQUIRE, "agent");
    __builtin_amdgcn_s_waitcnt(0);
  }
  __syncthreads();
}

#define NPHASE 23
#ifndef GRP
#define GRP 0xFFFF
#endif
#define EN(b) ((GRP >> (b)) & 1)
#ifndef DUPMASK
#define DUPMASK 0
#endif
#define PHASE(n, en, ...) if (ph_lo <= (n) && (n) < ph_hi) { if (EN(en)) { __VA_ARGS__ if ((DUPMASK >> (n)) & 1) { __syncthreads(); __VA_ARGS__ } } if ((n) + 1 < ph_hi) { if ((n) == 0) cg::this_grid().sync(); else grid_barrier(bar, (unsigned)((n) - 1)); } }

__device__ __forceinline__ bool deal_tile(int r, int NT, int& mt, int& nt) {
  const int G = gridDim.x, bid = blockIdx.x;
  if (G == 512) {
    const int x = bid & 7, lb = bid >> 3;
    const int NG = NT >> 3, rem = NT & 7;
    if (r < 2 * NG) { mt = 16 * x + (r & 1) * 8 + (lb >> 3); nt = (r >> 1) * 8 + (lb & 7); return true; }
    const int idx = (r - 2 * NG) * 64 + lb;
    if (idx < 16 * rem) { mt = 16 * x + idx / rem; nt = NG * 8 + idx % rem; return true; }
    return false;
  }
  const int t = bid + r * G;
  if (t < 128 * NT) { mt = t / NT; nt = t % NT; return true; }
  return false;
}
__device__ __forceinline__ int deal_rounds(int NT) {
  const int G = gridDim.x;
  if (G == 512) return 2 * (NT >> 3) + (16 * (NT & 7) + 63) / 64;
  return (128 * NT + G - 1) / G;
}
__device__ __forceinline__ void ph_proj(const P& p, int layer, char* lds) {
  {
    const int nr = deal_rounds(32);
    for (int r = 0; r < nr; ++r) {
      int mt, nt2;
      if (!deal_tile(r, 32, mt, nt2)) continue;
      GemmCtx cw; cw.A = p.ubuf; cw.lda = DM; cw.K = DM; cw.layer = layer; cw.j = 0; cw.Bt = p.Wp;
      cw.aux = p.a_mu + (size_t)(layer * 6 + (nt2 >> 3)) * DM;
      gemm_wide<AL_MIX, EP_PROJ>(p, cw, mt, nt2, lds);
    }
  }
  const int NL = layer == 0 ? 2 : 3;
  GemmCtx c; c.A = p.ubuf; c.lda = DM; c.K = DM; c.layer = layer; c.j = 0; c.Bt = p.Wp;
  const int nr = deal_rounds(NL);
  for (int r = 0; r < nr; ++r) {
    int mt, ntl;
    if (!deal_tile(r, NL, mt, ntl)) continue;
    const int nt = 64 + ntl;
    const int mui = nt == 64 ? 4 : nt == 65 ? 5 : 2;
    c.aux = p.a_mu + (size_t)(layer * 6 + mui) * DM;
    gemm_tile<AL_MIX, EP_PROJ>(p, c, mt, nt, lds);
  }
}
__device__ __forceinline__ void ph_wo(const P& p, int layer, const bf16_t* Wt, char* lds) {
  GemmCtx c; c.A = p.ubuf; c.lda = DM; c.Bt = Wt; c.K = DM; c.layer = layer; c.j = 0; c.aux = nullptr;
  const int nr = deal_rounds(8);
  for (int r = 0; r < nr; ++r) {
    int mt, nt2;
    if (!deal_tile(r, 8, mt, nt2)) continue;
    gemm_wide<AL_PLAIN, EP_RESID>(p, c, mt, nt2, lds);
  }
}
__device__ __forceinline__ void ph_kvwin(const P& p, int jl, int NTK, char* lds) {
  const int NK2 = NTK >> 1, NT2 = NK2 + 16;
  {
    const int nr = deal_rounds(NT2);
    for (int r = 0; r < nr; ++r) {
      int mt, nt2;
      if (!deal_tile(r, NT2, mt, nt2)) continue;
      GemmCtx c; c.lda = DM; c.K = DM; c.layer = 1; c.j = jl; c.aux = nullptr;
      if (nt2 < NK2) { c.A = p.hn; c.Bt = p.Wkv; gemm_wide<AL_PLAIN, EP_KV>(p, c, mt, nt2, lds); }
      else { c.A = p.ubuf; c.Bt = p.Win; gemm_wide<AL_PLAIN, EP_WIN>(p, c, mt, nt2 - NK2, lds); }
    }
  }
  if (jl != 0) {
    GemmCtx c; c.lda = DM; c.K = DM; c.layer = 1; c.j = jl; c.aux = nullptr; c.A = p.ubuf; c.Bt = p.Win;
    const int nr = deal_rounds(1);
    for (int r = 0; r < nr; ++r) {
      int mt, ntl;
      if (!deal_tile(r, 1, mt, ntl)) continue;
      gemm_tile<AL_PLAIN, EP_WIN>(p, c, mt, 32, lds);
    }
  }
}
__device__ __forceinline__ void ph_attn(const P& p, char* lds, unsigned long long* uni) {
  const int G = gridDim.x, bid = blockIdx.x;
  const bool xcd = G == 512;
  const int x = bid & 7, lb = bid >> 3, a = lb >> 1, half = lb & 1;
  int rnd = 0;
  for (int base = 0; base < 2048; base += G, ++rnd) {
    int idx;
    if (xcd) {
      const int bg = x * 2 + (rnd >> 1), b = bg >> 2, g = bg & 3;
      const int qb = (rnd & 1) ? a : 63 - a;
      idx = ((63 - qb) << 5) | (b << 3) | (g << 1) | half;
    } else idx = base + ((rnd & 1) ? (G - 1 - bid) : bid);
    if (idx < 2048) attn_item(p, idx, lds, uni);
    __syncthreads();
  }
}

__global__ void __launch_bounds__(NTHREADS, 2) fwd_kernel(const P p, const PJ pj, unsigned* bar, const int ph_lo, const int ph_hi) {
  __shared__ __attribute__((aligned(16))) char lds[LDS_BYTES];
  __shared__ unsigned long long uni[4];
  const int G = gridDim.x, bid = blockIdx.x;
  if (bid == 0 && ph_lo == 0) { for (int i = threadIdx.x; i < 64 * 32; i += NTHREADS) bar[i] = 0u; }
  PHASE(0, 0, norm_phase<0, 0>(p, pj, false, p.a_norm_g, p.ubuf, nullptr, nullptr, nullptr, lds);)
  PHASE(1, 1, ph_proj(p, 0, lds);)
  PHASE(2, 2, for (int it = bid; it < 512; it += G) scan_item(p, 0, G == 512 ? ((((it & 7) * 16 + (it >> 5)) << 2) | ((it >> 3) & 3)) : it, lds);)
  PHASE(3, 3, postscan_phase(p, 0);)
  PHASE(4, 4, ph_wo(p, 0, p.Wo, lds);)
  PHASE(5, 0, norm_phase<0, 1>(p, pj, true, p.a_norm_g + DM, p.ubuf, nullptr, nullptr, nullptr, lds);)
  PHASE(6, 1, ph_proj(p, 1, lds);)
  PHASE(7, 2, for (int it = bid; it < 512; it += G) scan_item(p, 1, G == 512 ? ((((it & 7) * 16 + (it >> 5)) << 2) | ((it >> 3) & 3)) : it, lds);)
  PHASE(8, 3, postscan_phase(p, 1);)
  PHASE(9, 4, ph_wo(p, 1, p.Wo, lds);)
  PHASE(10, 0, norm_phase<1, 2>(p, pj, true, p.kv_norm_g, p.hn, p.b_norm_g, p.ubuf, nullptr, lds);)
  PHASE(11, 5, ph_kvwin(p, 0, 24, lds);)
  PHASE(12, 6,
    for (int t = bid; t < 256; t += G) {
      if (t >= 128) {
        GemmCtx cg; cg.lda = DM; cg.K = DM; cg.layer = 1; cg.j = 0; cg.aux = nullptr; cg.A = p.ubuf; cg.Bt = p.Win;
        gemm_tile<AL_PLAIN, EP_WIN>(p, cg, t - 128, 32, lds);
        continue;
      }
      const int j = t >> 6, r = t & 63, mt = r >> 1, nt = r & 1;
      GemmCtx c; c.A = p.kc + (size_t)j * (8u << 20); c.lda = 0; c.Bt = p.Wc1 + (size_t)j * 256 * 4096; c.K = 4096; c.layer = 0; c.j = j;
      c.aux = p.cmp_pe + (size_t)j * 32 * 128;
      gemm_tile<AL_CMP, EP_CMP1>(p, c, mt, nt, lds);
    })
  PHASE(13, 7,
    for (int t = bid; t < 64; t += G) {
      const int j = t >> 5, mt = t & 31;
      GemmCtx c; c.A = p.hc + (size_t)j * 4096 * 256; c.lda = 256; c.Bt = p.Wc2 + (size_t)j * 128 * 256; c.K = 256; c.layer = 0; c.j = j; c.aux = nullptr;
      gemm_tile<AL_PLAIN, EP_CMP2>(p, c, mt, 0, lds);
    })
  PHASE(14, 8, for (int t = bid; t < 1024; t += G) cmp_item(p, t, lds);)
  PHASE(15, 9, ph_attn(p, lds, uni);)
  PHASE(16, 4, ph_wo(p, 1, p.Wob, lds);)
  PHASE(17, 0, norm_phase<0, 3>(p, pj, true, p.b_norm_g + DM, p.ubuf, nullptr, nullptr, nullptr, lds);)
  PHASE(18, 5, ph_kvwin(p, 1, 0, lds);)
  PHASE(19, 8, for (int t = bid; t < 1024; t += G) cmp_item(p, t, lds);)
  PHASE(20, 9, ph_attn(p, lds, uni);)
  PHASE(21, 4, ph_wo(p, 1, p.Wob, lds);)
  PHASE(22, 0, norm_phase<2, -1>(p, pj, true, p.final_g, nullptr, nullptr, nullptr, p.out, lds);)
}

static inline size_t MiB(double x) { return (size_t)(x * 1048576.0); }

extern "C" void kernel_launch(void* const* d_in, const int* in_sizes, int n_in, void* d_out, int out_size, void* d_ws, size_t ws_size, hipStream_t stream) {
  (void)in_sizes; (void)n_in; (void)out_size;
  P p; memset(&p, 0, sizeof(P));
  PJ pj; memset(&pj, 0, sizeof(PJ));
  const float* const* in = (const float* const*)d_in;
  p.x = in[0]; p.a_norm_g = in[1]; p.a_mu = in[2];
  const float* a_w_rkvz = in[3];
  p.a_w0 = in[4]; const float* a_w1 = in[5]; const float* a_w2 = in[6];
  p.a_a0 = in[7]; const float* a_a1 = in[8]; const float* a_a2 = in[9];
  p.a_v0 = in[10]; const float* a_v1 = in[11]; const float* a_v2 = in[12];
  p.a_k_k = in[13]; p.a_k_a = in[14]; p.a_r_k = in[15]; p.a_ln_g = in[16]; p.a_ln_b = in[17];
  const float* a_w_o = in[18];
  p.kv_norm_g = in[19]; const float* kv_w = in[20]; p.cmp_pe = in[21]; const float* cmp_w1 = in[22]; const float* cmp_w2 = in[23];
  p.b_norm_g = in[24]; const float* b_w_in = in[25]; p.b_gate_b = in[26]; const float* b_w_o = in[27]; p.final_g = in[28];
  p.out = (float*)d_out;
  if (ws_size < MiB(512)) { fprintf(stderr, "workspace too small: %zu\n", ws_size); return; }
  char* ws = (char*)d_ws;
  p.ysum = (bf16_t*)(ws + MiB(0)); p.ubuf = (bf16_t*)(ws + MiB(64)); p.r = (bf16_t*)(ws + MiB(128)); p.k = (bf16_t*)(ws + MiB(192));
  p.vA = (bf16_t*)(ws + MiB(256)); p.z = (bf16_t*)(ws + MiB(320)); p.vB = (bf16_t*)(ws + MiB(384));
  p.hn = (bf16_t*)(ws + MiB(128)); p.ocmp = p.hn; p.q = (bf16_t*)(ws + MiB(192)); p.sz = (bf16_t*)(ws + MiB(256));
  p.kc = (bf16_t*)(ws + MiB(320)); p.vc = (bf16_t*)(ws + MiB(336)); p.ks = (bf16_t*)(ws + MiB(352)); p.vsT = (bf16_t*)(ws + MiB(368));
  p.kw = (bf16_t*)(ws + MiB(384)); p.vwT = (bf16_t*)(ws + MiB(400));
  p.hc = (bf16_t*)(ws + MiB(416)); p.kcmp = (bf16_t*)(ws + MiB(420)); p.vcmpT = (bf16_t*)(ws + MiB(421));
  p.gates = (float*)(ws + MiB(422)); p.selmask = (unsigned*)(ws + MiB(425));
  char* ar = ws + MiB(448);
  p.Wp = (bf16_t*)ar;
  p.W2w = (bf16_t*)(ar + MiB(33.5)); p.W2a = (bf16_t*)(ar + MiB(34)); p.W2v = (bf16_t*)(ar + MiB(34.5));
  p.Wo = (bf16_t*)(ar + MiB(35));
  p.Wkv = (bf16_t*)ar;
  p.Win = (bf16_t*)(ar + MiB(12));
  p.Wc1 = (bf16_t*)(ar + MiB(28.5));
  p.Wc2 = (bf16_t*)(ar + MiB(32.5));
  p.Wob = (bf16_t*)(ar + MiB(33));
  p.lw = (bf16_t*)(ws + MiB(492)); p.la = (bf16_t*)(ws + MiB(496)); p.lv = (bf16_t*)(ws + MiB(500));
  unsigned* bar = (unsigned*)(ws + MiB(508));
  p.bon = (float*)(ws + MiB(504)); p.ropec = (float*)(ws + MiB(506)); p.ropes = (float*)(ws + MiB(506.5));

  int nj = 0, tile = 0;
  auto add = [&](const float* src, bf16_t* dst, int K, int N, int ld, int Kpad, int Npad) {
    ConvJob& j = pj.jobs[nj++]; j.src = src; j.dst = dst; j.K = K; j.N = N; j.ld = ld; j.Kpad = Kpad; j.Npad = Npad; j.tile0 = tile;
    tile += (Kpad / 64) * (Npad / 64);
  };
  const size_t DD = (size_t)DM * DM;
  for (int L = 0; L < 2; ++L) {
    tile = 0;
    for (int n4 = 0; n4 < 4; ++n4) add(a_w_rkvz + (size_t)(L * 4 + n4) * DD, p.Wp + (size_t)n4 * DD, DM, DM, DM, DM, DM);
    add(a_w1 + (size_t)L * DM * 96, p.Wp + (size_t)8192 * DM, DM, 96, 96, DM, 128);
    add(a_a1 + (size_t)L * DM * 96, p.Wp + (size_t)8320 * DM, DM, 96, 96, DM, 128);
    if (L == 1) add(a_v1, p.Wp + (size_t)8448 * DM, DM, 64, 64, DM, 128);
    add(a_w2 + (size_t)L * 96 * DM, p.W2w, 96, DM, DM, 128, DM);
    add(a_a2 + (size_t)L * 96 * DM, p.W2a, 96, DM, DM, 128, DM);
    if (L == 1) add(a_v2, p.W2v, 64, DM, DM, 128, DM);
    add(a_w_o + (size_t)L * DD, p.Wo, DM, DM, DM, DM, DM);
    pj.stage_tiles[L] = tile;
  }
  tile = 0;
  add(kv_w, p.Wkv, DM, 3072, 3072, DM, 3072);
  for (int j = 0; j < 2; ++j) add(cmp_w1 + (size_t)j * 4096 * 256, p.Wc1 + (size_t)j * 256 * 4096, 4096, 256, 256, 4096, 256);
  for (int j = 0; j < 2; ++j) add(cmp_w2 + (size_t)j * 256 * 128, p.Wc2 + (size_t)j * 128 * 256, 256, 128, 128, 256, 128);
  for (int L = 0; L < 2; ++L) {
    if (L == 1) { pj.stage_tiles[2] = tile; tile = 0; }
    const float* wi = b_w_in + (size_t)L * DM * 4144;
    add(wi, p.Win, DM, 2048, 4144, DM, 2048);
    add(wi + 2096, p.Win + (size_t)2048 * DM, DM, 2048, 4144, DM, 2048);
    add(wi + 2048, p.Win + (size_t)4096 * DM, DM, 48, 4144, DM, 128);
    add(b_w_o + (size_t)L * DD, p.Wob, DM, DM, DM, DM, DM);
  }
  pj.stage_tiles[3] = tile;
  for (int i = 0; i < 16; ++i) pj.rope_inv[i] = (float)pow(500000.0, -(double)i / 16.0);

  static int grid_blocks = 0;
  if (!grid_blocks) {
    int dev = 0, cus = 0, per_cu = 0;
    hipGetDevice(&dev);
    hipDeviceGetAttribute(&cus, hipDeviceAttributeMultiprocessorCount, dev);
    hipOccupancyMaxActiveBlocksPerMultiprocessor(&per_cu, fwd_kernel, NTHREADS, 0);
    if (per_cu > 2) per_cu = 2;
    if (per_cu < 1) per_cu = 1;
    grid_blocks = cus * per_cu;
  }
#if ONE_LAUNCH
  int lo = 0, hi = NPHASE;
  void* args[] = {(void*)&p, (void*)&pj, (void*)&bar, (void*)&lo, (void*)&hi};
  hipError_t e = hipLaunchCooperativeKernel((void*)fwd_kernel, dim3(grid_blocks), dim3(NTHREADS), args, 0, stream);
  if (e != hipSuccess) fprintf(stderr, "cooperative launch failed: %s (grid %d)\n", hipGetErrorString(e), grid_blocks);
#else
  for (int ph = 0; ph < NPHASE; ++ph) {
    hipLaunchKernelGGL(fwd_kernel, dim3(grid_blocks), dim3(NTHREADS), 0, stream, p, pj, bar, ph, ph + 1);
  }

#endif
}
```

```cpp
#include <hip/hip_runtime.h>
#include <hip/hip_cooperative_groups.h>
#include <cstdio>
#include <cstdint>
#include <cstring>
#include <cmath>
namespace cg = cooperative_groups;

#ifndef ONE_LAUNCH
#define ONE_LAUNCH 1
#endif

typedef unsigned short bf16_t;
typedef short bf16x8 __attribute__((ext_vector_type(8)));
typedef float f32x4 __attribute__((ext_vector_type(4)));
typedef float f32x16 __attribute__((ext_vector_type(16)));
typedef unsigned u32x4 __attribute__((ext_vector_type(4)));
typedef unsigned u32x2 __attribute__((ext_vector_type(2)));

#define MTOK 16384
#define TSEQ 4096
#define DM 2048
#define NTHREADS 256
#define QSCALE 0.12751743f
#define ATT_KSZ 17408
#define ATT_BUF 35840
#define LDS_BYTES 71680

struct ConvJob { const float* src; bf16_t* dst; int K, N, ld, Kpad, Npad, tile0; };

struct P {
  const float *x, *a_norm_g, *a_mu, *a_w0, *a_a0, *a_v0, *a_k_k, *a_k_a, *a_r_k, *a_ln_g, *a_ln_b;
  const float *kv_norm_g, *cmp_pe, *b_norm_g, *b_gate_b, *final_g;
  float* out;
  bf16_t *ysum, *ubuf, *r, *k, *vA, *z, *vB;
  bf16_t *lw, *la, *lv; float *bon; float *ropec, *ropes;
  bf16_t *Wp, *W2w, *W2a, *W2v, *Wo;
  bf16_t *Wkv, *Win, *Wc1, *Wc2, *Wob;
  bf16_t *hn, *q, *sz, *ocmp;
  bf16_t *kc, *vc, *ks, *vsT, *kw, *vwT, *hc, *kcmp, *vcmpT;
  float *gates; unsigned *selmask;
};
struct PJ {
  ConvJob jobs[33];
  float rope_inv[16];
  int stage_tiles[4];
};

typedef __bf16 bf16x2_t __attribute__((ext_vector_type(2)));
typedef float f32x2 __attribute__((ext_vector_type(2)));
__device__ __forceinline__ unsigned cvtpk(float lo, float hi) {
  f32x2 v = {lo, hi};
  bf16x2_t b = __builtin_convertvector(v, bf16x2_t);
  return __builtin_bit_cast(unsigned, b);
}
__device__ __forceinline__ bf16_t f2bf(float x) { return (bf16_t)(cvtpk(x, x) & 0xffffu); }
__device__ __forceinline__ float bflo(unsigned w) { return __uint_as_float(w << 16); }
__device__ __forceinline__ float bfhi(unsigned w) { return __uint_as_float(w & 0xffff0000u); }
__device__ __forceinline__ float bf2f(bf16_t v) { return __uint_as_float(((unsigned)v) << 16); }
__device__ __forceinline__ void unpack8(bf16x8 v, float* f) {
  u32x4 w = *reinterpret_cast<u32x4*>(&v);
#pragma unroll
  for (int i = 0; i < 4; ++i) { f[2 * i] = bflo(w[i]); f[2 * i + 1] = bfhi(w[i]); }
}
__device__ __forceinline__ bf16x8 pack8f(const float* f) {
  u32x4 w = {cvtpk(f[0], f[1]), cvtpk(f[2], f[3]), cvtpk(f[4], f[5]), cvtpk(f[6], f[7])};
  return *reinterpret_cast<bf16x8*>(&w);
}
__device__ __forceinline__ float sigmoidf_(float x) { return __builtin_amdgcn_rcpf(1.f + __expf(-x)); }
__device__ __forceinline__ float siluf_(float x) { return x * __builtin_amdgcn_rcpf(1.f + __expf(-x)); }
#define DPP(x, ctrl) __int_as_float(__builtin_amdgcn_mov_dpp(__float_as_int(x), ctrl, 0xF, 0xF, true))
__device__ __forceinline__ float sum8(float x) {
  x += DPP(x, 0xB1); x += DPP(x, 0x4E); x += DPP(x, 0x141); return x;
}
__device__ __forceinline__ float wave_sum(float x) {
#pragma unroll
  for (int o = 32; o >= 1; o >>= 1) x += __shfl_xor(x, o);
  return x;
}
__device__ __forceinline__ float swap32_max(float x) {
  auto rr = __builtin_amdgcn_permlane32_swap(__float_as_uint(x), __float_as_uint(x), false, false);
  return fmaxf(__uint_as_float(rr[0]), __uint_as_float(rr[1]));
}
__device__ __forceinline__ float swap32_sum(float x) {
  auto rr = __builtin_amdgcn_permlane32_swap(__float_as_uint(x), __float_as_uint(x), false, false);
  return __uint_as_float(rr[0]) + __uint_as_float(rr[1]);
}
__device__ __forceinline__ int crow(int r, int hi) { return (r & 3) + 8 * (r >> 2) + 4 * hi; }

__device__ __forceinline__ void conv_tile(const ConvJob& jb, int tile, char* lds) {
  float* T = (float*)lds;
  const int nkt = jb.Kpad >> 6;
  const int n0 = (tile / nkt) * 64, k0 = (tile % nkt) * 64;
  const int tx = threadIdx.x & 63, ty = threadIdx.x >> 6;
#pragma unroll 4
  for (int rr = 0; rr < 16; ++rr) {
    int kl = ty * 16 + rr, kk = k0 + kl, n = n0 + tx;
    float v = (kk < jb.K && n < jb.N) ? jb.src[(size_t)kk * jb.ld + n] : 0.f;
    T[kl * 65 + tx] = v;
  }
  __syncthreads();
  const int nl = threadIdx.x >> 2, kc = (threadIdx.x & 3) * 16;
  unsigned w[8];
#pragma unroll
  for (int i = 0; i < 8; ++i) w[i] = cvtpk(T[(kc + 2 * i) * 65 + nl], T[(kc + 2 * i + 1) * 65 + nl]);
  bf16_t* d = jb.dst + (size_t)(n0 + nl) * jb.Kpad + k0 + kc;
  *(u32x4*)d = u32x4{w[0], w[1], w[2], w[3]};
  *(u32x4*)(d + 8) = u32x4{w[4], w[5], w[6], w[7]};
  __syncthreads();
}

template <int MODE>
__device__ __forceinline__ void rmsnorm_row(const P& p, int row, bool has_y, const float* g1, bf16_t* o1, const float* g2, bf16_t* o2, float* of) {
  const int lane = threadIdx.x & 63;
  const float* xr = p.x + (size_t)row * DM;
  const bf16_t* yr = p.ysum + (size_t)row * DM;
  f32x4 v[8]; float ss = 0.f;
#pragma unroll
  for (int i = 0; i < 8; ++i) {
    int c = (lane + 64 * i) * 4;
    v[i] = *(const f32x4*)(xr + c);
    if (has_y) { u32x2 w = *(const u32x2*)(yr + c); v[i][0] += bflo(w[0]); v[i][1] += bfhi(w[0]); v[i][2] += bflo(w[1]); v[i][3] += bfhi(w[1]); }
    ss += v[i][0] * v[i][0] + v[i][1] * v[i][1] + v[i][2] * v[i][2] + v[i][3] * v[i][3];
  }
  ss = wave_sum(ss);
  const float rs = rsqrtf(ss * (1.f / DM) + 1e-6f);
#pragma unroll
  for (int i = 0; i < 8; ++i) {
    int c = (lane + 64 * i) * 4;
    f32x4 g = *(const f32x4*)(g1 + c);
    if (MODE == 2) {
      f32x4 y = {v[i][0] * rs * g[0], v[i][1] * rs * g[1], v[i][2] * rs * g[2], v[i][3] * rs * g[3]};
      *(f32x4*)(of + (size_t)row * DM + c) = y;
    } else {
      u32x2 w = {cvtpk(v[i][0] * rs * g[0], v[i][1] * rs * g[1]), cvtpk(v[i][2] * rs * g[2], v[i][3] * rs * g[3])};
      *(u32x2*)(o1 + (size_t)row * DM + c) = w;
      if (MODE == 1) {
        f32x4 gg = *(const f32x4*)(g2 + c);
        u32x2 w2 = {cvtpk(v[i][0] * rs * gg[0], v[i][1] * rs * gg[1]), cvtpk(v[i][2] * rs * gg[2], v[i][3] * rs * gg[3])};
        *(u32x2*)(o2 + (size_t)row * DM + c) = w2;
      }
    }
  }
}

template <int MODE, int STAGE>
__device__ __forceinline__ void norm_phase(const P& p, const PJ& pj, bool has_y, const float* g1, bf16_t* o1, const float* g2, bf16_t* o2, float* of, char* lds) {
  if constexpr (STAGE >= 0) {
    constexpr int J0 = STAGE == 0 ? 0 : STAGE == 1 ? 9 : STAGE == 2 ? 20 : 29;
    constexpr int J1 = STAGE == 0 ? 9 : STAGE == 1 ? 20 : STAGE == 2 ? 29 : 33;
    const int nt = pj.stage_tiles[STAGE];
    for (int t = blockIdx.x; t < nt; t += gridDim.x) {
      const float* jsrc = pj.jobs[J0].src; bf16_t* jdst = pj.jobs[J0].dst;
      int jK = pj.jobs[J0].K, jN = pj.jobs[J0].N, jld = pj.jobs[J0].ld, jKp = pj.jobs[J0].Kpad, jNp = pj.jobs[J0].Npad, jt0 = pj.jobs[J0].tile0;
#pragma unroll
      for (int j = J0 + 1; j < J1; ++j) {
        const bool cnd = t >= pj.jobs[j].tile0;
        jsrc = cnd ? pj.jobs[j].src : jsrc; jdst = cnd ? pj.jobs[j].dst : jdst;
        jK = cnd ? pj.jobs[j].K : jK; jN = cnd ? pj.jobs[j].N : jN; jld = cnd ? pj.jobs[j].ld : jld;
        jKp = cnd ? pj.jobs[j].Kpad : jKp; jNp = cnd ? pj.jobs[j].Npad : jNp; jt0 = cnd ? pj.jobs[j].tile0 : jt0;
      }
      ConvJob jb; jb.src = jsrc; jb.dst = jdst; jb.K = jK; jb.N = jN; jb.ld = jld; jb.Kpad = jKp; jb.Npad = jNp; jb.tile0 = jt0;
      conv_tile(jb, t - jt0, lds);
    }
    if constexpr (STAGE == 0) {
      for (int pos = blockIdx.x * NTHREADS + threadIdx.x; pos < TSEQ; pos += gridDim.x * NTHREADS) {
#pragma unroll
        for (int i = 0; i < 16; ++i) {
          const float ang = (float)pos * pj.rope_inv[i];
          const double a = (double)ang * 0.15915494309189535;
          const float fr = (float)(a - rint(a));
          p.ropec[pos * 16 + i] = __builtin_amdgcn_cosf(fr); p.ropes[pos * 16 + i] = __builtin_amdgcn_sinf(fr);
        }
      }
    }
  }
  const bool aff = gridDim.x == 512;
  const int gw = aff ? (((int)blockIdx.x >> 3) * 4 + (int)(threadIdx.x >> 6)) : (int)(blockIdx.x * 4 + (threadIdx.x >> 6));
  const int nw = aff ? 256 : (int)gridDim.x * 4;
  const int rbeg = aff ? ((int)blockIdx.x & 7) * 2048 : 0, rend = aff ? rbeg + 2048 : MTOK;
  for (int row = rbeg + gw; row < rend; row += nw) rmsnorm_row<MODE>(p, row, has_y, g1, o1, g2, o2, of);
}

enum { AL_PLAIN = 0, AL_MIX = 1, AL_CMP = 2 };
enum { EP_PROJ = 0, EP_RESID = 1, EP_KV = 2, EP_CMP1 = 3, EP_CMP2 = 4, EP_WIN = 5 };

struct GemmCtx {
  const bf16_t* A; int lda;
  const bf16_t* Bt; int K;
  const float* aux;
  int layer, j;
};

template <int NI>
__device__ __forceinline__ void store_rows_lds(bf16_t* base, const size_t ld, const int row0, const int cbase, f32x4 (&acc)[4][NI], char* lds, const bool rmw) {
  constexpr int RB = NI * 32 + 16;
  constexpr int CPR = NI * 2;
  const int lane = threadIdx.x & 63, wid = threadIdx.x >> 6, lr = lane & 15, lq = lane >> 4;
  char* W = lds + wid * (64 * RB);
#pragma unroll
  for (int mi = 0; mi < 4; ++mi)
#pragma unroll
    for (int ni = 0; ni < NI; ++ni)
#pragma unroll
      for (int j = 0; j < 4; ++j) *(bf16_t*)(W + (mi * 16 + lq * 4 + j) * RB + (ni * 16 + lr) * 2) = f2bf(acc[mi][ni][j]);
  __builtin_amdgcn_fence(__ATOMIC_RELEASE, "wavefront");
  __builtin_amdgcn_wave_barrier();
#pragma unroll 4
  for (int i = 0; i < CPR; ++i) {
    const int id = lane + 64 * i, row = id / CPR, cc = id % CPR;
    bf16x8 v = *(const bf16x8*)(W + row * RB + cc * 16);
    bf16_t* g = base + (size_t)(row0 + row) * ld + cbase + cc * 8;
    if (rmw) {
      float fa[8], fb[8]; unpack8(v, fa); unpack8(*(const bf16x8*)g, fb);
#pragma unroll
      for (int e = 0; e < 8; ++e) fa[e] += fb[e];
      v = pack8f(fa);
    }
    *(bf16x8*)g = v;
  }
}

template <int EP, int NI>
__device__ __forceinline__ void gemm_epilogue(const P& p, const GemmCtx& c, const int nt, const int m0, const int wr, const int lq, const int lr, const int cbase, f32x4 (&acc)[4][NI], char* lds) {
  const int rbase = m0 + wr * 64 + lq * 4; const int n0 = nt * 128;
  const int cl = cbase + lr;
  if constexpr (EP == EP_PROJ) {
    if (nt < 64) {
      const int which = nt >> 4;
      const int slab = which < 2 ? which : which == 3 ? 3 : (c.layer == 0 ? 2 : 4);
      bf16_t* dst = p.r + (size_t)slab * (32u << 20);
      store_rows_lds<NI>(dst + (nt & 15) * 128, DM, m0 + wr * 64, cbase, acc, lds, false);
    } else {
      bf16_t* dst = p.lw + (size_t)(nt - 64) * (2u << 20);
#pragma unroll
      for (int mi = 0; mi < 4; ++mi)
#pragma unroll
        for (int ni = 0; ni < NI; ++ni)
#pragma unroll
          for (int j = 0; j < 4; ++j) {
            float v = acc[mi][ni][j];
            if (nt == 64) v = 1.f - 2.f * __builtin_amdgcn_rcpf(1.f + __expf(2.f * v));
            dst[(size_t)(rbase + mi * 16 + j) * 128 + cl + ni * 16] = f2bf(v);
          }
    }
  } else if constexpr (EP == EP_RESID) {
    const bool has_y = c.layer != 0;
    store_rows_lds<NI>(p.ysum + n0, DM, m0 + wr * 64, cbase, acc, lds, has_y);
  } else if constexpr (EP == EP_KV || EP == EP_WIN || EP == EP_CMP2) {
    int kind;
    bool rope = false; float qs = 1.f;
    bf16_t* dst = nullptr; int bgidx = 0;
    if constexpr (EP == EP_KV) {
      const int i = nt >> 2, g = nt & 3; bgidx = g;
      kind = (i == 3 || i == 5) ? 1 : 0; rope = (i == 2 || i == 4);
      dst = p.kc + (size_t)i * (8u << 20);
    } else if constexpr (EP == EP_WIN) {
      kind = nt < 16 ? 0 : nt < 32 ? 2 : 3; rope = nt < 16; qs = nt < 16 ? QSCALE : 1.f;
      dst = p.q + (nt < 16 ? (size_t)0 : (size_t)(32u << 20));
    } else {
      kind = c.j == 0 ? 0 : 1; rope = c.j == 0; dst = p.kcmp + (size_t)c.j * (512u << 10);
    }
    if (rope && cbase == 0) {
#pragma unroll
      for (int mi = 0; mi < 4; ++mi)
#pragma unroll
        for (int j = 0; j < 4; ++j) {
          const int row = rbase + mi * 16 + j;
          int pos;
          if constexpr (EP == EP_CMP2) { pos = 16 * (row & 255) + 31; if (pos > TSEQ - 1) pos = TSEQ - 1; } else pos = row & (TSEQ - 1);
          const float cs = p.ropec[pos * 16 + lr], sn = p.ropes[pos * 16 + lr];
          const float x1 = acc[mi][0][j], x2 = acc[mi][1][j];
          acc[mi][0][j] = x1 * cs - x2 * sn; acc[mi][1][j] = x2 * cs + x1 * sn;
        }
    }
    if (kind == 0 || kind == 2) {
      const bool sil = kind == 2;
#pragma unroll
      for (int mi = 0; mi < 4; ++mi)
#pragma unroll
        for (int ni = 0; ni < NI; ++ni)
#pragma unroll
          for (int j = 0; j < 4; ++j) { const float v = acc[mi][ni][j]; acc[mi][ni][j] = sil ? siluf_(v) : v * qs; }
      bf16_t* base; size_t ld;
      if constexpr (EP == EP_KV) {
        const int i = nt >> 2;
        if (i < 2) { base = dst + bgidx * 128; ld = 512; }
        else { const int b = m0 >> 12; base = dst + (size_t)(3 * b + bgidx) * TSEQ * 128; ld = 128; }
      } else if constexpr (EP == EP_WIN) { base = dst + (nt & 15) * 128; ld = DM; }
      else { base = dst; ld = 128; }
      store_rows_lds<NI>(base, ld, m0 + wr * 64, cbase, acc, lds, false);
    } else if (kind == 1) {
#pragma unroll
      for (int mi = 0; mi < 4; ++mi)
#pragma unroll
        for (int ni = 0; ni < NI; ++ni) {
          const int row0 = m0 + wr * 64 + mi * 16;
          const int d = cl + ni * 16;
          const int slot = (lq & 1) * 8 + (lq >> 1) * 4;
          u32x2 w = {cvtpk(acc[mi][ni][0], acc[mi][ni][1]), cvtpk(acc[mi][ni][2], acc[mi][ni][3])};
          size_t idx;
          if constexpr (EP == EP_KV) { const int b = row0 >> 12, t0 = row0 & (TSEQ - 1); idx = ((size_t)((b * 4 + bgidx) * 128 + d)) * TSEQ + t0 + slot; }
          else { const int bg = row0 >> 8, c0 = row0 & 255; idx = ((size_t)(bg * 128 + d)) * 256 + c0 + slot; }
          *(u32x2*)(dst + idx) = w;
        }
    } else {
      const float* gb = p.b_gate_b + c.j * 48;
#pragma unroll
      for (int mi = 0; mi < 4; ++mi)
#pragma unroll
        for (int ni = 0; ni < NI; ++ni) {
          const int n = cl + ni * 16;
          if (n < 48) {
#pragma unroll
            for (int j = 0; j < 4; ++j) p.gates[(size_t)(rbase + mi * 16 + j) * 48 + n] = sigmoidf_(acc[mi][ni][j] + gb[n]);
          }
        }
    }
  } else if constexpr (EP == EP_CMP1) {
    bf16_t* dst = p.hc + (size_t)c.j * 4096 * 256;
#pragma unroll
    for (int mi = 0; mi < 4; ++mi)
#pragma unroll
      for (int ni = 0; ni < NI; ++ni)
#pragma unroll
        for (int j = 0; j < 4; ++j) dst[(size_t)(rbase + mi * 16 + j) * 256 + n0 + cl + ni * 16] = f2bf(siluf_(acc[mi][ni][j]));
  }
  __syncthreads();
}

template <int AL, int EP>
__device__ __forceinline__ void gemm_tile(const P& p, const GemmCtx& c, const int mt, const int nt, char* lds) {
  const int tid = threadIdx.x, lane = tid & 63, wid = tid >> 6;
  const int wr = wid >> 1, wc = wid & 1, lr = lane & 15, lq = lane >> 4;
  const int m0 = mt * 128, n0 = nt * 128;
  const int K = c.K, nk = K >> 6;
  const int lc = tid & 7, lrow = tid >> 3;
  f32x4 acc[4][4];
#pragma unroll
  for (int i = 0; i < 4; ++i)
#pragma unroll
    for (int j = 0; j < 4; ++j) acc[i][j] = f32x4{0.f, 0.f, 0.f, 0.f};
  bf16x8 ra[4], rp[4], rb[4]; f32x4 ax0, ax1;

  auto load_tile = [&](int kt) {
#pragma unroll
    for (int i = 0; i < 4; ++i) {
      const int row = lrow + 32 * i;
      rb[i] = *(const bf16x8*)(c.Bt + (size_t)(n0 + row) * K + kt * 64 + lc * 8);
      if constexpr (AL == AL_PLAIN) {
        ra[i] = *(const bf16x8*)(c.A + (size_t)(m0 + row) * c.lda + kt * 64 + lc * 8);
      } else if constexpr (AL == AL_MIX) {
        const int m = m0 + row;
        const bf16_t* src = c.A + (size_t)m * DM + kt * 64 + lc * 8;
        ra[i] = *(const bf16x8*)src;
        if ((m & (TSEQ - 1)) != 0) rp[i] = *(const bf16x8*)(src - DM); else rp[i] = bf16x8{0, 0, 0, 0, 0, 0, 0, 0};
      } else {
        const int R = m0 + row, bg = R >> 8, cc = R & 255, b = bg >> 2, g = bg & 3;
        const int l = kt >> 1, d = (kt & 1) * 64 + lc * 8;
        int t = 16 * cc + l; if (t > TSEQ - 1) t = TSEQ - 1;
        ra[i] = *(const bf16x8*)(c.A + ((size_t)(b * TSEQ + t)) * 512 + g * 128 + d);
      }
    }
    if constexpr (AL == AL_MIX) { const float* mu = c.aux + kt * 64 + lc * 8; ax0 = *(const f32x4*)mu; ax1 = *(const f32x4*)(mu + 4); }
    if constexpr (AL == AL_CMP) { const float* pe = c.aux + (kt >> 1) * 128 + (kt & 1) * 64 + lc * 8; ax0 = *(const f32x4*)pe; ax1 = *(const f32x4*)(pe + 4); }
  };
  auto store_tile = [&](int buf) {
    char* Ab = lds + buf * 32768; char* Bb = Ab + 16384;
#pragma unroll
    for (int i = 0; i < 4; ++i) {
      const int row = lrow + 32 * i;
      const int off = row * 128 + ((lc ^ (row & 7)) << 4);
      *(bf16x8*)(Bb + off) = rb[i];
      if constexpr (AL == AL_PLAIN) { *(bf16x8*)(Ab + off) = ra[i]; }
      else {
        float f[8]; unpack8(ra[i], f);
        const float mu[8] = {ax0[0], ax0[1], ax0[2], ax0[3], ax1[0], ax1[1], ax1[2], ax1[3]};
        if constexpr (AL == AL_MIX) {
          float fp[8]; unpack8(rp[i], fp);
#pragma unroll
          for (int e = 0; e < 8; ++e) f[e] = f[e] + (fp[e] - f[e]) * mu[e];
        } else {
#pragma unroll
          for (int e = 0; e < 8; ++e) f[e] = f[e] + mu[e];
        }
        *(bf16x8*)(Ab + off) = pack8f(f);
      }
    }
  };
  auto compute = [&](int buf) {
    const char* Ab = lds + buf * 32768; const char* Bb = Ab + 16384;
#pragma unroll
    for (int ks = 0; ks < 2; ++ks) {
      bf16x8 af[4], bfr[4];
#pragma unroll
      for (int mi = 0; mi < 4; ++mi) { const int row = wr * 64 + mi * 16 + lr; af[mi] = *(const bf16x8*)(Ab + row * 128 + (((ks * 4 + lq) ^ (row & 7)) << 4)); }
#pragma unroll
      for (int ni = 0; ni < 4; ++ni) { const int row = wc * 64 + ni * 16 + lr; bfr[ni] = *(const bf16x8*)(Bb + row * 128 + (((ks * 4 + lq) ^ (row & 7)) << 4)); }
#pragma unroll
      for (int mi = 0; mi < 4; ++mi)
#pragma unroll
        for (int ni = 0; ni < 4; ++ni) acc[mi][ni] = __builtin_amdgcn_mfma_f32_16x16x32_bf16(af[mi], bfr[ni], acc[mi][ni], 0, 0, 0);
    }
  };

  load_tile(0);
  store_tile(0);
  __syncthreads();
  for (int kt = 0; kt < nk; ++kt) {
    if (kt + 1 < nk) load_tile(kt + 1);
    __builtin_amdgcn_sched_barrier(0);
    compute(kt & 1);
    __builtin_amdgcn_sched_barrier(0);
    if (kt + 1 < nk) store_tile((kt + 1) & 1);
    __syncthreads();
  }

  gemm_epilogue<EP, 4>(p, c, nt, m0, wr, lq, lr, wc * 64, acc, lds);
}


template <int AL, int EP>
__device__ __forceinline__ void gemm_wide(const P& p, const GemmCtx& c, const int mt, const int nt2, char* lds) {
  const int tid = threadIdx.x, lane = tid & 63, wid = tid >> 6;
  const int wr = wid >> 1, wc = wid & 1, lr = lane & 15, lq = lane >> 4;
  const int m0 = mt * 128, n0 = nt2 * 256;
  const int K = c.K, nk = K >> 5;
  const bf16_t* A = c.A;
  const bf16_t* Bt = c.Bt;
  const float* mu = c.aux;
  const int lc = tid & 3, lrow = tid >> 2;
  f32x4 acc[4][8];
#pragma unroll
  for (int i = 0; i < 4; ++i)
#pragma unroll
    for (int j = 0; j < 8; ++j) acc[i][j] = f32x4{0.f, 0.f, 0.f, 0.f};
  bf16x8 ra[2], rp[2], rb[4]; f32x4 ax0, ax1;
  auto load_tile = [&](int kt) {
#pragma unroll
    for (int i = 0; i < 4; ++i) rb[i] = *(const bf16x8*)(Bt + (size_t)(n0 + lrow + 64 * i) * K + kt * 32 + lc * 8);
#pragma unroll
    for (int i = 0; i < 2; ++i) {
      const int m = m0 + lrow + 64 * i;
      const bf16_t* src = A + (size_t)m * c.lda + kt * 32 + lc * 8;
      ra[i] = *(const bf16x8*)src;
      if constexpr (AL == AL_MIX) { if ((m & (TSEQ - 1)) != 0) rp[i] = *(const bf16x8*)(src - DM); else rp[i] = bf16x8{0, 0, 0, 0, 0, 0, 0, 0}; }
    }
    if constexpr (AL == AL_MIX) { ax0 = *(const f32x4*)(mu + kt * 32 + lc * 8); ax1 = *(const f32x4*)(mu + kt * 32 + lc * 8 + 4); }
  };
  auto store_tile = [&](int buf) {
    char* Ab = lds + buf * 24576; char* Bb = Ab + 8192;
#pragma unroll
    for (int i = 0; i < 4; ++i) { const int row = lrow + 64 * i; *(bf16x8*)(Bb + row * 64 + ((lc ^ ((-(row >> 2)) & 3)) << 4)) = rb[i]; }
#pragma unroll
    for (int i = 0; i < 2; ++i) {
      const int row = lrow + 64 * i;
      if constexpr (AL == AL_MIX) {
        const float muv[8] = {ax0[0], ax0[1], ax0[2], ax0[3], ax1[0], ax1[1], ax1[2], ax1[3]};
        float f[8], fp[8]; unpack8(ra[i], f); unpack8(rp[i], fp);
#pragma unroll
        for (int e = 0; e < 8; ++e) f[e] = f[e] + (fp[e] - f[e]) * muv[e];
        *(bf16x8*)(Ab + row * 64 + ((lc ^ ((-(row >> 2)) & 3)) << 4)) = pack8f(f);
      } else {
        *(bf16x8*)(Ab + row * 64 + ((lc ^ ((-(row >> 2)) & 3)) << 4)) = ra[i];
      }
    }
  };
  auto compute = [&](int buf) {
    const char* Ab = lds + buf * 24576; const char* Bb = Ab + 8192;
    const int sw = (lq ^ ((-(lr >> 2)) & 3)) << 4;
    bf16x8 af[4];
#pragma unroll
    for (int mi = 0; mi < 4; ++mi) af[mi] = *(const bf16x8*)(Ab + (wr * 64 + mi * 16 + lr) * 64 + sw);
#pragma unroll
    for (int nh = 0; nh < 2; ++nh) {
      bf16x8 bfr[4];
#pragma unroll
      for (int ni = 0; ni < 4; ++ni) bfr[ni] = *(const bf16x8*)(Bb + (wc * 128 + (nh * 4 + ni) * 16 + lr) * 64 + sw);
#pragma unroll
      for (int mi = 0; mi < 4; ++mi)
#pragma unroll
        for (int ni = 0; ni < 4; ++ni) acc[mi][nh * 4 + ni] = __builtin_amdgcn_mfma_f32_16x16x32_bf16(af[mi], bfr[ni], acc[mi][nh * 4 + ni], 0, 0, 0);
    }
  };
  load_tile(0);
  store_tile(0);
  __syncthreads();
  for (int kt = 0; kt < nk; ++kt) {
    if (kt + 1 < nk) load_tile(kt + 1);
    __builtin_amdgcn_sched_barrier(0);
    compute(kt & 1);
    __builtin_amdgcn_sched_barrier(0);
    if (kt + 1 < nk) store_tile((kt + 1) & 1);
    __syncthreads();
  }
  gemm_epilogue<EP, 8>(p, c, 2 * nt2 + wc, m0, wr, lq, lr, 0, acc, lds);
}

__device__ __forceinline__ float sum16(float x) {
  x += DPP(x, 0xB1); x += DPP(x, 0x4E); x += DPP(x, 0x141); x += DPP(x, 0x140); return x;
}
__device__ __forceinline__ void scan_item(const P& p, const int layer, const int item, char* lds) {
  const int quarter = item & 3, h = (item >> 2) & 31, b = item >> 7;
  const int tid = threadIdx.x, lane = tid & 63, wid = tid >> 6;
  float* R = (float*)lds;
  float* W = R + 2048; float* Kk = W + 2048; float* Aa = Kk + 2048; float* Bv = Aa + 2048;
  float* V = Bv + 2048;
  float* Vg = V + 512;
  float* O = Vg + 512;
  float* KKp = O + 528; float* KAp = KKp + 64; float* RKp = KAp + 64;
  float* LBp = RKp + 64;
  const bf16_t* vsrc = p.vA + (size_t)layer * (64u << 20);
  bf16_t* vdst = p.vB;
  const int tl = tid >> 3, c8 = tid & 7;
  const int ch0 = h * 64 + c8 * 8;
  const int vc0 = h * 64 + quarter * 16;
  const int lr = lane & 15, lq = lane >> 4;
  const int ten = wid >> 1, lmi = wid & 1;
  const bf16_t* lA = p.lw + (size_t)ten * (2u << 20);
  const bf16_t* lB = p.W2w + (size_t)ten * (256u << 10);
  if (tid < 64) {
    KKp[tid] = p.a_k_k[layer * DM + h * 64 + tid]; KAp[tid] = p.a_k_a[layer * DM + h * 64 + tid]; RKp[tid] = p.a_r_k[layer * DM + h * 64 + tid];
  }
  if (tid < 128) { const float b0_ = p.a_w0[layer * DM + h * 64 + (tid & 63)], b1_ = p.a_a0[layer * DM + h * 64 + (tid & 63)]; LBp[tid] = tid < 64 ? b0_ : b1_; }
  if (tid >= 128 && tid < 144) LBp[tid] = layer == 1 ? p.a_v0[vc0 + (tid - 128)] : 0.f;
  const int row = tid >> 4, kq = tid & 15;
  f32x2 S01 = {0.f, 0.f}, S23 = {0.f, 0.f};

  const size_t tok0 = (size_t)b * TSEQ;
  bf16x8 rr, rk, rv, rvf;
  bf16x8 wB[3][4], wBv[2], fA[3], fAv[2];
#pragma unroll
  for (int ks = 0; ks < 3; ++ks)
#pragma unroll
    for (int ni = 0; ni < 4; ++ni) wB[ks][ni] = *(const bf16x8*)(lB + (size_t)(h * 64 + ni * 16 + lr) * 128 + ks * 32 + lq * 8);
  if (layer == 1) {
#pragma unroll
    for (int ks = 0; ks < 2; ++ks) wBv[ks] = *(const bf16x8*)(p.W2v + (size_t)(vc0 + lr) * 128 + ks * 32 + lq * 8);
  }
  auto load_raw = [&](int c) {
    const size_t m = tok0 + c * 32 + tl;
    {
      const size_t ml = tok0 + c * 32 + lmi * 16 + lr;
#pragma unroll
      for (int ks = 0; ks < 3; ++ks) fA[ks] = *(const bf16x8*)(lA + ml * 128 + ks * 32 + lq * 8);
      if (layer == 1) {
#pragma unroll
        for (int ks = 0; ks < 2; ++ks) fAv[ks] = *(const bf16x8*)(p.lv + ml * 128 + ks * 32 + lq * 8);
      }
    }
    rr = *(const bf16x8*)(p.r + m * DM + ch0);
    rk = *(const bf16x8*)(p.k + m * DM + ch0);
    if (c8 < 2) {
      rv = *(const bf16x8*)(vsrc + m * DM + vc0 + c8 * 8);
      if (layer == 1) rvf = *(const bf16x8*)(p.vA + m * DM + vc0 + c8 * 8);
    }
  };
  load_raw(0);
  __syncthreads();
  for (int c = 0; c < TSEQ / 32; ++c) {
    const size_t mc = tok0 + c * 32;
    {
      f32x4 acc[4];
#pragma unroll
      for (int ni = 0; ni < 4; ++ni) acc[ni] = f32x4{0.f, 0.f, 0.f, 0.f};
#pragma unroll
      for (int ks = 0; ks < 3; ++ks) {
#pragma unroll
        for (int ni = 0; ni < 4; ++ni) acc[ni] = __builtin_amdgcn_mfma_f32_16x16x32_bf16(fA[ks], wB[ks][ni], acc[ni], 0, 0, 0);
      }
      float* dstL = ten == 0 ? W : Bv;
#pragma unroll
      for (int ni = 0; ni < 4; ++ni)
#pragma unroll
        for (int j = 0; j < 4; ++j) {
          float sg = sigmoidf_(acc[ni][j] + LBp[ten * 64 + ni * 16 + lr]);
          float val = ten == 0 ? __expf(-0.6065306597126334f * sg) : sg;
          dstL[(lmi * 16 + lq * 4 + j) * 64 + ni * 16 + lr] = val;
        }
      if (layer == 1 && wid < 2) {
        f32x4 av = f32x4{0.f, 0.f, 0.f, 0.f};
#pragma unroll
        for (int ks = 0; ks < 2; ++ks) av = __builtin_amdgcn_mfma_f32_16x16x32_bf16(fAv[ks], wBv[ks], av, 0, 0, 0);
#pragma unroll
        for (int j = 0; j < 4; ++j) Vg[(wid * 16 + lq * 4 + j) * 16 + lr] = sigmoidf_(av[j] + LBp[128 + lr]);
      }
    }
    if (c > 0) {
      const float o0 = O[(c8 * 2) * 33 + tl], o1 = O[(c8 * 2 + 1) * 33 + tl];
      *(unsigned*)(p.ubuf + (mc - 32 + tl) * DM + vc0 + c8 * 2) = cvtpk(o0, o1);
    }
    __syncthreads();
    {
      float fr[8], fk[8], fa[8];
      unpack8(rr, fr); unpack8(rk, fk);
      { f32x4 a0 = *(const f32x4*)(Bv + tl * 64 + c8 * 8), a1 = *(const f32x4*)(Bv + tl * 64 + c8 * 8 + 4);
        fa[0] = a0[0]; fa[1] = a0[1]; fa[2] = a0[2]; fa[3] = a0[3]; fa[4] = a1[0]; fa[5] = a1[1]; fa[6] = a1[2]; fa[7] = a1[3]; }
      float kk[8], ss = 0.f, bsum = 0.f;
      float kkv[8], kav[8], rkv[8];
      { f32x4 t0 = *(const f32x4*)(KKp + c8 * 8), t1 = *(const f32x4*)(KKp + c8 * 8 + 4);
        kkv[0] = t0[0]; kkv[1] = t0[1]; kkv[2] = t0[2]; kkv[3] = t0[3]; kkv[4] = t1[0]; kkv[5] = t1[1]; kkv[6] = t1[2]; kkv[7] = t1[3];
        t0 = *(const f32x4*)(KAp + c8 * 8); t1 = *(const f32x4*)(KAp + c8 * 8 + 4);
        kav[0] = t0[0]; kav[1] = t0[1]; kav[2] = t0[2]; kav[3] = t0[3]; kav[4] = t1[0]; kav[5] = t1[1]; kav[6] = t1[2]; kav[7] = t1[3];
        t0 = *(const f32x4*)(RKp + c8 * 8); t1 = *(const f32x4*)(RKp + c8 * 8 + 4);
        rkv[0] = t0[0]; rkv[1] = t0[1]; rkv[2] = t0[2]; rkv[3] = t0[3]; rkv[4] = t1[0]; rkv[5] = t1[1]; rkv[6] = t1[2]; rkv[7] = t1[3]; }
#pragma unroll
      for (int e = 0; e < 8; ++e) { kk[e] = fk[e] * kkv[e]; ss += kk[e] * kk[e]; }
      ss = sum8(ss);
      const float inv = __builtin_amdgcn_rsqf(fmaxf(ss, 1e-24f));
      float kp[8], na[8], bb[8];
#pragma unroll
      for (int e = 0; e < 8; ++e) {
        kk[e] *= inv;
        kp[e] = fk[e] * (1.f + (fa[e] - 1.f) * kav[e]);
        na[e] = -kk[e]; bb[e] = kk[e] * fa[e];
        bsum += fr[e] * kp[e] * rkv[e];
      }
      bsum = sum8(bsum);
      float* d;
      d = R + tl * 64 + c8 * 8;  *(f32x4*)d = f32x4{fr[0], fr[1], fr[2], fr[3]}; *(f32x4*)(d + 4) = f32x4{fr[4], fr[5], fr[6], fr[7]};
      d = Kk + tl * 64 + c8 * 8; *(f32x4*)d = f32x4{kp[0], kp[1], kp[2], kp[3]}; *(f32x4*)(d + 4) = f32x4{kp[4], kp[5], kp[6], kp[7]};
      d = Aa + tl * 64 + c8 * 8; *(f32x4*)d = f32x4{na[0], na[1], na[2], na[3]}; *(f32x4*)(d + 4) = f32x4{na[4], na[5], na[6], na[7]};
      d = Bv + tl * 64 + c8 * 8; *(f32x4*)d = f32x4{bb[0], bb[1], bb[2], bb[3]}; *(f32x4*)(d + 4) = f32x4{bb[4], bb[5], bb[6], bb[7]};
      if (quarter == 0 && c8 == 0) p.bon[(mc + tl) * 32 + h] = bsum;
      if (c8 < 2) {
        float fv[8]; unpack8(rv, fv);
        if (layer == 1) {
          float ff[8]; unpack8(rvf, ff);
          f32x4 g0 = *(const f32x4*)(Vg + tl * 16 + c8 * 8), g1 = *(const f32x4*)(Vg + tl * 16 + c8 * 8 + 4);
          const float gg[8] = {g0[0], g0[1], g0[2], g0[3], g1[0], g1[1], g1[2], g1[3]};
#pragma unroll
          for (int e = 0; e < 8; ++e) fv[e] = fv[e] + (ff[e] - fv[e]) * gg[e];
          *(bf16x8*)(vdst + (mc + tl) * DM + vc0 + c8 * 8) = pack8f(fv);
        }
        d = V + tl * 16 + c8 * 8; *(f32x4*)d = f32x4{fv[0], fv[1], fv[2], fv[3]}; *(f32x4*)(d + 4) = f32x4{fv[4], fv[5], fv[6], fv[7]};
      }
    }
    __syncthreads();
    if (c + 1 < TSEQ / 32) load_raw(c + 1);
    {
      f32x4 xa, xw, xk, xb, xr, na_, nw_, nk_, nb_, nr_; float xv, nv;
      const float* bA = Aa + kq * 4; const float* bW = W + kq * 4; const float* bK = Kk + kq * 4; const float* bB = Bv + kq * 4; const float* bR = R + kq * 4;
      xa = *(const f32x4*)bA; xw = *(const f32x4*)bW; xk = *(const f32x4*)bK; xb = *(const f32x4*)bB; xr = *(const f32x4*)bR; xv = V[row];
      float opend = 0.f;
#pragma unroll 8
      for (int t = 0; t < 32; ++t) {
        const f32x2 xa01 = {xa[0], xa[1]}, xa23 = {xa[2], xa[3]};
        f32x2 pa = S01 * xa01; pa = __builtin_elementwise_fma(S23, xa23, pa);
        float ra_ = pa[0] + pa[1];
        __builtin_amdgcn_sched_barrier(0);
        {
          const int o_ = ((t + 1) & 31) * 64;
          na_ = *(const f32x4*)(bA + o_); nw_ = *(const f32x4*)(bW + o_); nk_ = *(const f32x4*)(bK + o_); nb_ = *(const f32x4*)(bB + o_); nr_ = *(const f32x4*)(bR + o_);
          nv = V[((t + 1) & 31) * 16 + row];
        }
        float ro_ = opend;
        ra_ += DPP(ra_, 0xB1); ro_ += DPP(ro_, 0xB1);
        ra_ += DPP(ra_, 0x4E); ro_ += DPP(ro_, 0x4E);
        ra_ += DPP(ra_, 0x141); ro_ += DPP(ro_, 0x141);
        ra_ += DPP(ra_, 0x140); ro_ += DPP(ro_, 0x140);
        O[row * 33 + ((t - 1) & 31)] = ro_;
        const f32x2 sa2 = {ra_, ra_}, xv2 = {xv, xv};
        const f32x2 xk01 = {xk[0], xk[1]}, xk23 = {xk[2], xk[3]}, xb01 = {xb[0], xb[1]}, xb23 = {xb[2], xb[3]};
        const f32x2 xw01 = {xw[0], xw[1]}, xw23 = {xw[2], xw[3]}, xr01 = {xr[0], xr[1]}, xr23 = {xr[2], xr[3]};
        S01 = __builtin_elementwise_fma(S01, xw01, __builtin_elementwise_fma(sa2, xb01, xv2 * xk01));
        S23 = __builtin_elementwise_fma(S23, xw23, __builtin_elementwise_fma(sa2, xb23, xv2 * xk23));
        f32x2 po = S01 * xr01; po = __builtin_elementwise_fma(S23, xr23, po);
        opend = po[0] + po[1];
        xa = na_; xw = nw_; xk = nk_; xb = nb_; xr = nr_; xv = nv;
      }
      { const float ro_ = sum16(opend); O[row * 33 + 31] = ro_; }
    }
    __syncthreads();
  }
  {
    const size_t mp = tok0 + (TSEQ - 32);
    const float o0 = O[(c8 * 2) * 33 + tl], o1 = O[(c8 * 2 + 1) * 33 + tl];
    *(unsigned*)(p.ubuf + (mp + tl) * DM + vc0 + c8 * 2) = cvtpk(o0, o1);
  }
  __syncthreads();
}

__device__ __forceinline__ void postscan_phase(const P& p, const int layer) {
  const int tid = threadIdx.x, head = tid >> 3, ch = tid * 8;
  const bf16_t* vsrc = p.vA + (size_t)layer * (64u << 20);
  float lg[8], lb[8];
  {
    const float* pg = p.a_ln_g + layer * DM + ch; const float* pb = p.a_ln_b + layer * DM + ch;
#pragma unroll
    for (int e = 0; e < 8; ++e) { lg[e] = pg[e]; lb[e] = pb[e]; }
  }
  const bool aff = gridDim.x == 512;
  const int mstride = aff ? 64 : (int)gridDim.x;
  const int mbeg = aff ? ((int)blockIdx.x & 7) * 2048 + ((int)blockIdx.x >> 3) : (int)blockIdx.x;
  const int mend = aff ? ((int)blockIdx.x & 7) * 2048 + 2048 : MTOK;
  for (int m0 = mbeg; m0 < mend; m0 += 4 * mstride) {
    bf16x8 ro[4], rv[4], rz[4]; float bn[4];
#pragma unroll
    for (int u = 0; u < 4; ++u) {
      const int m = m0 + u * mstride;
      if (m < mend) {
        ro[u] = *(const bf16x8*)(p.ubuf + (size_t)m * DM + ch);
        rv[u] = *(const bf16x8*)(vsrc + (size_t)m * DM + ch);
        rz[u] = *(const bf16x8*)(p.z + (size_t)m * DM + ch);
        bn[u] = p.bon[(size_t)m * 32 + head];
      }
    }
#pragma unroll
    for (int u = 0; u < 4; ++u) {
      const int m = m0 + u * mstride;
      if (m < MTOK) {
        float fo[8], fv[8], fz[8];
        unpack8(ro[u], fo); unpack8(rv[u], fv); unpack8(rz[u], fz);
        float sm = 0.f;
#pragma unroll
        for (int e = 0; e < 8; ++e) sm += fo[e];
        const float mean = sum8(sm) * (1.f / 64.f);
        float sv = 0.f;
#pragma unroll
        for (int e = 0; e < 8; ++e) { fo[e] -= mean; sv += fo[e] * fo[e]; }
        const float rstd = rsqrtf(sum8(sv) * (1.f / 64.f) + 64e-5f);
#pragma unroll
        for (int e = 0; e < 8; ++e) fo[e] = (fo[e] * rstd * lg[e] + lb[e] + bn[u] * fv[e]) * siluf_(fz[e]);
        *(bf16x8*)(p.ubuf + (size_t)m * DM + ch) = pack8f(fo);
      }
    }
  }
}

__device__ __forceinline__ void cmp_item(const P& p, const int item, char* lds) {
  const int qb = (item & 512) ? 63 - (item & 63) : (item & 63), g = (item >> 6) & 3, b = item >> 8;
  const int bg = b * 4 + g;
  const int tid = threadIdx.x, lane = tid & 63, w = tid >> 6;
  const int n = lane & 31, hi = lane >> 5;
  float* impM = (float*)lds;
  float* impS = impM + 64 * 68;
  for (int e = lane; e < 16 * 68; e += 64) { impM[w * 16 * 68 + e] = 0.f; impS[w * 16 * 68 + e] = 0.f; }
  const int ql = 16 * w + (n & 15);
  const int tq = qb * 64 + ql;
  const size_t m = (size_t)b * TSEQ + tq;
  const int cmaxq = (tq - 31) >> 4;
  const int nkt = (4 * qb + 3 + 31) >> 5;
  const bf16_t* Kc = p.kcmp + (size_t)bg * 256 * 128;
  const bf16_t* Vc = p.vcmpT + (size_t)bg * 128 * 256;
  const float NEG = -__builtin_inff();
#pragma unroll 1
  for (int ct = 0; ct < 2; ++ct) {
    const int head = g * 4 + 2 * ct + (n >> 4);
    bf16x8 qf[8];
#pragma unroll
    for (int d0 = 0; d0 < 8; ++d0) qf[d0] = *(const bf16x8*)(p.q + m * DM + head * 128 + d0 * 16 + hi * 8);
    float mx = -1e30f, l = 0.f;
#pragma unroll 1
    for (int kt = 0; kt < nkt; ++kt) {
      f32x16 sc; for (int r = 0; r < 16; ++r) sc[r] = 0.f;
#pragma unroll
      for (int d0 = 0; d0 < 8; ++d0) {
        bf16x8 kf = *(const bf16x8*)(Kc + (size_t)(kt * 32 + n) * 128 + d0 * 16 + hi * 8);
        sc = __builtin_amdgcn_mfma_f32_32x32x16_bf16(kf, qf[d0], sc, 0, 0, 0);
      }
      float tm = NEG;
#pragma unroll
      for (int r = 0; r < 16; ++r) { const int cc = kt * 32 + crow(r, hi); if (cc > cmaxq) sc[r] = NEG; tm = fmaxf(tm, sc[r]); }
      tm = swap32_max(tm);
      const float mn = fmaxf(mx, tm);
      float ps = 0.f;
#pragma unroll
      for (int r = 0; r < 16; ++r) ps += __builtin_amdgcn_exp2f(sc[r] - mn);
      ps = swap32_sum(ps);
      l = l * __builtin_amdgcn_exp2f(mx - mn) + ps; mx = mn;
    }
    const float inv_l = l > 0.f ? 1.f / l : 0.f;
    f32x16 o[4];
#pragma unroll
    for (int dt = 0; dt < 4; ++dt) for (int r = 0; r < 16; ++r) o[dt][r] = 0.f;
#pragma unroll 1
    for (int kt = 0; kt < nkt; ++kt) {
      f32x16 sc; for (int r = 0; r < 16; ++r) sc[r] = 0.f;
#pragma unroll
      for (int d0 = 0; d0 < 8; ++d0) {
        bf16x8 kf = *(const bf16x8*)(Kc + (size_t)(kt * 32 + n) * 128 + d0 * 16 + hi * 8);
        sc = __builtin_amdgcn_mfma_f32_32x32x16_bf16(kf, qf[d0], sc, 0, 0, 0);
      }
      float pr[16];
#pragma unroll
      for (int r = 0; r < 16; ++r) { const int cc = kt * 32 + crow(r, hi); pr[r] = (cc > cmaxq) ? 0.f : __builtin_amdgcn_exp2f(sc[r] - mx) * inv_l; }
#pragma unroll
      for (int a = 0; a < 4; ++a) {
        float mainv = pr[4 * a] + pr[4 * a + 1] + pr[4 * a + 2] + 0.5f * pr[4 * a + 3];
        float spill = 0.5f * pr[4 * a + 3];
        mainv += __shfl_xor(mainv, 16); spill += __shfl_xor(spill, 16);
        if ((n & 16) == 0) {
          const int jj = 8 * kt + 2 * a + hi;
          impM[ql * 68 + jj] += mainv; impS[ql * 68 + jj + 1] += spill;
        }
      }
      const float pf0[8] = {pr[0], pr[1], pr[2], pr[3], pr[4], pr[5], pr[6], pr[7]};
      const float pf1[8] = {pr[8], pr[9], pr[10], pr[11], pr[12], pr[13], pr[14], pr[15]};
      const bf16x8 pb0 = pack8f(pf0), pb1 = pack8f(pf1);
#pragma unroll
      for (int dt = 0; dt < 4; ++dt) {
        const bf16_t* vp = Vc + (size_t)(dt * 32 + n) * 256 + kt * 32 + hi * 8;
        bf16x8 v0 = *(const bf16x8*)vp, v1 = *(const bf16x8*)(vp + 16);
        o[dt] = __builtin_amdgcn_mfma_f32_32x32x16_bf16(v0, pb0, o[dt], 0, 0, 0);
        o[dt] = __builtin_amdgcn_mfma_f32_32x32x16_bf16(v1, pb1, o[dt], 0, 0, 0);
      }
    }
    const float gt = p.gates[m * 48 + head * 3 + 0];
#pragma unroll
    for (int dt = 0; dt < 4; ++dt)
#pragma unroll
      for (int a = 0; a < 4; ++a) {
        u32x2 wv = {cvtpk(o[dt][4 * a] * gt, o[dt][4 * a + 1] * gt), cvtpk(o[dt][4 * a + 2] * gt, o[dt][4 * a + 3] * gt)};
        *(u32x2*)(p.ocmp + m * DM + head * 128 + dt * 32 + 8 * a + 4 * hi) = wv;
      }
  }
  __syncthreads();
  {
    const int qq = 16 * w + (lane >> 2), part = lane & 3;
    const int cur = qb;
    unsigned lo, hi32;
    if (cur < 16) { lo = (2u << cur) - 1u; hi32 = 0u; }
    else {
      float* rowp = impM + qq * 68; const float* rows = impS + qq * 68;
      for (int e = 0; e < 16; ++e) { const int j = part * 16 + e; rowp[j] = rowp[j] + rows[j]; }
      __builtin_amdgcn_fence(__ATOMIC_RELEASE, "wavefront");
      __builtin_amdgcn_wave_barrier();
      float vj[16]; int rank[16];
#pragma unroll
      for (int e = 0; e < 16; ++e) { vj[e] = rowp[part * 16 + e]; rank[e] = 0; }
      for (int j2 = 1; j2 <= cur - 2; ++j2) {
        const float v2 = rowp[j2];
#pragma unroll
        for (int e = 0; e < 16; ++e) { const int j = part * 16 + e; rank[e] += (v2 > vj[e] || (v2 == vj[e] && j2 < j)) ? 1 : 0; }
      }
      unsigned bits = 0;
#pragma unroll
      for (int e = 0; e < 16; ++e) { const int j = part * 16 + e; if (j >= 1 && j <= cur - 2 && rank[e] < 13) bits |= 1u << e; }
      const int base = lane & ~3;
      const unsigned b0 = __shfl(bits, base), b1 = __shfl(bits, base + 1), b2 = __shfl(bits, base + 2), b3 = __shfl(bits, base + 3);
      lo = b0 | (b1 << 16); hi32 = b2 | (b3 << 16);
      lo |= 1u;
      { const int j = cur - 1; if (j < 32) lo |= 1u << j; else hi32 |= 1u << (j - 32); }
      { const int j = cur; if (j < 32) lo |= 1u << j; else hi32 |= 1u << (j - 32); }
    }
    if (part == 0) {
      unsigned* sp = p.selmask + ((size_t)bg * TSEQ + qb * 64 + qq) * 2;
      sp[0] = lo; sp[1] = hi32;
    }
  }
  __syncthreads();
}

template <int BR>
__device__ __forceinline__ void attn_pass(const P& p, const int b, const int g, const int qb, const int head, const int tq, const bf16x8* qf,
                                          unsigned long long tiles, const unsigned long long mysel, char* lds) {
  const int tid = threadIdx.x, lane = tid & 63;
  const int kl = lane & 31, hi = lane >> 5;
  const int bg = b * 4 + g;
  const bf16_t* Kg = (BR == 0 ? p.kw : p.ks) + (size_t)bg * TSEQ * 128;
  const bf16_t* Vg = (BR == 0 ? p.vwT : p.vsT) + (size_t)bg * 128 * TSEQ;
  const unsigned Wlim = BR == 0 ? 512u : 0x80000000u;
  const float NEG = -__builtin_inff();
  f32x16 o[4];
#pragma unroll
  for (int dt = 0; dt < 4; ++dt) for (int r = 0; r < 16; ++r) o[dt][r] = 0.f;
  float mx = -1e30f, l = 0.f;
  bf16x8 sk[4], sv[4];
  auto load_tile = [&](int j) {
#pragma unroll
    for (int i = 0; i < 4; ++i) {
      const int id = tid + 256 * i;
      sk[i] = *(const bf16x8*)(Kg + (size_t)(j * 64 + (id >> 4)) * 128 + (id & 15) * 8);
      sv[i] = *(const bf16x8*)(Vg + (size_t)(id >> 3) * TSEQ + j * 64 + (id & 7) * 8);
    }
  };
  auto store_tile = [&](int buf) {
    char* Kb = lds + buf * ATT_BUF; char* Vb = Kb + ATT_KSZ;
#pragma unroll
    for (int i = 0; i < 4; ++i) {
      const int id = tid + 256 * i;
      { const int row = id >> 4, c16 = id & 15; *(bf16x8*)(Kb + row * 272 + (c16 << 4)) = sk[i]; }
      { const int d = id >> 3, cx = id & 7; *(bf16x8*)(Vb + d * 144 + (cx << 4)) = sv[i]; }
    }
  };
  int j = __builtin_ctzll(tiles); tiles &= tiles - 1;
  load_tile(j);
  store_tile(0);
  __syncthreads();
  int buf = 0;
  while (true) {
    const bool more = tiles != 0ull;
    int jn = 0;
    if (more) { jn = __builtin_ctzll(tiles); tiles &= tiles - 1; load_tile(jn); }
    {
      const char* Kb = lds + buf * ATT_BUF + kl * 272 + hi * 16; const char* Vb = lds + buf * ATT_BUF + ATT_KSZ + kl * 144 + hi * 16;
      const bool lane_ok = BR == 0 ? true : ((mysel >> j) & 1ull) != 0ull;
      const bool wave_any = __any(lane_ok);
      const bool boundary = BR == 0 ? (j == qb || j + 8 == qb) : (j == qb);
      if (wave_any) {
#pragma unroll
        for (int hs = 0; hs < 2; ++hs) {
          f32x16 sc; for (int r = 0; r < 16; ++r) sc[r] = 0.f;
#pragma unroll
          for (int d0 = 0; d0 < 8; ++d0) {
            bf16x8 kf = *(const bf16x8*)(Kb + hs * 32 * 272 + d0 * 32);
            sc = __builtin_amdgcn_mfma_f32_32x32x16_bf16(kf, qf[d0], sc, 0, 0, 0);
          }
          if (boundary) {
            const int dq = tq - (j * 64 + hs * 32 + 4 * hi);
#pragma unroll
            for (int r = 0; r < 16; ++r) { const int cidx = (r & 3) + 8 * (r >> 2); if ((unsigned)(dq - cidx) >= Wlim) sc[r] = NEG; }
          }
          if (BR == 1) {
#pragma unroll
            for (int r = 0; r < 16; ++r) sc[r] = lane_ok ? sc[r] : NEG;
          }
          float tm = sc[0];
#pragma unroll
          for (int r = 1; r < 16; ++r) tm = fmaxf(tm, sc[r]);
          tm = swap32_max(tm);
          if (!__all(tm <= mx + 8.f)) {
            const float mn = fmaxf(mx, tm);
            const float alpha = __builtin_amdgcn_exp2f(mx - mn);
            l *= alpha; mx = mn;
#pragma unroll
            for (int dt = 0; dt < 4; ++dt)
#pragma unroll
              for (int r = 0; r < 16; ++r) o[dt][r] *= alpha;
          }
          float pr[16]; float ps = 0.f;
#pragma unroll
          for (int r = 0; r < 16; ++r) { pr[r] = __builtin_amdgcn_exp2f(sc[r] - mx); ps += pr[r]; }
          ps = swap32_sum(ps);
          l += ps;
          const float pf0[8] = {pr[0], pr[1], pr[2], pr[3], pr[4], pr[5], pr[6], pr[7]};
          const float pf1[8] = {pr[8], pr[9], pr[10], pr[11], pr[12], pr[13], pr[14], pr[15]};
          const bf16x8 pb0 = pack8f(pf0), pb1 = pack8f(pf1);
#pragma unroll
          for (int dt = 0; dt < 4; ++dt) {
            bf16x8 v0 = *(const bf16x8*)(Vb + dt * 32 * 144 + hs * 64);
            bf16x8 v1 = *(const bf16x8*)(Vb + dt * 32 * 144 + hs * 64 + 32);
            o[dt] = __builtin_amdgcn_mfma_f32_32x32x16_bf16(v0, pb0, o[dt], 0, 0, 0);
            o[dt] = __builtin_amdgcn_mfma_f32_32x32x16_bf16(v1, pb1, o[dt], 0, 0, 0);
          }
        }
      }
    }
    if (more) store_tile(buf ^ 1);
    __syncthreads();
    if (!more) break;
    j = jn; buf ^= 1;
  }
  const size_t m = (size_t)b * TSEQ + tq;
  const float gt = p.gates[m * 48 + head * 3 + (BR == 0 ? 2 : 1)];
  const float sc_ = gt / l;
  if (BR == 0) {
#pragma unroll
    for (int dt = 0; dt < 4; ++dt)
#pragma unroll
      for (int a = 0; a < 4; ++a) {
        const size_t idx = m * DM + head * 128 + dt * 32 + 8 * a + 4 * hi;
        *(u32x2*)(p.ubuf + idx) = u32x2{cvtpk(o[dt][4 * a] * sc_, o[dt][4 * a + 1] * sc_), cvtpk(o[dt][4 * a + 2] * sc_, o[dt][4 * a + 3] * sc_)};
      }
  } else {
#pragma unroll
    for (int dt = 0; dt < 4; ++dt)
#pragma unroll
      for (int a = 0; a < 4; ++a) {
        const size_t idx = m * DM + head * 128 + dt * 32 + 8 * a + 4 * hi;
        const u32x2 oc = *(const u32x2*)(p.ocmp + idx);
        const u32x2 zz = *(const u32x2*)(p.sz + idx);
        const u32x2 ww = *(const u32x2*)(p.ubuf + idx);
        const float y0 = (o[dt][4 * a] * sc_ + bflo(ww[0]) + bflo(oc[0])) * bflo(zz[0]);
        const float y1 = (o[dt][4 * a + 1] * sc_ + bfhi(ww[0]) + bfhi(oc[0])) * bfhi(zz[0]);
        const float y2 = (o[dt][4 * a + 2] * sc_ + bflo(ww[1]) + bflo(oc[1])) * bflo(zz[1]);
        const float y3 = (o[dt][4 * a + 3] * sc_ + bfhi(ww[1]) + bfhi(oc[1])) * bfhi(zz[1]);
        *(u32x2*)(p.ubuf + idx) = u32x2{cvtpk(y0, y1), cvtpk(y2, y3)};
      }
  }
}

__device__ __forceinline__ void attn_item(const P& p, const int item, char* lds, unsigned long long* uni) {
  const int half = item & 1, g = (item >> 1) & 3, b = (item >> 3) & 3, qb = 63 - (item >> 5);
  const int tid = threadIdx.x, lane = tid & 63, w = tid >> 6;
  const int kl = lane & 31, hi = lane >> 5;
  const int head = g * 4 + half * 2 + (w >> 1);
  const int tq = qb * 64 + (w & 1) * 32 + kl;
  const size_t m = (size_t)b * TSEQ + tq;
  bf16x8 qf[8];
#pragma unroll
  for (int d0 = 0; d0 < 8; ++d0) qf[d0] = *(const bf16x8*)(p.q + m * DM + head * 128 + d0 * 16 + hi * 8);
  const unsigned* sp = p.selmask + ((size_t)(b * 4 + g) * TSEQ + tq) * 2;
  const unsigned long long mysel = (unsigned long long)sp[0] | ((unsigned long long)sp[1] << 32);
  unsigned long long u = mysel;
#pragma unroll
  for (int o = 16; o >= 1; o >>= 1) { u |= (unsigned long long)__shfl_xor((unsigned)u, o) | ((unsigned long long)__shfl_xor((unsigned)(u >> 32), o) << 32); }
  if (lane == 0) uni[w] = u;
  __syncthreads();
  const unsigned long long U = (uni[0] | uni[1] | uni[2] | uni[3]) & (qb == 63 ? ~0ull : ((2ull << qb) - 1ull));
  const int jlo = qb >= 8 ? qb - 8 : 0;
  const unsigned long long wt = (qb == 63 ? ~0ull : ((2ull << qb) - 1ull)) & ~((1ull << jlo) - 1ull);
  attn_pass<0>(p, b, g, qb, head, tq, qf, wt, mysel, lds);
  attn_pass<1>(p, b, g, qb, head, tq, qf, U, mysel, lds);
}

typedef __attribute__((address_space(1))) unsigned gunsigned;
__device__ __forceinline__ unsigned gb_ld(unsigned* p) { return __hip_atomic_load((gunsigned*)p, __ATOMIC_RELAXED, __HIP_MEMORY_SCOPE_AGENT); }
__device__ __forceinline__ unsigned gb_add(unsigned* p, unsigned v) { return __hip_atomic_fetch_add((gunsigned*)p, v, __ATOMIC_RELAXED, __HIP_MEMORY_SCOPE_AGENT); }
__device__ __forceinline__ void grid_barrier(unsigned* bar, const unsigned e) {
  __builtin_amdgcn_fence(__ATOMIC_RELEASE, "workgroup");
  __builtin_amdgcn_s_waitcnt(0);
  __syncthreads();
  if (threadIdx.x == 0) {
    const unsigned G = gridDim.x, g = blockIdx.x & 7u;
    const unsigned ngrp = G < 8u ? G : 8u, nloc = (G + 7u - g) >> 3;
    __builtin_amdgcn_fence(__ATOMIC_RELEASE, "agent");
    __builtin_amdgcn_s_waitcnt(0);
    const unsigned old = gb_add(&bar[64u * (1u + g)], 1u);
    if (old + 1u == (e + 1u) * nloc) {
      const unsigned og = gb_add(&bar[0], 1u);
      if (og + 1u == (e + 1u) * ngrp) gb_add(&bar[64u * 20u], 1u);
      else { unsigned sp = 0; while (gb_ld(&bar[64u * 20u]) <= e && ++sp < (1u << 24)) __builtin_amdgcn_s_sleep(1); }
      gb_add(&bar[64u * (10u + g)], 1u);
    } else {
      unsigned sp = 0; while (gb_ld(&bar[64u * (10u + g)]) <= e && ++sp < (1u << 24)) __builtin_amdgcn_s_sleep(1);
    }
    __builtin_amdgcn_fence(__ATOMIC_ACQUIRE, "agent");
    __builtin_amdgcn_s_waitcnt(0);
  }
  __syncthreads();
}

#define NPHASE 23
#ifndef GRP
#define GRP 0xFFFF
#endif
#define EN(b) ((GRP >> (b)) & 1)
#ifndef DUPMASK
#define DUPMASK 0
#endif
#define PHASE(n, en, ...) if (ph_lo <= (n) && (n) < ph_hi) { if (EN(en)) { __VA_ARGS__ if ((DUPMASK >> (n)) & 1) { __syncthreads(); __VA_ARGS__ } } if ((n) + 1 < ph_hi) { if ((n) == 0) cg::this_grid().sync(); else grid_barrier(bar, (unsigned)((n) - 1)); } }

__device__ __forceinline__ bool deal_tile(int r, int NT, int& mt, int& nt) {
  const int G = gridDim.x, bid = blockIdx.x;
  if (G == 512) {
    const int x = bid & 7, lb = bid >> 3;
    const int NG = NT >> 3, rem = NT & 7;
    if (r < 2 * NG) { mt = 16 * x + (r & 1) * 8 + (lb >> 3); nt = (r >> 1) * 8 + (lb & 7); return true; }
    const int idx = (r - 2 * NG) * 64 + lb;
    if (idx < 16 * rem) { mt = 16 * x + idx / rem; nt = NG * 8 + idx % rem; return true; }
    return false;
  }
  const int t = bid + r * G;
  if (t < 128 * NT) { mt = t / NT; nt = t % NT; return true; }
  return false;
}
__device__ __forceinline__ int deal_rounds(int NT) {
  const int G = gridDim.x;
  if (G == 512) return 2 * (NT >> 3) + (16 * (NT & 7) + 63) / 64;
  return (128 * NT + G - 1) / G;
}
__device__ __forceinline__ void ph_proj(const P& p, int layer, char* lds) {
  {
    const int nr = deal_rounds(32);
    for (int r = 0; r < nr; ++r) {
      int mt, nt2;
      if (!deal_tile(r, 32, mt, nt2)) continue;
      GemmCtx cw; cw.A = p.ubuf; cw.lda = DM; cw.K = DM; cw.layer = layer; cw.j = 0; cw.Bt = p.Wp;
      cw.aux = p.a_mu + (size_t)(layer * 6 + (nt2 >> 3)) * DM;
      gemm_wide<AL_MIX, EP_PROJ>(p, cw, mt, nt2, lds);
    }
  }
  const int NL = layer == 0 ? 2 : 3;
  GemmCtx c; c.A = p.ubuf; c.lda = DM; c.K = DM; c.layer = layer; c.j = 0; c.Bt = p.Wp;
  const int nr = deal_rounds(NL);
  for (int r = 0; r < nr; ++r) {
    int mt, ntl;
    if (!deal_tile(r, NL, mt, ntl)) continue;
    const int nt = 64 + ntl;
    const int mui = nt == 64 ? 4 : nt == 65 ? 5 : 2;
    c.aux = p.a_mu + (size_t)(layer * 6 + mui) * DM;
    gemm_tile<AL_MIX, EP_PROJ>(p, c, mt, nt, lds);
  }
}
__device__ __forceinline__ void ph_wo(const P& p, int layer, const bf16_t* Wt, char* lds) {
  GemmCtx c; c.A = p.ubuf; c.lda = DM; c.Bt = Wt; c.K = DM; c.layer = layer; c.j = 0; c.aux = nullptr;
  const int nr = deal_rounds(8);
  for (int r = 0; r < nr; ++r) {
    int mt, nt2;
    if (!deal_tile(r, 8, mt, nt2)) continue;
    gemm_wide<AL_PLAIN, EP_RESID>(p, c, mt, nt2, lds);
  }
}
__device__ __forceinline__ void ph_kvwin(const P& p, int jl, int NTK, char* lds) {
  const int NK2 = NTK >> 1, NT2 = NK2 + 16;
  {
    const int nr = deal_rounds(NT2);
    for (int r = 0; r < nr; ++r) {
      int mt, nt2;
      if (!deal_tile(r, NT2, mt, nt2)) continue;
      GemmCtx c; c.lda = DM; c.K = DM; c.layer = 1; c.j = jl; c.aux = nullptr;
      if (nt2 < NK2) { c.A = p.hn; c.Bt = p.Wkv; gemm_wide<AL_PLAIN, EP_KV>(p, c, mt, nt2, lds); }
      else { c.A = p.ubuf; c.Bt = p.Win; gemm_wide<AL_PLAIN, EP_WIN>(p, c, mt, nt2 - NK2, lds); }
    }
  }
  if (jl != 0) {
    GemmCtx c; c.lda = DM; c.K = DM; c.layer = 1; c.j = jl; c.aux = nullptr; c.A = p.ubuf; c.Bt = p.Win;
    const int nr = deal_rounds(1);
    for (int r = 0; r < nr; ++r) {
      int mt, ntl;
      if (!deal_tile(r, 1, mt, ntl)) continue;
      gemm_tile<AL_PLAIN, EP_WIN>(p, c, mt, 32, lds);
    }
  }
}
__device__ __forceinline__ void ph_attn(const P& p, char* lds, unsigned long long* uni) {
  const int G = gridDim.x, bid = blockIdx.x;
  const bool xcd = G == 512;
  const int x = bid & 7, lb = bid >> 3, a = lb >> 1, half = lb & 1;
  int rnd = 0;
  for (int base = 0; base < 2048; base += G, ++rnd) {
    int idx;
    if (xcd) {
      const int bg = x * 2 + (rnd >> 1), b = bg >> 2, g = bg & 3;
      const int qb = (rnd & 1) ? a : 63 - a;
      idx = ((63 - qb) << 5) | (b << 3) | (g << 1) | half;
    } else idx = base + ((rnd & 1) ? (G - 1 - bid) : bid);
    if (idx < 2048) attn_item(p, idx, lds, uni);
    __syncthreads();
  }
}

__device__ __forceinline__ int cmp_deal(int t) {
  if (gridDim.x != 512) return t;
  const int bid = t & 511, r = t >> 9, x = bid & 7, lb = bid >> 3;
  const int bg = 2 * x + r, b = bg >> 2, g = bg & 3, qb = r ? 63 - lb : lb;
  return (b << 8) | (g << 6) | ((b >= 2) ? 63 - qb : qb);
}
__global__ void __launch_bounds__(NTHREADS, 2) fwd_kernel(const P p, const PJ pj, unsigned* bar, const int ph_lo, const int ph_hi) {
  __shared__ __attribute__((aligned(16))) char lds[LDS_BYTES];
  __shared__ unsigned long long uni[4];
  const int G = gridDim.x, bid = blockIdx.x;
  if (bid == 0 && ph_lo == 0) { for (int i = threadIdx.x; i < 64 * 32; i += NTHREADS) bar[i] = 0u; }
  PHASE(0, 0, norm_phase<0, 0>(p, pj, false, p.a_norm_g, p.ubuf, nullptr, nullptr, nullptr, lds);)
  PHASE(1, 1, ph_proj(p, 0, lds);)
  PHASE(2, 2, for (int it = bid; it < 512; it += G) scan_item(p, 0, G == 512 ? ((((it & 7) * 16 + (it >> 5)) << 2) | ((it >> 3) & 3)) : it, lds);)
  PHASE(3, 3, postscan_phase(p, 0);)
  PHASE(4, 4, ph_wo(p, 0, p.Wo, lds);)
  PHASE(5, 0, norm_phase<0, 1>(p, pj, true, p.a_norm_g + DM, p.ubuf, nullptr, nullptr, nullptr, lds);)
  PHASE(6, 1, ph_proj(p, 1, lds);)
  PHASE(7, 2, for (int it = bid; it < 512; it += G) scan_item(p, 1, G == 512 ? ((((it & 7) * 16 + (it >> 5)) << 2) | ((it >> 3) & 3)) : it, lds);)
  PHASE(8, 3, postscan_phase(p, 1);)
  PHASE(9, 4, ph_wo(p, 1, p.Wo, lds);)
  PHASE(10, 0, norm_phase<1, 2>(p, pj, true, p.kv_norm_g, p.hn, p.b_norm_g, p.ubuf, nullptr, lds);)
  PHASE(11, 5, ph_kvwin(p, 0, 24, lds);)
  PHASE(12, 6,
    for (int t = bid; t < 256; t += G) {
      if (t >= 128) {
        GemmCtx cg; cg.lda = DM; cg.K = DM; cg.layer = 1; cg.j = 0; cg.aux = nullptr; cg.A = p.ubuf; cg.Bt = p.Win;
        gemm_tile<AL_PLAIN, EP_WIN>(p, cg, t - 128, 32, lds);
        continue;
      }
      const int j = t >> 6, r = t & 63, mt = r >> 1, nt = r & 1;
      GemmCtx c; c.A = p.kc + (size_t)j * (8u << 20); c.lda = 0; c.Bt = p.Wc1 + (size_t)j * 256 * 4096; c.K = 4096; c.layer = 0; c.j = j;
      c.aux = p.cmp_pe + (size_t)j * 32 * 128;
      gemm_tile<AL_CMP, EP_CMP1>(p, c, mt, nt, lds);
    })
  PHASE(13, 7,
    for (int t = bid; t < 64; t += G) {
      const int j = t >> 5, mt = t & 31;
      GemmCtx c; c.A = p.hc + (size_t)j * 4096 * 256; c.lda = 256; c.Bt = p.Wc2 + (size_t)j * 128 * 256; c.K = 256; c.layer = 0; c.j = j; c.aux = nullptr;
      gemm_tile<AL_PLAIN, EP_CMP2>(p, c, mt, 0, lds);
    })
  PHASE(14, 8, for (int t = bid; t < 1024; t += G) cmp_item(p, cmp_deal(t), lds);)
  PHASE(15, 9, ph_attn(p, lds, uni);)
  PHASE(16, 4, ph_wo(p, 1, p.Wob, lds);)
  PHASE(17, 0, norm_phase<0, 3>(p, pj, true, p.b_norm_g + DM, p.ubuf, nullptr, nullptr, nullptr, lds);)
  PHASE(18, 5, ph_kvwin(p, 1, 0, lds);)
  PHASE(19, 8, for (int t = bid; t < 1024; t += G) cmp_item(p, cmp_deal(t), lds);)
  PHASE(20, 9, ph_attn(p, lds, uni);)
  PHASE(21, 4, ph_wo(p, 1, p.Wob, lds);)
  PHASE(22, 0, norm_phase<2, -1>(p, pj, true, p.final_g, nullptr, nullptr, nullptr, p.out, lds);)
}

static inline size_t MiB(double x) { return (size_t)(x * 1048576.0); }

extern "C" void kernel_launch(void* const* d_in, const int* in_sizes, int n_in, void* d_out, int out_size, void* d_ws, size_t ws_size, hipStream_t stream) {
  (void)in_sizes; (void)n_in; (void)out_size;
  P p; memset(&p, 0, sizeof(P));
  PJ pj; memset(&pj, 0, sizeof(PJ));
  const float* const* in = (const float* const*)d_in;
  p.x = in[0]; p.a_norm_g = in[1]; p.a_mu = in[2];
  const float* a_w_rkvz = in[3];
  p.a_w0 = in[4]; const float* a_w1 = in[5]; const float* a_w2 = in[6];
  p.a_a0 = in[7]; const float* a_a1 = in[8]; const float* a_a2 = in[9];
  p.a_v0 = in[10]; const float* a_v1 = in[11]; const float* a_v2 = in[12];
  p.a_k_k = in[13]; p.a_k_a = in[14]; p.a_r_k = in[15]; p.a_ln_g = in[16]; p.a_ln_b = in[17];
  const float* a_w_o = in[18];
  p.kv_norm_g = in[19]; const float* kv_w = in[20]; p.cmp_pe = in[21]; const float* cmp_w1 = in[22]; const float* cmp_w2 = in[23];
  p.b_norm_g = in[24]; const float* b_w_in = in[25]; p.b_gate_b = in[26]; const float* b_w_o = in[27]; p.final_g = in[28];
  p.out = (float*)d_out;
  if (ws_size < MiB(512)) { fprintf(stderr, "workspace too small: %zu\n", ws_size); return; }
  char* ws = (char*)d_ws;
  p.ysum = (bf16_t*)(ws + MiB(0)); p.ubuf = (bf16_t*)(ws + MiB(64)); p.r = (bf16_t*)(ws + MiB(128)); p.k = (bf16_t*)(ws + MiB(192));
  p.vA = (bf16_t*)(ws + MiB(256)); p.z = (bf16_t*)(ws + MiB(320)); p.vB = (bf16_t*)(ws + MiB(384));
  p.hn = (bf16_t*)(ws + MiB(128)); p.ocmp = p.hn; p.q = (bf16_t*)(ws + MiB(192)); p.sz = (bf16_t*)(ws + MiB(256));
  p.kc = (bf16_t*)(ws + MiB(320)); p.vc = (bf16_t*)(ws + MiB(336)); p.ks = (bf16_t*)(ws + MiB(352)); p.vsT = (bf16_t*)(ws + MiB(368));
  p.kw = (bf16_t*)(ws + MiB(384)); p.vwT = (bf16_t*)(ws + MiB(400));
  p.hc = (bf16_t*)(ws + MiB(416)); p.kcmp = (bf16_t*)(ws + MiB(420)); p.vcmpT = (bf16_t*)(ws + MiB(421));
  p.gates = (float*)(ws + MiB(422)); p.selmask = (unsigned*)(ws + MiB(425));
  char* ar = ws + MiB(448);
  p.Wp = (bf16_t*)ar;
  p.W2w = (bf16_t*)(ar + MiB(33.5)); p.W2a = (bf16_t*)(ar + MiB(34)); p.W2v = (bf16_t*)(ar + MiB(34.5));
  p.Wo = (bf16_t*)(ar + MiB(35));
  p.Wkv = (bf16_t*)ar;
  p.Win = (bf16_t*)(ar + MiB(12));
  p.Wc1 = (bf16_t*)(ar + MiB(28.5));
  p.Wc2 = (bf16_t*)(ar + MiB(32.5));
  p.Wob = (bf16_t*)(ar + MiB(33));
  p.lw = (bf16_t*)(ws + MiB(492)); p.la = (bf16_t*)(ws + MiB(496)); p.lv = (bf16_t*)(ws + MiB(500));
  unsigned* bar = (unsigned*)(ws + MiB(508));
  p.bon = (float*)(ws + MiB(504)); p.ropec = (float*)(ws + MiB(506)); p.ropes = (float*)(ws + MiB(506.5));

  int nj = 0, tile = 0;
  auto add = [&](const float* src, bf16_t* dst, int K, int N, int ld, int Kpad, int Npad) {
    ConvJob& j = pj.jobs[nj++]; j.src = src; j.dst = dst; j.K = K; j.N = N; j.ld = ld; j.Kpad = Kpad; j.Npad = Npad; j.tile0 = tile;
    tile += (Kpad / 64) * (Npad / 64);
  };
  const size_t DD = (size_t)DM * DM;
  for (int L = 0; L < 2; ++L) {
    tile = 0;
    for (int n4 = 0; n4 < 4; ++n4) add(a_w_rkvz + (size_t)(L * 4 + n4) * DD, p.Wp + (size_t)n4 * DD, DM, DM, DM, DM, DM);
    add(a_w1 + (size_t)L * DM * 96, p.Wp + (size_t)8192 * DM, DM, 96, 96, DM, 128);
    add(a_a1 + (size_t)L * DM * 96, p.Wp + (size_t)8320 * DM, DM, 96, 96, DM, 128);
    if (L == 1) add(a_v1, p.Wp + (size_t)8448 * DM, DM, 64, 64, DM, 128);
    add(a_w2 + (size_t)L * 96 * DM, p.W2w, 96, DM, DM, 128, DM);
    add(a_a2 + (size_t)L * 96 * DM, p.W2a, 96, DM, DM, 128, DM);
    if (L == 1) add(a_v2, p.W2v, 64, DM, DM, 128, DM);
    add(a_w_o + (size_t)L * DD, p.Wo, DM, DM, DM, DM, DM);
    pj.stage_tiles[L] = tile;
  }
  tile = 0;
  add(kv_w, p.Wkv, DM, 3072, 3072, DM, 3072);
  for (int j = 0; j < 2; ++j) add(cmp_w1 + (size_t)j * 4096 * 256, p.Wc1 + (size_t)j * 256 * 4096, 4096, 256, 256, 4096, 256);
  for (int j = 0; j < 2; ++j) add(cmp_w2 + (size_t)j * 256 * 128, p.Wc2 + (size_t)j * 128 * 256, 256, 128, 128, 256, 128);
  for (int L = 0; L < 2; ++L) {
    if (L == 1) { pj.stage_tiles[2] = tile; tile = 0; }
    const float* wi = b_w_in + (size_t)L * DM * 4144;
    add(wi, p.Win, DM, 2048, 4144, DM, 2048);
    add(wi + 2096, p.Win + (size_t)2048 * DM, DM, 2048, 4144, DM, 2048);
    add(wi + 2048, p.Win + (size_t)4096 * DM, DM, 48, 4144, DM, 128);
    add(b_w_o + (size_t)L * DD, p.Wob, DM, DM, DM, DM, DM);
  }
  pj.stage_tiles[3] = tile;
  for (int i = 0; i < 16; ++i) pj.rope_inv[i] = (float)pow(500000.0, -(double)i / 16.0);

  static int grid_blocks = 0;
  if (!grid_blocks) {
    int dev = 0, cus = 0, per_cu = 0;
    hipGetDevice(&dev);
    hipDeviceGetAttribute(&cus, hipDeviceAttributeMultiprocessorCount, dev);
    hipOccupancyMaxActiveBlocksPerMultiprocessor(&per_cu, fwd_kernel, NTHREADS, 0);
    if (per_cu > 2) per_cu = 2;
    if (per_cu < 1) per_cu = 1;
    grid_blocks = cus * per_cu;
  }
#if ONE_LAUNCH
  int lo = 0, hi = NPHASE;
  void* args[] = {(void*)&p, (void*)&pj, (void*)&bar, (void*)&lo, (void*)&hi};
  hipError_t e = hipLaunchCooperativeKernel((void*)fwd_kernel, dim3(grid_blocks), dim3(NTHREADS), args, 0, stream);
  if (e != hipSuccess) fprintf(stderr, "cooperative launch failed: %s (grid %d)\n", hipGetErrorString(e), grid_blocks);
#else
  for (int ph = 0; ph < NPHASE; ++ph) {
    hipLaunchKernelGGL(fwd_kernel, dim3(grid_blocks), dim3(NTHREADS), 0, stream, p, pj, bar, ph, ph + 1);
  }

#endif
}
```
